# Optimizing an MI355X kernel written in HIP

```python
import math
import jax, jax.numpy as jnp
from jax import lax
import numpy as np

D_MODEL = 2048
BATCH = 4
SEQ = 2048
DEPTH = 1

MIX_WIDTH = D_MODEL
ATTN_WIDTH = MIX_WIDTH // 2
POOL_WIDTH = MIX_WIDTH - ATTN_WIDTH
N_DIFF_HEADS = 8
DIFF_HEAD_DIM = ATTN_WIDTH // N_DIFF_HEADS // 2
DIFF_V_DIM = 2 * DIFF_HEAD_DIM
POOL_WINDOWS = (2, 4, 8, 16)
N_POOL_GROUPS = len(POOL_WINDOWS)
POOL_GROUP_DIM = POOL_WIDTH // N_POOL_GROUPS
IN_WIDTH = 3 * ATTN_WIDTH + POOL_WIDTH
N_EXPERT_GROUPS = 4
EXPERTS_PER_GROUP = 8
N_EXPERTS = N_EXPERT_GROUPS * EXPERTS_PER_GROUP
TOP_K_FINE = 2
D_FF_EXPERT = D_MODEL // 4
Q_BLOCK = 128
RMS_EPS = 1e-6
NEG_INF = -1e30

kernel_name = "hymba_diffattn_pool_hmoe_block"


def rmsnorm(x, g):
    xf = x.astype(jnp.float32)
    y = xf * lax.rsqrt(jnp.mean(xf * xf, axis=-1, keepdims=True) + RMS_EPS)
    return (y * g.astype(jnp.float32)).astype(x.dtype)


def alibi_slopes(n_heads):
    return jnp.exp2(-8.0 * jnp.arange(1, n_heads + 1, dtype=jnp.float32) / n_heads)


def diff_attention(q, k, v, lam, subln_g, lam_init):
    B, S = q.shape[0], q.shape[1]
    nb = S // Q_BLOCK
    q1 = q[:, :, :, 0].transpose(0, 2, 1, 3)
    q2 = q[:, :, :, 1].transpose(0, 2, 1, 3)
    k1 = k[:, :, :, 0].transpose(0, 2, 1, 3)
    k2 = k[:, :, :, 1].transpose(0, 2, 1, 3)
    vh = v.transpose(0, 2, 1, 3)
    scale = DIFF_HEAD_DIM ** -0.5
    slopes = alibi_slopes(N_DIFF_HEADS)
    key_pos = jnp.arange(S, dtype=jnp.int32)

    def to_blocks(t):
        return t.reshape(B, N_DIFF_HEADS, nb, Q_BLOCK, -1).transpose(2, 0, 1, 3, 4)

    def block(args):
        q1i, q2i, bi = args
        qpos = bi * Q_BLOCK + jnp.arange(Q_BLOCK, dtype=jnp.int32)
        dist = qpos[:, None] - key_pos[None, :]
        bias = jnp.where(dist[None] >= 0,
                         -slopes[:, None, None] * dist[None].astype(jnp.float32),
                         NEG_INF)
        s1 = jnp.einsum('bhqd,bhkd->bhqk', q1i, k1).astype(jnp.float32) * scale + bias
        s2 = jnp.einsum('bhqd,bhkd->bhqk', q2i, k2).astype(jnp.float32) * scale + bias
        a = jax.nn.softmax(s1, axis=-1) - lam * jax.nn.softmax(s2, axis=-1)
        return jnp.einsum('bhqk,bhkv->bhqv', a.astype(vh.dtype), vh)

    out = lax.map(block, (to_blocks(q1), to_blocks(q2), jnp.arange(nb, dtype=jnp.int32)))
    out = out.transpose(1, 2, 0, 3, 4).reshape(B, N_DIFF_HEADS, S, DIFF_V_DIM)
    out = rmsnorm(out, subln_g) * (1.0 - lam_init)
    return out.transpose(0, 2, 1, 3).reshape(B, S, ATTN_WIDTH)


def pool_mixer(u, pool_w, pool_scale):
    B, S = u.shape[0], u.shape[1]
    ug = u.reshape(B, S, N_POOL_GROUPS, POOL_GROUP_DIM)
    pos = jnp.arange(S, dtype=jnp.int32)
    outs = []
    for gi, w in enumerate(POOL_WINDOWS):
        ch = ug[:, :, gi, :].astype(jnp.float32)
        csum = jnp.pad(jnp.cumsum(ch, axis=1), ((0, 0), (1, 0), (0, 0)))
        lag = jnp.pad(csum, ((0, 0), (w - 1, 0), (0, 0)))[:, :S]
        count = jnp.minimum(pos + 1, w).astype(jnp.float32)
        mean = (csum[:, 1:] - lag) / count[None, :, None]
        outs.append(mean - ch)
    pooled = jnp.stack(outs, axis=2).astype(u.dtype)
    mixed = jnp.einsum('bsgc,gce->bsge', pooled, pool_w)
    return mixed.reshape(B, S, POOL_WIDTH) * pool_scale


def hierarchical_moe(xn, w_coarse, b_coarse, w_fine, b_fine, w_gate, w_up, w_down):
    B, S, D = xn.shape
    T = B * S
    xt = xn.reshape(T, D)
    tok = jnp.arange(T, dtype=jnp.int32)
    coarse = jnp.einsum('td,dg->tg', xt, w_coarse).astype(jnp.float32) + b_coarse.astype(jnp.float32)
    gsel = jnp.argmax(coarse, axis=-1)
    p_group = jax.nn.softmax(coarse, axis=-1)[tok, gsel]
    fine = jnp.einsum('td,gde->tge', xt, w_fine).astype(jnp.float32) + b_fine.astype(jnp.float32)[None]
    fine_sel = fine[tok, gsel]
    top_v, top_i = lax.top_k(fine_sel, TOP_K_FINE)
    wts = jax.nn.softmax(top_v, axis=-1) * p_group[:, None]
    eidx = gsel[:, None] * EXPERTS_PER_GROUP + top_i
    combine = jnp.sum(jax.nn.one_hot(eidx, N_EXPERTS, dtype=jnp.float32) * wts[..., None], axis=1)
    combine = combine.astype(xn.dtype)
    y = jnp.zeros((T, D), dtype=xn.dtype)
    for g in range(N_EXPERT_GROUPS):
        sl = slice(g * EXPERTS_PER_GROUP, (g + 1) * EXPERTS_PER_GROUP)
        hg = jnp.einsum('td,edf->tef', xt, w_gate[sl])
        hu = jnp.einsum('td,edf->tef', xt, w_up[sl])
        h = jax.nn.silu(hg) * hu * combine[:, sl, None]
        y = y + jnp.einsum('tef,efd->td', h, w_down[sl])
    return y.reshape(B, S, D)


def setup_inputs(seed: int = 0) -> dict:
    key = jax.random.key(seed)
    ks = jax.random.split(key, 20)
    f32 = jnp.float32
    L, D = DEPTH, D_MODEL

    def nrm(k, shape, scale):
        return jax.random.normal(k, shape, f32) * scale

    return {
        "x": jax.random.normal(ks[0], (BATCH, SEQ, D), f32),
        "norm1_g": 1.0 + nrm(ks[1], (L, D), 0.02),
        "w_in": nrm(ks[2], (L, D, IN_WIDTH), D ** -0.5),
        "lambda_q1": nrm(ks[3], (L, DIFF_HEAD_DIM), 0.1),
        "lambda_k1": nrm(ks[4], (L, DIFF_HEAD_DIM), 0.1),
        "lambda_q2": nrm(ks[5], (L, DIFF_HEAD_DIM), 0.1),
        "lambda_k2": nrm(ks[6], (L, DIFF_HEAD_DIM), 0.1),
        "subln_g": 1.0 + nrm(ks[7], (L, DIFF_V_DIM), 0.02),
        "pool_w": nrm(ks[8], (L, N_POOL_GROUPS, POOL_GROUP_DIM, POOL_GROUP_DIM), POOL_GROUP_DIM ** -0.5),
        "pool_scale": 1.0 + nrm(ks[9], (L, POOL_WIDTH), 0.1),
        "w_out": nrm(ks[10], (L, MIX_WIDTH, D), MIX_WIDTH ** -0.5),
        "norm2_g": 1.0 + nrm(ks[11], (L, D), 0.02),
        "w_coarse": nrm(ks[12], (L, D, N_EXPERT_GROUPS), D ** -0.5),
        "b_coarse": nrm(ks[13], (L, N_EXPERT_GROUPS), 0.01),
        "w_fine": nrm(ks[14], (L, N_EXPERT_GROUPS, D, EXPERTS_PER_GROUP), D ** -0.5),
        "b_fine": nrm(ks[15], (L, N_EXPERT_GROUPS, EXPERTS_PER_GROUP), 0.01),
        "w_gate": nrm(ks[16], (L, N_EXPERTS, D, D_FF_EXPERT), D ** -0.5),
        "w_up": nrm(ks[17], (L, N_EXPERTS, D, D_FF_EXPERT), D ** -0.5),
        "w_down": nrm(ks[18], (L, N_EXPERTS, D_FF_EXPERT, D), D_FF_EXPERT ** -0.5),
        "final_norm_g": 1.0 + nrm(ks[19], (D,), 0.02),
    }


def reference(x, norm1_g, w_in, lambda_q1, lambda_k1, lambda_q2, lambda_k2, subln_g,
              pool_w, pool_scale, w_out, norm2_g, w_coarse, b_coarse, w_fine, b_fine,
              w_gate, w_up, w_down, final_norm_g):
    B, S, D = x.shape
    h = x
    for l in range(DEPTH):
        lam_init = 0.8 - 0.6 * math.exp(-0.3 * l)
        xn = rmsnorm(h, norm1_g[l])
        proj = jnp.einsum('bsd,de->bse', xn, w_in[l])
        q = proj[..., :ATTN_WIDTH].reshape(B, S, N_DIFF_HEADS, 2, DIFF_HEAD_DIM)
        k = proj[..., ATTN_WIDTH:2 * ATTN_WIDTH].reshape(B, S, N_DIFF_HEADS, 2, DIFF_HEAD_DIM)
        v = proj[..., 2 * ATTN_WIDTH:3 * ATTN_WIDTH].reshape(B, S, N_DIFF_HEADS, DIFF_V_DIM)
        u = proj[..., 3 * ATTN_WIDTH:]
        lam = (jnp.exp(jnp.sum(lambda_q1[l].astype(jnp.float32) * lambda_k1[l].astype(jnp.float32)))
               - jnp.exp(jnp.sum(lambda_q2[l].astype(jnp.float32) * lambda_k2[l].astype(jnp.float32)))
               + lam_init)
        attn_out = diff_attention(q, k, v, lam, subln_g[l], lam_init)
        pool_out = pool_mixer(u, pool_w[l], pool_scale[l])
        mixed = jnp.concatenate([attn_out, pool_out], axis=-1)
        h = h + jnp.einsum('bsm,md->bsd', mixed, w_out[l])
        hn = rmsnorm(h, norm2_g[l])
        h = h + hierarchical_moe(hn, w_coarse[l], b_coarse[l], w_fine[l], b_fine[l],
                                 w_gate[l], w_up[l], w_down[l])
    return rmsnorm(h, final_norm_g)
```

```cpp
#include <hip/hip_runtime.h>
#include <hip/hip_bf16.h>
#include <cstdio>
#include <cstdint>

#ifndef MK_N_LAUNCHES
#define MK_N_LAUNCHES 1
#endif

#define GAS __attribute__((address_space(1)))
#define LAS __attribute__((address_space(3)))
typedef unsigned short bf16;
typedef unsigned v4u __attribute__((ext_vector_type(4)));
typedef unsigned v2u __attribute__((ext_vector_type(2)));
typedef float f32x4 __attribute__((ext_vector_type(4)));
typedef float f32x2 __attribute__((ext_vector_type(2)));
typedef float f32x16 __attribute__((ext_vector_type(16)));
typedef short bf16x8 __attribute__((ext_vector_type(8)));
typedef short s16x4 __attribute__((ext_vector_type(4)));
typedef GAS unsigned gu32;
#define RLX_AGENT __ATOMIC_RELAXED, __HIP_MEMORY_SCOPE_AGENT
#define LDS_WAIT() asm volatile("s_waitcnt lgkmcnt(0)" ::: "memory")
#define VM_WAIT() asm volatile("s_waitcnt vmcnt(0)" ::: "memory")

constexpr int T = 8192, SEQ = 2048, D = 2048, INW = 4096, AW = 1024, NH = 8, NE = 32, FF = 512;
constexpr float RMS_EPS = 1e-6f;
constexpr float LOG2E = 1.4426950408889634f;
constexpr float C2 = 0.125f * LOG2E;

constexpr size_t MiB = 1u << 20;
constexpr size_t WS_CTL = 0, CTL_ZERO_BYTES = 1 * MiB;
constexpr size_t WS_WFRAG = 1 * MiB;
constexpr size_t WS_BT2 = 1 * MiB + 512 * 1024;
constexpr size_t WS_WIN = 2 * MiB;
constexpr size_t WS_WOUT = 18 * MiB;
constexpr size_t WS_WOUT2 = 26 * MiB;
constexpr size_t WS_TOK = 34 * MiB;
constexpr size_t WS_SW = 35 * MiB;
constexpr size_t WS_WGU = 40 * MiB;
constexpr size_t WS_WD = 168 * MiB;
constexpr size_t WS_XN = 232 * MiB;
constexpr size_t WS_HMID = 232 * MiB;
constexpr size_t WS_Q = 264 * MiB, WS_K = 280 * MiB, WS_V = 296 * MiB, WS_U = 312 * MiB;
constexpr size_t WS_Y = 264 * MiB;
constexpr size_t WS_A3 = 328 * MiB;
constexpr size_t WS_HB = 360 * MiB;
constexpr size_t WS_END = 392 * MiB;
constexpr int CW_CNT = 1024;
constexpr int CW_BAR = 4096;

constexpr int RING_BYTES = 131072;
constexpr int WSF_OFF = RING_BYTES;
constexpr int TAB_OFF = WSF_OFF + 2048;
constexpr int MISC_OFF = TAB_OFF + 512;
constexpr int LDS_BYTES = 147456;

namespace pg8 {
#define PG8_LAS __attribute__((address_space(3)))
typedef unsigned short bf16_t;
typedef unsigned u32x4 __attribute__((ext_vector_type(4)));
constexpr int BM = 256, BK = 64, HALF = 128, HTB = HALF * BK * 2, STAGE_BYTES = 8 * HTB, NXCD = 8, WGM = 8;

__host__ __device__ __forceinline__ int lds_byte(int r, int c) { const int st = (r >> 4) * 2 + (c >> 5), rr = r & 15, cc = c & 31, ob = rr * 64 + cc * 2; return st * 1024 + (ob ^ (((ob >> 9) & 1) << 5)); }
__host__ __device__ __forceinline__ void stage_rc(int b, int& R, int& C) { const int st = b / 1024, sb = b % 1024, swz = sb ^ (((sb >> 9) & 1) << 5); R = (st >> 1) * 16 + swz / 64; C = (st & 1) * 32 + (swz % 64) / 2; }
__host__ __device__ __forceinline__ int perm32(int rho) { const int n = rho >> 4, i = rho & 15; return 8 * (i >> 2) + 4 * n + (i & 3); }

struct Unit { const char* a; const char* b; int orow, ocol, e, s0, cnt; };

__device__ __forceinline__ unsigned cvt_pk_bf16(float lo, float hi) { unsigned r; asm volatile("v_cvt_pk_bf16_f32 %0, %1, %2" : "=v"(r) : "v"(lo), "v"(hi)); return r; }

struct DenseOrder {
    int nM, nN, nwg, G, c; const char* A; const char* Bt; size_t tsA, tsB;
    __device__ void init(int M, int N, int G_, int c_, const void* A_, const void* Bt_, int lda, int ldb) { nM = M / BM; nN = N / BM; nwg = nM * nN; G = G_; c = c_; A = (const char*)A_; Bt = (const char*)Bt_; tsA = (size_t)BM * lda * 2; tsB = (size_t)BM * ldb * 2; }
    __device__ bool next(int i, Unit& u) const {
        const long L = (long)i * G + c; if (L >= nwg) return false;
        int wgid = (int)L; { const int q = nwg / NXCD, r = nwg % NXCD, xcd = wgid % NXCD, off = wgid / NXCD; wgid = (xcd < r ? xcd * (q + 1) : r * (q + 1) + (xcd - r) * q) + off; }
        const int nig = WGM * nN, gid = wgid / nig, fm = gid * WGM, gsz = (nM - fm) < WGM ? (nM - fm) : WGM;
        const int pm = fm + ((wgid % nig) % gsz), pn = (wgid % nig) / gsz;
        u.a = A + (size_t)pm * tsA; u.b = Bt + (size_t)pn * tsB; u.orow = pm * BM; u.ocol = pn * BM; u.e = 0; u.s0 = 0; u.cnt = 0; return true;
    }
    __device__ __forceinline__ unsigned row_off(const Unit&, int) const { return 0u; }
};

template <class Epi, class Sched, bool ALIGN_EPI, bool GATHER>
__device__ __forceinline__ void gemm_phase(PG8_LAS unsigned char* lds, const int nt, const int lda, const int ldb, const Sched& S, const Epi& E) {
    const int tid = threadIdx.x, wid = __builtin_amdgcn_readfirstlane(tid >> 6), lane = tid & 63, wr = wid >> 2, wc = wid & 3, fr = lane & 15, fq = lane >> 4;
    unsigned voffA[2], voffB[2]; int rA[2]; unsigned cA2[2];
#pragma unroll
    for (int i = 0; i < 2; ++i) { int R, C; stage_rc(tid * 16 + i * 8192, R, C); const int Rb = Epi::PERM ? ((R & ~31) + perm32(R & 31)) : R;
        voffA[i] = (unsigned)(R * lda + C) * 2u; voffB[i] = (unsigned)(Rb * ldb + C) * 2u; rA[i] = R; cA2[i] = (unsigned)C * 2u; }
    const size_t kstep = (size_t)(BK * 2);
    const size_t hstepA = (size_t)HALF * lda * 2, hstepB = (size_t)HALF * ldb * 2;
    const unsigned ldsw = (unsigned)wid * 1024u;
    const int aoff = lds_byte(wr * 64 + fr, fq * 8), boff = lds_byte(wc * 32 + fr, fq * 8);
#define PG8_SA(b, h) (((b) * 2 + (h)) * HTB)
#define PG8_SB(b, h) ((4 + (b) * 2 + (h)) * HTB)
#define PG8_STAGE_O(bufoff, gbase, o0, o1) do { \
        __builtin_amdgcn_global_load_lds((const unsigned*)((const char*)(gbase) + (o0)), (PG8_LAS unsigned*)(lds + (bufoff) + ldsw), 16, 0, 0); \
        __builtin_amdgcn_global_load_lds((const unsigned*)((const char*)(gbase) + (o1)), (PG8_LAS unsigned*)(lds + (bufoff) + ldsw + 8192), 16, 0, 0); } while (0)
#define PG8_STB(b, h, bptr) PG8_STAGE_O(PG8_SB(b, h), (bptr) + (h) * hstepB, voffB[0], voffB[1])
#define PG8_STA(b, h, aptr, O) do { if constexpr (GATHER) { PG8_STAGE_O(PG8_SA(b, h), (aptr), O[h][0], O[h][1]); } else { PG8_STAGE_O(PG8_SA(b, h), (aptr) + (h) * hstepA, voffA[0], voffA[1]); } } while (0)
#define PG8_LDA(dst, b, h) do { _Pragma("unroll") for (int m = 0; m < 4; ++m) _Pragma("unroll") for (int k = 0; k < 2; ++k) dst[m][k] = *(const PG8_LAS bf16x8*)(lds + PG8_SA(b, h) + aoff + m * 2048 + k * 1024); } while (0)
#define PG8_LDB(dst, b, h) do { _Pragma("unroll") for (int n = 0; n < 2; ++n) _Pragma("unroll") for (int k = 0; k < 2; ++k) dst[n][k] = *(const PG8_LAS bf16x8*)(lds + PG8_SB(b, h) + boff + n * 2048 + k * 1024); } while (0)
#define PG8_MMA(ai, bj, At, Bt) do { __builtin_amdgcn_s_setprio(1); _Pragma("unroll") for (int m = 0; m < 4; ++m) _Pragma("unroll") for (int n = 0; n < 2; ++n) _Pragma("unroll") for (int k = 0; k < 2; ++k) \
        acc[ai][bj][m][n] = __builtin_amdgcn_mfma_f32_16x16x32_bf16(Bt[n][k], At[m][k], acc[ai][bj][m][n], 0, 0, 0); __builtin_amdgcn_s_setprio(0); } while (0)
#define PG8_WAIT_V(n) asm volatile("s_waitcnt vmcnt(" #n ")" ::: "memory")
#define PG8_WAIT_L(n) asm volatile("s_waitcnt lgkmcnt(" #n ")" ::: "memory")
#define PG8_BAR __builtin_amdgcn_s_barrier()
#define PG8_SCHED __builtin_amdgcn_sched_barrier(0)
#define PG8_FETCH(u, O) do { _Pragma("unroll") for (int h_ = 0; h_ < 2; ++h_) _Pragma("unroll") for (int i_ = 0; i_ < 2; ++i_) O[h_][i_] = S.row_off(u, h_ * HALF + rA[i_]) + cA2[i_]; } while (0)
    Unit cur, nxt; int ui = 0;
    if (!S.next(0, cur)) return;
    f32x4 acc[2][2][4][2];
#pragma unroll
    for (int a = 0; a < 2; ++a)
#pragma unroll
        for (int b = 0; b < 2; ++b)
#pragma unroll
            for (int m = 0; m < 4; ++m)
#pragma unroll
                for (int n = 0; n < 2; ++n) acc[a][b][m][n] = (f32x4){0.f, 0.f, 0.f, 0.f};
    bf16x8 At[4][2], B0[2][2], B1[2][2];
    unsigned oC[2][2] = {{0u, 0u}, {0u, 0u}}, oN[2][2] = {{0u, 0u}, {0u, 0u}}, o2[2][2] = {{0u, 0u}, {0u, 0u}};
    if constexpr (GATHER) { PG8_FETCH(cur, oC); }
    const char* cA = cur.a; const char* cB = cur.b;
    PG8_STB(0, 0, cB); PG8_STB(0, 1, cB); PG8_STA(0, 0, cA, oC); PG8_STA(0, 1, cA, oC);
    if (wr == 1) PG8_BAR;
    PG8_WAIT_V(2); PG8_BAR;
    PG8_STB(1, 0, cB + kstep); PG8_STA(1, 0, cA + kstep, oC); PG8_STB(1, 1, cB + kstep);
    PG8_WAIT_V(6); PG8_BAR;
    for (;;) {
        const bool has_next = S.next(ui + 1, nxt);
        const char* nA = has_next ? nxt.a : cA; const char* nB = has_next ? nxt.b : cB;
        if constexpr (GATHER) { if (has_next) { PG8_FETCH(nxt, oN); } else {
#pragma unroll
            for (int h_ = 0; h_ < 2; ++h_)
#pragma unroll
                for (int i_ = 0; i_ < 2; ++i_) oN[h_][i_] = oC[h_][i_]; } }
        for (int t = 0; t < nt; t += 2) {
            const bool last = (t == nt - 2);
            const char* a1 = cA + (size_t)(t + 1) * kstep;
            const char* a2 = last ? nA : cA + (size_t)(t + 2) * kstep; const char* b2 = last ? nB : cB + (size_t)(t + 2) * kstep;
            const char* a3 = a2 + kstep; const char* b3 = b2 + kstep;
            if constexpr (GATHER) {
#pragma unroll
                for (int h_ = 0; h_ < 2; ++h_)
#pragma unroll
                    for (int i_ = 0; i_ < 2; ++i_) o2[h_][i_] = last ? oN[h_][i_] : oC[h_][i_]; }
            PG8_LDB(B0, 0, 0); PG8_LDB(B1, 0, 1); PG8_SCHED; PG8_LDA(At, 0, 0); PG8_STA(1, 1, a1, oC);
            PG8_WAIT_V(8); PG8_WAIT_L(0); PG8_BAR; PG8_MMA(0, 0, At, B0); PG8_MMA(0, 1, At, B1); PG8_BAR; PG8_SCHED;
            PG8_LDA(At, 0, 1); PG8_STB(0, 0, b2); PG8_STB(0, 1, b2); PG8_STA(0, 0, a2, o2);
            PG8_WAIT_V(8); PG8_WAIT_L(0); PG8_BAR; PG8_MMA(1, 0, At, B0); PG8_MMA(1, 1, At, B1); PG8_BAR; PG8_SCHED;
            PG8_LDB(B0, 1, 0); PG8_LDB(B1, 1, 1); PG8_SCHED; PG8_LDA(At, 1, 0); PG8_STA(0, 1, a2, o2);
            PG8_WAIT_V(8); PG8_WAIT_L(0); PG8_BAR; PG8_MMA(0, 0, At, B0); PG8_MMA(0, 1, At, B1); PG8_BAR; PG8_SCHED;
            PG8_LDA(At, 1, 1); PG8_STB(1, 0, b3); PG8_STB(1, 1, b3); PG8_STA(1, 0, a3, o2);
            PG8_WAIT_V(8); PG8_WAIT_L(0); PG8_BAR; PG8_MMA(1, 0, At, B0); PG8_MMA(1, 1, At, B1); PG8_BAR; PG8_SCHED;
        }
        if constexpr (ALIGN_EPI) { if (wr == 0) PG8_BAR; }
        E(acc, cur, wr, wc, fr, fq);
        if (!has_next) break;
#pragma unroll
        for (int a = 0; a < 2; ++a)
#pragma unroll
            for (int b = 0; b < 2; ++b)
#pragma unroll
                for (int m = 0; m < 4; ++m)
#pragma unroll
                    for (int n = 0; n < 2; ++n) acc[a][b][m][n] = (f32x4){0.f, 0.f, 0.f, 0.f};
        cur = nxt; cA = nA; cB = nB; ++ui;
        if constexpr (GATHER) {
#pragma unroll
            for (int h_ = 0; h_ < 2; ++h_)
#pragma unroll
                for (int i_ = 0; i_ < 2; ++i_) oC[h_][i_] = oN[h_][i_]; }
        if constexpr (ALIGN_EPI) { if (wr == 1) PG8_BAR; }
    }
    PG8_WAIT_V(0);
    if constexpr (!ALIGN_EPI) { if (wr == 0) PG8_BAR; }
    PG8_BAR;
#undef PG8_SA
#undef PG8_SB
#undef PG8_STAGE_O
#undef PG8_STB
#undef PG8_STA
#undef PG8_LDA
#undef PG8_LDB
#undef PG8_MMA
#undef PG8_WAIT_V
#undef PG8_WAIT_L
#undef PG8_BAR
#undef PG8_SCHED
#undef PG8_FETCH
}

struct EpiStoreBf16 {
    static constexpr bool PERM = true;
    bf16_t* O; int ldc; int split_cols; size_t split_stride; float scale0;
    __device__ __forceinline__ void operator()(const f32x4 (&acc)[2][2][4][2], const Unit& u, int wr, int wc, int fr, int fq) const {
        const int row0 = u.orow + wr * 64 + fr; int colt = u.ocol; bf16_t* base = O;
        float sc = 1.f; if (split_cols) { const int t = colt / split_cols; base += (size_t)t * split_stride; colt -= t * split_cols; if (t == 0) sc = scale0; }
        const int col0 = colt + wc * 32 + 8 * fq;
#pragma unroll
        for (int ai = 0; ai < 2; ++ai)
#pragma unroll
            for (int m = 0; m < 4; ++m) { bf16_t* rowp = base + (size_t)(row0 + ai * HALF + m * 16) * ldc + col0;
#pragma unroll
                for (int bj = 0; bj < 2; ++bj) { const f32x4 v0 = acc[ai][bj][m][0] * sc, v1 = acc[ai][bj][m][1] * sc;
                    u32x4 w; w.x = cvt_pk_bf16(v0[0], v0[1]); w.y = cvt_pk_bf16(v0[2], v0[3]); w.z = cvt_pk_bf16(v1[0], v1[1]); w.w = cvt_pk_bf16(v1[2], v1[3]);
                    *(u32x4*)(rowp + bj * HALF) = w; } }
    }
};
struct EpiResid {
    static constexpr bool PERM = false;
    const float* x; float* out; bf16_t* hb;
    __device__ __forceinline__ void operator()(const f32x4 (&acc)[2][2][4][2], const Unit& u, int wr, int wc, int fr, int fq) const {
        const int row0 = u.orow + wr * 64 + fr, col0 = u.ocol + wc * 32 + 4 * fq;
#pragma unroll
        for (int ai = 0; ai < 2; ++ai)
#pragma unroll
            for (int m = 0; m < 4; ++m) { const size_t off = (size_t)(row0 + ai * HALF + m * 16) * D + col0;
#pragma unroll
                for (int bj = 0; bj < 2; ++bj)
#pragma unroll
                    for (int n = 0; n < 2; ++n) { const size_t o = off + bj * HALF + n * 16; const f32x4 xv = *(const f32x4*)(x + o); const f32x4 hv = xv + acc[ai][bj][m][n];
                        *(f32x4*)(out + o) = hv; v2u w; w.x = cvt_pk_bf16(hv[0], hv[1]); w.y = cvt_pk_bf16(hv[2], hv[3]); *(v2u*)(hb + o) = w; } }
    }
};
struct EpiGateUp {
    static constexpr bool PERM = true;
    bf16_t* hmid; const f32x2* sw;
    __device__ __forceinline__ void operator()(const f32x4 (&acc)[2][2][4][2], const Unit& u, int wr, int wc, int fr, int fq) const {
        const int col0 = u.ocol + wc * 32 + 8 * fq;
#pragma unroll
        for (int ai = 0; ai < 2; ++ai)
#pragma unroll
            for (int m = 0; m < 4; ++m) { const int r = ai * HALF + wr * 64 + m * 16 + fr; const int slot = u.s0 + r; const bool valid = slot < u.cnt;
                f32x2 rw = (f32x2){0.f, 0.f}; if (valid) rw = sw[(size_t)u.e * 8192 + slot];
                float hv[8];
#pragma unroll
                for (int n = 0; n < 2; ++n)
#pragma unroll
                    for (int j = 0; j < 4; ++j) { const float g = acc[ai][0][m][n][j] * rw.x, up = acc[ai][1][m][n][j] * rw.x;
                        const float e = __builtin_amdgcn_exp2f(-g * LOG2E); const float s = g * __builtin_amdgcn_rcpf(1.0f + e); hv[n * 4 + j] = valid ? s * up * rw.y : 0.f; }
                u32x4 w; w.x = cvt_pk_bf16(hv[0], hv[1]); w.y = cvt_pk_bf16(hv[2], hv[3]); w.z = cvt_pk_bf16(hv[4], hv[5]); w.w = cvt_pk_bf16(hv[6], hv[7]);
                *(u32x4*)(hmid + (size_t)(u.orow + r) * FF + col0) = w; }
    }
};
struct EpiDown {
    static constexpr bool PERM = true;
    bf16_t* y; const unsigned* tok;
    __device__ __forceinline__ void operator()(const f32x4 (&acc)[2][2][4][2], const Unit& u, int wr, int wc, int fr, int fq) const {
        const int col0 = u.ocol + wc * 32 + 8 * fq;
#pragma unroll
        for (int ai = 0; ai < 2; ++ai)
#pragma unroll
            for (int m = 0; m < 4; ++m) { const int r = ai * HALF + wr * 64 + m * 16 + fr; const int slot = u.s0 + r;
                if (slot < u.cnt) { const unsigned ti = tok[(size_t)u.e * 8192 + slot]; const unsigned token = ti & 0xffffu, ks = ti >> 16;
                    bf16_t* rowp = y + ((size_t)ks * T + token) * D + col0;
#pragma unroll
                    for (int bj = 0; bj < 2; ++bj) { const f32x4 v0 = acc[ai][bj][m][0], v1 = acc[ai][bj][m][1];
                        u32x4 w; w.x = cvt_pk_bf16(v0[0], v0[1]); w.y = cvt_pk_bf16(v0[2], v0[3]); w.z = cvt_pk_bf16(v1[0], v1[1]); w.w = cvt_pk_bf16(v1[2], v1[3]);
                        *(u32x4*)(rowp + bj * HALF) = w; } } }
    }
};
struct W2Order {
    int G, c; const char* A; const char* Bt;
    __device__ bool next(int i, Unit& u) const { const int L = i * G + c; if (L >= 32) return false; const int g = L & 3, dt = L >> 2;
        u.a = A + ((size_t)dt * 256 * D + 1024 + 256 * g) * 2; u.b = Bt + (size_t)g * 65536 * 2; u.orow = dt * 256; u.ocol = 1024 + 256 * g; u.e = 0; u.s0 = 0; u.cnt = 0; return true; }
    __device__ __forceinline__ unsigned row_off(const Unit&, int) const { return 0u; }
};
template <int NPN, bool UP> struct MoeOrder {
    int G, c; const PG8_LAS int* tab; const char* A; const char* W; const unsigned* tok;
    __device__ bool next(int i, Unit& u) const {
        const int total = __builtin_amdgcn_readfirstlane(tab[32]) * NPN; const int L = i * G + c; if (L >= total) return false;
        const int Tt = L / NPN, pn = L % NPN; int e = 0;
        for (int k = 1; k < 32; ++k) e = (tab[k] <= Tt) ? k : e;
        e = __builtin_amdgcn_readfirstlane(e);
        const int mt = Tt - __builtin_amdgcn_readfirstlane(tab[e]);
        u.e = e; u.s0 = mt * 256; u.cnt = __builtin_amdgcn_readfirstlane(tab[40 + e]); u.orow = Tt * 256;
        if (UP) { u.a = A; u.b = W + ((size_t)(e * 4 + pn) * 256) * D * 2; u.ocol = pn * 128; }
        else { u.a = A + (size_t)Tt * 256 * FF * 2; u.b = W + ((size_t)e * D + pn * 256) * FF * 2; u.ocol = pn * 256; }
        return true;
    }
    __device__ __forceinline__ unsigned row_off(const Unit& u, int R) const {
        const int slot = u.s0 + R; unsigned token = 0u; if (slot < u.cnt) token = tok[(size_t)u.e * 8192 + slot] & 0xffffu; return token * (unsigned)(D * 2);
    }
};
}

namespace att {
constexpr int PITCH = 1024, QB = 128, KVB = 64, BUFB = 32768;
__device__ __forceinline__ int crow(int r, int hi) { return (r & 3) + 8 * (r >> 2) + 4 * hi; }
__device__ __forceinline__ unsigned cvtpk(float lo, float hi) { unsigned r; asm volatile("v_cvt_pk_bf16_f32 %0, %1, %2" : "=v"(r) : "v"(lo), "v"(hi)); return r; }
typedef short v4i16_t __attribute__((ext_vector_type(4)));
__device__ __forceinline__ s16x4 vtr(const LAS char* p) { return __builtin_bit_cast(s16x4, __builtin_amdgcn_ds_read_tr16_b64_v4i16((LAS v4i16_t*)p)); }
__device__ __forceinline__ float hswap_max(float m) { auto rr = __builtin_amdgcn_permlane32_swap(__float_as_uint(m), __float_as_uint(m), false, false); return fmaxf(__uint_as_float(rr[0]), __uint_as_float(rr[1])); }
__device__ __forceinline__ float hswap_sum(float m) { auto rr = __builtin_amdgcn_permlane32_swap(__float_as_uint(m), __float_as_uint(m), false, false); return __uint_as_float(rr[0]) + __uint_as_float(rr[1]); }

__device__ __forceinline__ void attn_unit(int b, int h, int qb, const bf16* Q, const bf16* K, const bf16* V, bf16* A3, const float* subg, float lam, LAS unsigned char* lds, LAS float* wsf_all) {
    const int tid = threadIdx.x, lane = tid & 63, r32 = lane & 31, hi = lane >> 5; const int wid = __builtin_amdgcn_readfirstlane(tid >> 6);
    const int jm = wid >> 2, rg = wid & 3;
    const long rowbase = (long)b * SEQ; const int q0 = qb * QB, qmin = q0 + 32 * rg, qmax = qmin + 31;
    const float slope2 = exp2f(-(float)(h + 1)) * LOG2E;
    LAS float* wsf = wsf_all + wid * 64;
    const bf16* Kh = K + rowbase * PITCH + h * 128; const bf16* Vh = V + rowbase * PITCH + h * 128;
    const int NT = (q0 + QB) / KVB;
    const bf16* ksrc = Kh + (long)lane * PITCH + wid * 8;
    const bf16* vsrc = Vh + (long)(16 * (wid & 3) + (lane >> 2)) * PITCH + (wid >> 2) * 32 + (lane & 3) * 8;
#define ATT_DMA(t, bsel) do { const long to_ = (long)(t) * KVB * PITCH; LAS unsigned char* bb_ = lds + (bsel) * BUFB; \
        __builtin_amdgcn_global_load_lds((const unsigned*)(ksrc + to_), (LAS unsigned*)(bb_ + wid * 1024), 16, 0, 0); \
        __builtin_amdgcn_global_load_lds((const unsigned*)(ksrc + to_ + 64), (LAS unsigned*)(bb_ + 8192 + wid * 1024), 16, 0, 0); \
        __builtin_amdgcn_global_load_lds((const unsigned*)(vsrc + to_), (LAS unsigned*)(bb_ + 16384 + (wid >> 2) * 4096 + (wid & 3) * 1024), 16, 0, 0); \
        __builtin_amdgcn_global_load_lds((const unsigned*)(vsrc + to_ + 64), (LAS unsigned*)(bb_ + 16384 + (2 + (wid >> 2)) * 4096 + (wid & 3) * 1024), 16, 0, 0); } while (0)
    ATT_DMA(0, 0);
    const bf16* Qw = Q + (rowbase + qmin) * PITCH + h * 128 + jm * 64;
    bf16x8 qr[4];
#pragma unroll
    for (int d0 = 0; d0 < 4; ++d0) qr[d0] = *(const bf16x8*)(Qw + (long)r32 * PITCH + d0 * 16 + hi * 8);
    float bias0[16];
#pragma unroll
    for (int r = 0; r < 16; ++r) bias0[r] = slope2 * (float)(crow(r, hi) - r32);
    const float s32 = 32.f * slope2;
    float mrow = -INFINITY, lsum = 0.f;
    f32x16 o[4];
#pragma unroll
    for (int d0 = 0; d0 < 4; ++d0)
#pragma unroll
        for (int r = 0; r < 16; ++r) o[d0][r] = 0.f;
    for (int t = 0; t < NT; ++t) {
        VM_WAIT(); __syncthreads();
        if (t + 1 < NT) ATT_DMA(t + 1, (t + 1) & 1);
        if (KVB * t <= qmax) {
            const LAS unsigned char* bb = lds + (t & 1) * BUFB;
            const LAS unsigned char* kb = bb + jm * 8192 + hi * 1024 + r32 * 16;
            f32x16 p0, p1;
#pragma unroll
            for (int r = 0; r < 16; ++r) { p0[r] = 0.f; p1[r] = 0.f; }
#pragma unroll
            for (int d0 = 0; d0 < 4; ++d0) {
                const bf16x8 k0 = *(const LAS bf16x8*)(kb + d0 * 2048), k1 = *(const LAS bf16x8*)(kb + d0 * 2048 + 512);
                p0 = __builtin_amdgcn_mfma_f32_32x32x16_bf16(k0, qr[d0], p0, 0, 0, 0);
                p1 = __builtin_amdgcn_mfma_f32_32x32x16_bf16(k1, qr[d0], p1, 0, 0, 0);
            }
#pragma unroll
            for (int r = 0; r < 16; ++r) { p0[r] += bias0[r]; p1[r] += bias0[r]; }
            if (KVB * t + 63 > qmin) {
                const int dq = qmin + r32 - KVB * t - 4 * hi;
#pragma unroll
                for (int r = 0; r < 16; ++r) { const int kk = (r & 3) + 8 * (r >> 2); if (kk > dq) p0[r] = -INFINITY; if (kk + 32 > dq) p1[r] = -INFINITY; }
            }
            const float tb = slope2 * (float)(KVB * t - qmin);
            float m0 = p0[0], m1 = p1[0];
#pragma unroll
            for (int r = 1; r < 16; ++r) { m0 = fmaxf(m0, p0[r]); m1 = fmaxf(m1, p1[r]); }
            float rmt = fmaxf(m0, m1 + s32) + tb; rmt = hswap_max(rmt);
            const float mnew = fmaxf(mrow, rmt);
            const float alpha = __builtin_amdgcn_exp2f(mrow - mnew);
            mrow = mnew;
            const float e0 = mnew - tb, e1 = e0 - s32;
            float sacc = 0.f;
#pragma unroll
            for (int r = 0; r < 16; ++r) { p0[r] = __builtin_amdgcn_exp2f(p0[r] - e0); p1[r] = __builtin_amdgcn_exp2f(p1[r] - e1); sacc += p0[r] + p1[r]; }
            lsum = lsum * alpha + sacc;
            if (!__all(alpha == 1.0f)) {
                if (hi == 0) wsf[r32] = alpha;
                LDS_WAIT();
                float al[16];
#pragma unroll
                for (int r = 0; r < 16; ++r) al[r] = wsf[crow(r, hi)];
#pragma unroll
                for (int d0 = 0; d0 < 4; ++d0)
#pragma unroll
                    for (int r = 0; r < 16; ++r) o[d0][r] *= al[r];
            }
            v4u pw[4];
            pw[0] = (v4u){cvtpk(p0[0], p0[1]), cvtpk(p0[2], p0[3]), cvtpk(p0[4], p0[5]), cvtpk(p0[6], p0[7])};
            pw[1] = (v4u){cvtpk(p0[8], p0[9]), cvtpk(p0[10], p0[11]), cvtpk(p0[12], p0[13]), cvtpk(p0[14], p0[15])};
            pw[2] = (v4u){cvtpk(p1[0], p1[1]), cvtpk(p1[2], p1[3]), cvtpk(p1[4], p1[5]), cvtpk(p1[6], p1[7])};
            pw[3] = (v4u){cvtpk(p1[8], p1[9]), cvtpk(p1[10], p1[11]), cvtpk(p1[12], p1[13]), cvtpk(p1[14], p1[15])};
            const LAS char* vb = (const LAS char*)(bb + 16384) + ((lane >> 4) & 1) * 32 + (lane & 3) * 8 + (4 * hi + ((lane & 15) >> 2)) * 64;
#pragma unroll
            for (int d0 = 0; d0 < 4; ++d0) {
#pragma unroll
                for (int ks = 0; ks < 4; ++ks) {
                    const s16x4 lo = vtr(vb + d0 * 4096 + ks * 1024), hh = vtr(vb + d0 * 4096 + ks * 1024 + 512);
                    const bf16x8 vf = (bf16x8){lo[0], lo[1], lo[2], lo[3], hh[0], hh[1], hh[2], hh[3]};
                    o[d0] = __builtin_amdgcn_mfma_f32_32x32x16_bf16(__builtin_bit_cast(bf16x8, pw[ks]), vf, o[d0], 0, 0, 0);
                }
            }
        }
    }
#undef ATT_DMA
    lsum = hswap_sum(lsum);
    if (hi == 0) wsf[r32] = __builtin_amdgcn_rcpf(lsum);
    LDS_WAIT();
    {
        float rl[16];
#pragma unroll
        for (int r = 0; r < 16; ++r) rl[r] = wsf[crow(r, hi)];
#pragma unroll
        for (int d0 = 0; d0 < 4; ++d0)
#pragma unroll
            for (int r = 0; r < 16; ++r) o[d0][r] *= rl[r];
    }
    __syncthreads();
    LAS float* X = (LAS float*)lds + rg * 4096;
    if (jm == 1) {
#pragma unroll
        for (int d0 = 0; d0 < 4; ++d0)
#pragma unroll
            for (int r = 0; r < 16; ++r) X[(d0 * 16 + r) * 64 + lane] = o[d0][r];
    }
    __syncthreads();
    if (jm == 0) {
        float ss[16];
#pragma unroll
        for (int r = 0; r < 16; ++r) ss[r] = 0.f;
#pragma unroll
        for (int d0 = 0; d0 < 4; ++d0)
#pragma unroll
            for (int r = 0; r < 16; ++r) { const float dv = o[d0][r] - lam * X[(d0 * 16 + r) * 64 + lane]; o[d0][r] = dv; ss[r] += dv * dv; }
#pragma unroll
        for (int r = 0; r < 16; ++r) {
#pragma unroll
            for (int off = 1; off < 32; off <<= 1) ss[r] += __shfl_xor(ss[r], off);
            ss[r] = rsqrtf(ss[r] * (1.0f / 128.0f) + RMS_EPS) * 0.8f;
        }
        bf16* Ow = A3 + (rowbase + qmin) * D + h * 128 + r32;
#pragma unroll
        for (int d0 = 0; d0 < 4; ++d0) { const float gg = subg[d0 * 32 + r32];
#pragma unroll
            for (int r = 0; r < 16; ++r) { const float v = o[d0][r] * ss[r] * gg; const unsigned pk = cvtpk(v, v); Ow[(long)crow(r, hi) * D + d0 * 32] = (bf16)(pk & 0xffffu); } }
    }
    __syncthreads();
}
}

#define XB_TMO      128
#define XB_XCNT(j)  (256  + 64 * (j))
#define XB_XSUB(j)  (1280 + 64 * (j))
#define XB_XGEN(j)  (2304 + 64 * (j))
#define XB_TOP      3328
#define XB_TOPGEN   3392
#define XCD_BAR_WORDS 3456
#define XB_SPIN_CAP (1u << 18)

__device__ __forceinline__ unsigned xb_ld(unsigned* p)              { return __hip_atomic_load(p, __ATOMIC_RELAXED, __HIP_MEMORY_SCOPE_AGENT); }
__device__ __forceinline__ unsigned xb_add(unsigned* p, unsigned v) { return __hip_atomic_fetch_add(p, v, __ATOMIC_RELAXED, __HIP_MEMORY_SCOPE_AGENT); }
__device__ __forceinline__ unsigned xb_xcc_id() { return (unsigned)__builtin_amdgcn_s_getreg((3 << 11) | 20) & 0xFu; }
#define XB_SPIN(cond, bar) do { unsigned _sp = 0; while (cond) { __builtin_amdgcn_s_sleep(1); \
    if ((++_sp & 255u) == 0u) { if (xb_ld(&(bar)[XB_TMO])) break; if (_sp > XB_SPIN_CAP) { atomicAdd(&(bar)[XB_TMO], 1u); break; } } } } while (0)

struct XcdBarrier { unsigned* bar; unsigned x; volatile LAS unsigned* st; };

__device__ __forceinline__ XcdBarrier xcd_barrier_post(unsigned* bar, volatile LAS unsigned* st) {
    XcdBarrier b; b.bar = bar; b.x = xb_xcc_id(); b.st = st;
    if (threadIdx.x == 0) (void)xb_add(&bar[XB_XCNT(b.x)], 1u);
    return b;
}
__device__ __forceinline__ void xcd_barrier_complete(unsigned* bar, unsigned x, unsigned& nloc, unsigned& nx) {
    const unsigned G = gridDim.x * gridDim.y * gridDim.z;
    unsigned sum, cnt, mine, sp = 0u;
    for (;;) {
        sum = 0u; cnt = 0u; mine = 0u;
#pragma unroll
        for (unsigned j = 0; j < 16; ++j) { const unsigned c = xb_ld(&bar[XB_XCNT(j)]); sum += c; cnt += (c > 0u) ? 1u : 0u; mine = (j == x) ? c : mine; }
        if (sum == G) break;
        __builtin_amdgcn_s_sleep(1);
        if ((++sp & 255u) == 0u) { if (xb_ld(&bar[XB_TMO])) break; if (sp > XB_SPIN_CAP) { atomicAdd(&bar[XB_TMO], 1u); break; } }
    }
    nloc = mine > 0u ? mine : 1u; nx = cnt > 0u ? cnt : 1u;
}
__device__ __forceinline__ void xcd_barrier(const XcdBarrier& b) {
    asm volatile("s_waitcnt vmcnt(0)" ::: "memory");
    __syncthreads();
    if (threadIdx.x == 0) {
        unsigned* bar = b.bar;
        __builtin_amdgcn_s_waitcnt(0);
        unsigned nloc = b.st[0], nx = b.st[1];
        if (nloc == 0u) { xcd_barrier_complete(bar, b.x, nloc, nx); b.st[0] = nloc; b.st[1] = nx; }
        const unsigned old = xb_add(&bar[XB_XSUB(b.x)], 1u);
        const unsigned gen = old / nloc;
        if (old + 1u == (gen + 1u) * nloc) {
            __builtin_amdgcn_fence(__ATOMIC_RELEASE, "agent");
            asm volatile("s_waitcnt vmcnt(0)" ::: "memory");
            const unsigned og = xb_add(&bar[XB_TOP], 1u);
            const unsigned tg = og / nx;
            if (og + 1u == (tg + 1u) * nx) xb_add(&bar[XB_TOPGEN], 1u);
            else XB_SPIN(xb_ld(&bar[XB_TOPGEN]) == tg, bar);
            __builtin_amdgcn_fence(__ATOMIC_ACQUIRE, "agent");
            xb_add(&bar[XB_XGEN(b.x)], 1u);
            asm volatile("s_waitcnt vmcnt(0)" ::: "memory");
        } else {
            XB_SPIN(xb_ld(&bar[XB_XGEN(b.x)]) == gen, bar);
            __builtin_amdgcn_fence(__ATOMIC_ACQUIRE, "agent");
            asm volatile("s_waitcnt vmcnt(0)" ::: "memory");
        }
    }
    __syncthreads();
}

__device__ __forceinline__ unsigned f2bf(float f) { unsigned u = __builtin_bit_cast(unsigned, f); return (u + 0x7fffu + ((u >> 16) & 1u)) >> 16; }
__device__ __forceinline__ unsigned pk2(float lo, float hi) { return f2bf(lo) | (f2bf(hi) << 16); }
__device__ __forceinline__ float bf2f(unsigned short v) { return __uint_as_float(((unsigned)v) << 16); }
__device__ __forceinline__ float wave_sum(float v) {
#pragma unroll
    for (int o = 1; o < 64; o <<= 1) v += __shfl_xor(v, o);
    return v;
}
__device__ __forceinline__ void p0_transpose_item(const float* src, int N, bf16* dst, int ldt, const float* ks, LAS float* scr, int lane) {
#pragma unroll 8
    for (int i = 0; i < 32; ++i) { const int kk = 2 * i + (lane >> 5); float v = src[(size_t)kk * N + (lane & 31)]; if (ks) v *= ks[kk]; scr[kk * 33 + (lane & 31)] = v; }
    LDS_WAIT(); asm volatile("" ::: "memory");
    const int c = lane & 7;
#pragma unroll
    for (int j = 0; j < 4; ++j) { const int n = (lane >> 3) + 8 * j; const LAS float* s = scr + (8 * c) * 33 + n;
        v4u o; o.x = pk2(s[0 * 33], s[1 * 33]); o.y = pk2(s[2 * 33], s[3 * 33]); o.z = pk2(s[4 * 33], s[5 * 33]); o.w = pk2(s[6 * 33], s[7 * 33]);
        *(GAS v4u*)(dst + (size_t)n * ldt + 8 * c) = o; }
    LDS_WAIT(); asm volatile("" ::: "memory");
}

template <int IDX> __device__ __forceinline__ const float* ldarg_ptr() {
    auto ka = __builtin_amdgcn_kernarg_segment_ptr();
    unsigned long long v; asm volatile("s_load_dwordx2 %0, %1, %2\n\ts_waitcnt lgkmcnt(0)" : "=s"(v) : "s"(ka), "i"(IDX * 8) : "memory"); return (const float*)v;
}
struct Args { const float* in[20]; float* out; unsigned char* ws; int ph_lo, ph_hi, li, pad; };
constexpr int NPH = 8;

__global__ void __launch_bounds__(512, 2) hymba_fwd(Args args) {
    extern __shared__ __attribute__((aligned(16))) unsigned char lds_raw[];
    LAS unsigned char* lds = (LAS unsigned char*)lds_raw;
    const int tid = threadIdx.x, lane = tid & 63, wave = __builtin_amdgcn_readfirstlane(tid >> 6);
    const int G = gridDim.x; const int bx = blockIdx.x; const int vcu = (G % 8 == 0) ? (bx % 8) * (G / 8) + bx / 8 : bx;
    gu32* ctl = (gu32*)(args.ws + WS_CTL);
#define LDARG(i) ldarg_ptr<i>()
#define WSPTR(name, off) bf16* name = (bf16*)(ws + (off))
#define PHASE_WS() unsigned char* ws = args.ws; asm volatile("" : "+s"(ws)); float* out = args.out; asm volatile("" : "+s"(out)); (void)out
    volatile LAS unsigned* MISC = (volatile LAS unsigned*)(lds + MISC_OFF);
    if (tid < 4) MISC[tid] = 0u;
    __syncthreads();
    const int lo = args.ph_lo, hi_ph = args.ph_hi;
    const bool use_bar = (hi_ph - lo) > 1;
    XcdBarrier bar; bar.bar = (unsigned*)(ctl + CW_BAR); bar.x = 0; bar.st = nullptr;
    if (use_bar) bar = xcd_barrier_post((unsigned*)(ctl + CW_BAR), MISC);
#ifndef PHASE_MASK
#define PHASE_MASK 0xFF
#endif
#define IN(k) (((PHASE_MASK >> (k)) & 1) && lo <= (k) && (k) < hi_ph)
#define BOTH(k) (IN(k) && IN((k) + 1))
#define GRID_BAR() do { xcd_barrier(bar); } while (0)
    const int gw = vcu * 8 + wave, NGW = G * 8;

    if (IN(0)) {
        PHASE_WS(); WSPTR(wfrag, WS_WFRAG); WSPTR(bt2, WS_BT2); WSPTR(win_t, WS_WIN); WSPTR(wout_t, WS_WOUT); WSPTR(wout_t2, WS_WOUT2); WSPTR(wgu_t, WS_WGU); WSPTR(wd_t, WS_WD); WSPTR(XN, WS_XN);
        const float* x = LDARG(0); const float* norm1_g = LDARG(1); const float* w_in = LDARG(2); const float* pool_w = LDARG(8); const float* pool_scale = LDARG(9); const float* w_out = LDARG(10);
        const float* norm2_g = LDARG(11); const float* w_coarse = LDARG(12); const float* w_fine = LDARG(14); const float* w_gate = LDARG(16); const float* w_up = LDARG(17); const float* w_down = LDARG(18);
        LAS float* scr = (LAS float*)(lds + wave * 16384);
        constexpr int I_IN = 32 * 128, I_OUT = 32 * 64, I_OUT2 = 16 * 64, I_G = 32 * 16 * 32, I_U = I_G, I_D = 8 * 64 * 32;
        constexpr int NITEMS = I_IN + I_OUT + I_OUT2 + I_G + I_U + I_D;
        for (int it = gw; it < NITEMS; it += NGW) {
            int r = it;
            if (r < I_IN) { const int kb = r / 128, nb = r % 128, k0 = 64 * kb, n0 = 32 * nb; p0_transpose_item(w_in + (size_t)k0 * INW + n0, INW, win_t + (size_t)n0 * D + k0, D, nullptr, scr, lane); continue; } r -= I_IN;
            if (r < I_OUT) { const int kb = r / 64, nb = r % 64, k0 = 64 * kb, n0 = 32 * nb; p0_transpose_item(w_out + (size_t)k0 * D + n0, D, wout_t + (size_t)n0 * D + k0, D, nullptr, scr, lane); continue; } r -= I_OUT;
            if (r < I_OUT2) { const int kb = r / 64, nb = r % 64, k0 = 64 * kb, n0 = 32 * nb; p0_transpose_item(w_out + (size_t)k0 * D + n0, D, wout_t2 + (size_t)n0 * D + k0, D, nullptr, scr, lane); continue; } r -= I_OUT2;
            if (r < I_G + I_U) { const bool up = r >= I_G; if (up) r -= I_G; const int e = r / 512, q = r % 512, kb = q / 16, nb = q % 16, k0 = 64 * kb, n0 = 32 * nb;
                const float* W = (up ? w_up : w_gate) + (size_t)e * D * FF; const int drow = (n0 >> 7) * 256 + (up ? 128 : 0) + (n0 & 127);
                p0_transpose_item(W + (size_t)k0 * FF + n0, FF, wgu_t + ((size_t)e * 1024 + drow) * D + k0, D, norm2_g + k0, scr, lane); continue; } r -= I_G + I_U;
            { const int e = r / 512, q = r % 512, kb = q / 64, nb = q % 64, k0 = 64 * kb, n0 = 32 * nb;
                p0_transpose_item(w_down + (size_t)e * FF * D + (size_t)k0 * D + n0, D, wd_t + ((size_t)e * D + n0) * FF + k0, FF, nullptr, scr, lane); }
        }
        for (int i = blockIdx.x * 512 + tid; i < 4 * 256 * 256 / 4; i += G * 512) { const int e4 = (i & 63) * 4, gc = i >> 6, g = gc >> 8;
            const f32x4 w = *(const f32x4*)(pool_w + (size_t)gc * 256 + e4); const f32x4 s = *(const f32x4*)(pool_scale + g * 256 + e4);
            v2u o; o.x = pk2(w[0] * s[0], w[1] * s[1]); o.y = pk2(w[2] * s[2], w[3] * s[3]); *(v2u*)(bt2 + (size_t)gc * 256 + e4) = o; }
        for (int i = blockIdx.x * 512 + tid; i < 128 * 2 * 64; i += G * 512) { const int ln = i & 63, nt_ = (i >> 6) & 1, gs = i >> 7; const int n = ln & 31;
            unsigned hw[4], lw[4];
#pragma unroll
            for (int jp = 0; jp < 4; ++jp) { float v[2];
#pragma unroll
                for (int q = 0; q < 2; ++q) { const int k = 16 * gs + 8 * (ln >> 5) + 2 * jp + q; float w = 0.f;
                    if (nt_ == 0) w = w_fine[((size_t)(n >> 3) * D + k) * 8 + (n & 7)]; else if (n < 4) w = w_coarse[(size_t)k * 4 + n];
                    v[q] = w * norm2_g[k]; }
                const unsigned h0 = f2bf(v[0]), h1 = f2bf(v[1]); hw[jp] = h0 | (h1 << 16);
                lw[jp] = f2bf(v[0] - __uint_as_float(h0 << 16)) | (f2bf(v[1] - __uint_as_float(h1 << 16)) << 16); }
            *(v4u*)(wfrag + ((size_t)((gs * 2 + nt_) * 2 + 0) * 64 + ln) * 8) = (v4u){hw[0], hw[1], hw[2], hw[3]};
            *(v4u*)(wfrag + ((size_t)((gs * 2 + nt_) * 2 + 1) * 64 + ln) * 8) = (v4u){lw[0], lw[1], lw[2], lw[3]}; }
        for (int m = gw; m < T; m += NGW) {
            const f32x4* xr = (const f32x4*)(x + (size_t)m * D) + lane; f32x4 v[8]; float s = 0.f;
#pragma unroll
            for (int j = 0; j < 8; ++j) { v[j] = xr[64 * j]; s += (v[j].x * v[j].x + v[j].y * v[j].y) + (v[j].z * v[j].z + v[j].w * v[j].w); }
            const float rstd = rsqrtf(wave_sum(s) * (1.f / D) + RMS_EPS);
            unsigned long long* o8 = (unsigned long long*)(XN + (size_t)m * D) + lane;
#pragma unroll
            for (int j = 0; j < 8; ++j) { const f32x4 gg = ((const f32x4*)norm1_g)[lane + 64 * j];
                o8[64 * j] = (unsigned long long)pk2(v[j].x * rstd * gg.x, v[j].y * rstd * gg.y) | ((unsigned long long)pk2(v[j].z * rstd * gg.z, v[j].w * rstd * gg.w) << 32); }
        }
        if (BOTH(0)) GRID_BAR();
    }

    if (IN(1)) {
        PHASE_WS(); WSPTR(bt2, WS_BT2); WSPTR(win_t, WS_WIN); WSPTR(wout_t, WS_WOUT); WSPTR(wout_t2, WS_WOUT2); WSPTR(XN, WS_XN); WSPTR(Qb, WS_Q);
        { pg8::DenseOrder S; S.init(T, INW, G, bx, XN, win_t, D, D);
          pg8::EpiStoreBf16 E{Qb, AW, AW, (size_t)T * AW, C2};
          pg8::gemm_phase<pg8::EpiStoreBf16, pg8::DenseOrder, true, false>(lds, D / 64, D, D, S, E); }
        { pg8::W2Order S{G, bx, (const char*)wout_t, (const char*)bt2};
          pg8::EpiStoreBf16 E{wout_t2, D, 0, 0, 1.f};
          int nt_w2 = 256 / 64; asm volatile("" : "+s"(nt_w2));
          pg8::gemm_phase<pg8::EpiStoreBf16, pg8::W2Order, true, false>(lds, nt_w2, D, 256, S, E); }
        if (BOTH(1)) GRID_BAR();
    }

    if (IN(2)) {
        PHASE_WS(); WSPTR(Qb, WS_Q); WSPTR(Kb, WS_K); WSPTR(Vb, WS_V); WSPTR(Ub, WS_U); WSPTR(A3, WS_A3);
        for (int tb = vcu; tb < T / 32; tb += G) {
#pragma unroll 1
            for (int k = 0; k < 8; ++k) { const int item = tid + 512 * k, tk = item >> 7, ch = item & 127, c0 = ch * 8, gi = ch >> 5, w = 2 << gi;
                const int t = tb * 32 + tk, pos = t & (SEQ - 1); const int cw = (pos + 1 < w) ? pos + 1 : w;
                float a[8];
#pragma unroll
                for (int j = 0; j < 8; ++j) a[j] = 0.f;
                const bf16* up = Ub + (size_t)t * AW + c0;
                v4u self = *(const v4u*)up;
                for (int i = 0; i < cw; ++i) { const v4u v = *(const v4u*)(up - (size_t)i * AW);
#pragma unroll
                    for (int j = 0; j < 4; ++j) { a[2 * j] += __uint_as_float(v[j] << 16); a[2 * j + 1] += __uint_as_float(v[j] & 0xffff0000u); } }
                const float inv = 1.0f / (float)cw; v4u o;
#pragma unroll
                for (int j = 0; j < 4; ++j) { const float s0 = __uint_as_float(self[j] << 16), s1 = __uint_as_float(self[j] & 0xffff0000u); o[j] = pk2(a[2 * j] * inv - s0, a[2 * j + 1] * inv - s1); }
                *(v4u*)(A3 + (size_t)t * D + AW + c0) = o; }
        }
        const float* lq1 = LDARG(3); const float* lk1 = LDARG(4); const float* lq2 = LDARG(5); const float* lk2 = LDARG(6); const float* subln_g = LDARG(7);
        float lam;
        { const float p1 = wave_sum(lq1[lane] * lk1[lane]), p2 = wave_sum(lq2[lane] * lk2[lane]); lam = expf(p1) - expf(p2) + 0.2f; }
        LAS float* wsf = (LAS float*)(lds + WSF_OFF);
        for (int p = vcu; p < 256; p += G) {
            const int bh = p >> 3, s = p & 7;
#pragma unroll 1
            for (int ui = 0; ui < 2; ++ui) att::attn_unit(bh >> 3, bh & 7, ui ? s : 15 - s, Qb, Kb, Vb, A3, subln_g, lam, lds, wsf);
        }
        if (BOTH(2)) GRID_BAR();
    }

    if (IN(3)) {
        PHASE_WS(); WSPTR(wout_t2, WS_WOUT2); WSPTR(A3, WS_A3); WSPTR(hb, WS_HB);
        pg8::DenseOrder S; S.init(T, D, G, bx, A3, wout_t2, D, D);
        const float* x = LDARG(0);
        pg8::EpiResid E{x, out, hb};
        pg8::gemm_phase<pg8::EpiResid, pg8::DenseOrder, true, false>(lds, D / 64, D, D, S, E);
        if (BOTH(3)) GRID_BAR();
    }

    if (IN(4)) {
        PHASE_WS(); WSPTR(wfrag, WS_WFRAG); unsigned* tokl = (unsigned*)(ws + WS_TOK); f32x2* swl = (f32x2*)(ws + WS_SW);
        const float* b_coarse = LDARG(13); const float* b_fine = LDARG(15);
        LAS float* part = (LAS float*)lds;
        LAS float* ssqs = (LAS float*)(lds + 65536);
        LAS float* logit = (LAS float*)(lds + 65536 + 1024);
        const int r32 = lane & 31, hi = lane >> 5;
        for (int rb = vcu; rb < T / 32; rb += G) {
            const int R0 = rb * 32;
            const float* hp = out + (size_t)(R0 + r32) * D + wave * 256 + 8 * hi;
            f32x16 acc0, acc1;
#pragma unroll
            for (int r = 0; r < 16; ++r) { acc0[r] = 0.f; acc1[r] = 0.f; }
            float ssq = 0.f;
#pragma unroll 4
            for (int s = 0; s < 16; ++s) {
                const f32x4 a = *(const f32x4*)(hp + 16 * s), b = *(const f32x4*)(hp + 16 * s + 4);
                ssq += (a.x * a.x + a.y * a.y) + (a.z * a.z + a.w * a.w) + (b.x * b.x + b.y * b.y) + (b.z * b.z + b.w * b.w);
                const float v[8] = {a.x, a.y, a.z, a.w, b.x, b.y, b.z, b.w};
                unsigned hw[4], lw[4];
#pragma unroll
                for (int jp = 0; jp < 4; ++jp) { const unsigned h0 = f2bf(v[2 * jp]), h1 = f2bf(v[2 * jp + 1]); hw[jp] = h0 | (h1 << 16);
                    lw[jp] = f2bf(v[2 * jp] - __uint_as_float(h0 << 16)) | (f2bf(v[2 * jp + 1] - __uint_as_float(h1 << 16)) << 16); }
                const bf16x8 ah = __builtin_bit_cast(bf16x8, (v4u){hw[0], hw[1], hw[2], hw[3]}), al = __builtin_bit_cast(bf16x8, (v4u){lw[0], lw[1], lw[2], lw[3]});
                const int gs = wave * 16 + s;
                const bf16x8* wf = (const bf16x8*)wfrag + (size_t)gs * 256 + lane;
                const bf16x8 bh0 = wf[0], bl0 = wf[64], bh1 = wf[128], bl1 = wf[192];
                acc0 = __builtin_amdgcn_mfma_f32_32x32x16_bf16(ah, bh0, acc0, 0, 0, 0);
                acc0 = __builtin_amdgcn_mfma_f32_32x32x16_bf16(al, bh0, acc0, 0, 0, 0);
                acc0 = __builtin_amdgcn_mfma_f32_32x32x16_bf16(ah, bl0, acc0, 0, 0, 0);
                acc1 = __builtin_amdgcn_mfma_f32_32x32x16_bf16(ah, bh1, acc1, 0, 0, 0);
                acc1 = __builtin_amdgcn_mfma_f32_32x32x16_bf16(al, bh1, acc1, 0, 0, 0);
                acc1 = __builtin_amdgcn_mfma_f32_32x32x16_bf16(ah, bl1, acc1, 0, 0, 0);
            }
            ssq += __shfl_xor(ssq, 32);
            __syncthreads();
#pragma unroll
            for (int r = 0; r < 16; ++r) { part[((wave * 2 + 0) * 16 + r) * 64 + lane] = acc0[r]; part[((wave * 2 + 1) * 16 + r) * 64 + lane] = acc1[r]; }
            if (hi == 0) ssqs[wave * 32 + r32] = ssq;
            __syncthreads();
#pragma unroll
            for (int q = 0; q < 4; ++q) { const int idx = tid + 512 * q; float sm = 0.f;
#pragma unroll
                for (int w = 0; w < 8; ++w) sm += part[w * 2048 + idx];
                const int nt_ = idx >> 10, r = (idx >> 6) & 15, ln = idx & 63; const int row = att::crow(r, ln >> 5), n = nt_ * 32 + (ln & 31);
                logit[row * 64 + n] = sm; }
            __syncthreads();
            if (tid < 32) {
                const int row = tid, token = R0 + row; float ss = 0.f;
#pragma unroll
                for (int w = 0; w < 8; ++w) ss += ssqs[w * 32 + row];
                const float rs = rsqrtf(ss * (1.f / D) + RMS_EPS);
                const LAS float* lg = logit + row * 64;
                float c[4];
#pragma unroll
                for (int k = 0; k < 4; ++k) c[k] = lg[32 + k] * rs + b_coarse[k];
                float cb = c[0]; int g = 0;
#pragma unroll
                for (int k = 1; k < 4; ++k) if (c[k] > cb) { cb = c[k]; g = k; }
                float den = 0.f;
#pragma unroll
                for (int k = 0; k < 4; ++k) den += expf(c[k] - cb);
                const float pg = 1.0f / den;
                float f[8];
#pragma unroll
                for (int k = 0; k < 8; ++k) f[k] = lg[g * 8 + k] * rs + b_fine[g * 8 + k];
                float v0 = f[0]; int i0 = 0;
#pragma unroll
                for (int k = 1; k < 8; ++k) if (f[k] > v0) { v0 = f[k]; i0 = k; }
                float v1 = -INFINITY; int i1 = 0;
#pragma unroll
                for (int k = 0; k < 8; ++k) if (k != i0 && f[k] > v1) { v1 = f[k]; i1 = k; }
                const float ex = expf(v1 - v0); const float w0 = pg / (1.0f + ex), w1 = pg * ex / (1.0f + ex);
                const int e0 = g * 8 + i0, e1 = g * 8 + i1;
                const unsigned s0 = __hip_atomic_fetch_add((unsigned*)(ctl + CW_CNT + 64 * e0), 1u, RLX_AGENT);
                const unsigned s1 = __hip_atomic_fetch_add((unsigned*)(ctl + CW_CNT + 64 * e1), 1u, RLX_AGENT);
                tokl[(size_t)e0 * 8192 + s0] = (unsigned)token; swl[(size_t)e0 * 8192 + s0] = (f32x2){rs, w0};
                tokl[(size_t)e1 * 8192 + s1] = (unsigned)token | 0x10000u; swl[(size_t)e1 * 8192 + s1] = (f32x2){rs, w1};
            }
        }
        __syncthreads();
        if (BOTH(4)) GRID_BAR();
    }

    if (IN(5) || IN(6)) {
        PHASE_WS(); WSPTR(hb, WS_HB); WSPTR(wgu_t, WS_WGU); WSPTR(wd_t, WS_WD); WSPTR(hmid, WS_HMID); WSPTR(yb, WS_Y); unsigned* tokl = (unsigned*)(ws + WS_TOK); f32x2* swl = (f32x2*)(ws + WS_SW);
        LAS int* tab = (LAS int*)(lds + TAB_OFF);
        if (tid < 32) tab[40 + tid] = (int)__hip_atomic_load((unsigned*)(ctl + CW_CNT + 64 * tid), RLX_AGENT);
        __syncthreads();
        if (tid == 0) { int acc = 0; for (int e = 0; e < 32; ++e) { tab[e] = acc; acc += (tab[40 + e] + 255) >> 8; } tab[32] = acc; }
        __syncthreads();
        if (IN(5)) {
            pg8::MoeOrder<4, true> S{G, bx, tab, (const char*)hb, (const char*)wgu_t, tokl};
            pg8::EpiGateUp E{hmid, swl};
            pg8::gemm_phase<pg8::EpiGateUp, pg8::MoeOrder<4, true>, true, true>(lds, D / 64, D, D, S, E);
            if (BOTH(5)) GRID_BAR();
        }
        if (IN(6)) {
            pg8::MoeOrder<8, false> S{G, bx, tab, (const char*)hmid, (const char*)wd_t, tokl};
            pg8::EpiDown E{yb, tokl};
            pg8::gemm_phase<pg8::EpiDown, pg8::MoeOrder<8, false>, true, false>(lds, FF / 64, FF, FF, S, E);
            if (BOTH(6)) GRID_BAR();
        }
    }

    if (IN(7)) {
        PHASE_WS(); WSPTR(yb, WS_Y);
        const float* final_g = LDARG(19);
        for (int m = gw; m < T; m += NGW) {
            f32x4* hr = (f32x4*)(out + (size_t)m * D) + lane; f32x4 v[8]; float s = 0.f;
            const v2u* y0 = (const v2u*)(yb + (size_t)m * D) + lane; const v2u* y1 = (const v2u*)(yb + ((size_t)T + m) * D) + lane;
#pragma unroll
            for (int j = 0; j < 8; ++j) { v[j] = hr[64 * j]; const v2u a = y0[64 * j], b = y1[64 * j];
                v[j].x += __uint_as_float(a.x << 16) + __uint_as_float(b.x << 16); v[j].y += __uint_as_float(a.x & 0xffff0000u) + __uint_as_float(b.x & 0xffff0000u);
                v[j].z += __uint_as_float(a.y << 16) + __uint_as_float(b.y << 16); v[j].w += __uint_as_float(a.y & 0xffff0000u) + __uint_as_float(b.y & 0xffff0000u);
                s += (v[j].x * v[j].x + v[j].y * v[j].y) + (v[j].z * v[j].z + v[j].w * v[j].w); }
            const float rstd = rsqrtf(wave_sum(s) * (1.f / D) + RMS_EPS);
#pragma unroll
            for (int j = 0; j < 8; ++j) { const f32x4 gg = ((const f32x4*)final_g)[lane + 64 * j]; hr[64 * j] = v[j] * rstd * gg; }
        }
    }
#undef IN
#undef BOTH
#undef GRID_BAR
}

extern "C" void kernel_launch(void* const* d_in, const int* in_sizes, int n_in, void* d_out, int out_size, void* d_ws, size_t ws_size, hipStream_t stream) {
    static int grid = 0;
    if (grid == 0) {
        if (n_in != 20 || out_size != T * D || ws_size < WS_END) { fprintf(stderr, "kernel_launch: unexpected shapes (n_in %d out %d ws %zu)\n", n_in, out_size, ws_size); grid = -1; return; }
        int dev = 0, cus = 0, per_cu = 0;
        if (hipGetDevice(&dev) != hipSuccess || hipDeviceGetAttribute(&cus, hipDeviceAttributeMultiprocessorCount, dev) != hipSuccess) { grid = -1; return; }
        if (hipFuncSetAttribute((const void*)hymba_fwd, hipFuncAttributeMaxDynamicSharedMemorySize, LDS_BYTES) != hipSuccess) { fprintf(stderr, "kernel_launch: hipFuncSetAttribute failed\n"); grid = -1; return; }
        if (hipOccupancyMaxActiveBlocksPerMultiprocessor(&per_cu, (const void*)hymba_fwd, 512, LDS_BYTES) != hipSuccess || per_cu < 1) fprintf(stderr, "kernel_launch: occupancy query reports %d\n", per_cu);
        (void)hipGetLastError();
        grid = cus;
    }
    if (grid < 0) return;
    (void)hipMemsetAsync((char*)d_ws + WS_CTL, 0, CTL_ZERO_BYTES, stream);
    Args a{};
    for (int i = 0; i < 20; ++i) a.in[i] = (const float*)d_in[i];
    a.out = (float*)d_out; a.ws = (unsigned char*)d_ws;
    if (MK_N_LAUNCHES == 1) { a.ph_lo = 0; a.ph_hi = NPH; a.li = 0; hipLaunchKernelGGL(hymba_fwd, dim3(grid), dim3(512), LDS_BYTES, stream, a); }
    else { for (int p = 0; p < NPH; ++p) { a.ph_lo = p; a.ph_hi = p + 1; a.li = p; hipLaunchKernelGGL(hymba_fwd, dim3(grid), dim3(512), LDS_BYTES, stream, a); } }
}
```

```cpp
#include <hip/hip_runtime.h>
#include <hip/hip_bf16.h>
#include <cstdio>
#include <cstdint>

#ifndef MK_N_LAUNCHES
#define MK_N_LAUNCHES 1
#endif
#ifndef PROBE_DUP
#define PROBE_DUP -1
#endif

#define GAS __attribute__((address_space(1)))
#define LAS __attribute__((address_space(3)))
typedef unsigned short bf16;
typedef unsigned v4u __attribute__((ext_vector_type(4)));
typedef unsigned v2u __attribute__((ext_vector_type(2)));
typedef float f32x4 __attribute__((ext_vector_type(4)));
typedef float f32x2 __attribute__((ext_vector_type(2)));
typedef float f32x16 __attribute__((ext_vector_type(16)));
typedef short bf16x8 __attribute__((ext_vector_type(8)));
typedef short s16x4 __attribute__((ext_vector_type(4)));
typedef GAS unsigned gu32;
#define RLX_AGENT __ATOMIC_RELAXED, __HIP_MEMORY_SCOPE_AGENT
#define LDS_WAIT() asm volatile("s_waitcnt lgkmcnt(0)" ::: "memory")
#define VM_WAIT() asm volatile("s_waitcnt vmcnt(0)" ::: "memory")

constexpr int T = 8192, SEQ = 2048, D = 2048, INW = 4096, AW = 1024, NH = 8, NE = 32, FF = 512;
constexpr float RMS_EPS = 1e-6f;
constexpr float LOG2E = 1.4426950408889634f;
constexpr float C2 = 0.125f * LOG2E;

constexpr size_t MiB = 1u << 20;
constexpr size_t WS_CTL = 0, CTL_ZERO_BYTES = 1 * MiB;
constexpr size_t WS_WFRAG = 1 * MiB;
constexpr size_t WS_BT2 = 1 * MiB + 512 * 1024;
constexpr size_t WS_WIN = 2 * MiB;
constexpr size_t WS_WOUT = 18 * MiB;
constexpr size_t WS_WOUT2 = 26 * MiB;
constexpr size_t WS_TOK = 34 * MiB;
constexpr size_t WS_SW = 35 * MiB;
constexpr size_t WS_WGU = 40 * MiB;
constexpr size_t WS_WD = 168 * MiB;
constexpr size_t WS_XN = 232 * MiB;
constexpr size_t WS_HMID = 232 * MiB;
constexpr size_t WS_Q = 264 * MiB, WS_K = 280 * MiB, WS_V = 296 * MiB, WS_U = 312 * MiB;
constexpr size_t WS_Y = 264 * MiB;
constexpr size_t WS_A3 = 328 * MiB;
constexpr size_t WS_HB = 360 * MiB;
constexpr size_t WS_END = 392 * MiB;
constexpr int CW_CNT = 1024;
constexpr int CW_BAR = 4096;

constexpr int RING_BYTES = 131072;
constexpr int WSF_OFF = RING_BYTES;
constexpr int TAB_OFF = WSF_OFF + 2048;
constexpr int MISC_OFF = TAB_OFF + 512;
constexpr int LDS_BYTES = 147456;

namespace pg8 {
#define PG8_LAS __attribute__((address_space(3)))
typedef unsigned short bf16_t;
typedef unsigned u32x4 __attribute__((ext_vector_type(4)));
constexpr int BM = 256, BK = 64, HALF = 128, HTB = HALF * BK * 2, STAGE_BYTES = 8 * HTB, NXCD = 8, WGM = 8;

__host__ __device__ __forceinline__ int lds_byte(int r, int c) { const int st = (r >> 4) * 2 + (c >> 5), rr = r & 15, cc = c & 31, ob = rr * 64 + cc * 2; return st * 1024 + (ob ^ (((ob >> 9) & 1) << 5)); }
__host__ __device__ __forceinline__ void stage_rc(int b, int& R, int& C) { const int st = b / 1024, sb = b % 1024, swz = sb ^ (((sb >> 9) & 1) << 5); R = (st >> 1) * 16 + swz / 64; C = (st & 1) * 32 + (swz % 64) / 2; }
__host__ __device__ __forceinline__ int perm32(int rho) { const int n = rho >> 4, i = rho & 15; return 8 * (i >> 2) + 4 * n + (i & 3); }

struct Unit { const char* a; const char* b; int orow, ocol, e, s0, cnt; };

__device__ __forceinline__ unsigned cvt_pk_bf16(float lo, float hi) { unsigned r; asm volatile("v_cvt_pk_bf16_f32 %0, %1, %2" : "=v"(r) : "v"(lo), "v"(hi)); return r; }

struct DenseOrder {
    int nM, nN, nwg, G, c; const char* A; const char* Bt; size_t tsA, tsB;
    __device__ void init(int M, int N, int G_, int c_, const void* A_, const void* Bt_, int lda, int ldb) { nM = M / BM; nN = N / BM; nwg = nM * nN; G = G_; c = c_; A = (const char*)A_; Bt = (const char*)Bt_; tsA = (size_t)BM * lda * 2; tsB = (size_t)BM * ldb * 2; }
    __device__ bool next(int i, Unit& u) const {
        const long L = (long)i * G + c; if (L >= nwg) return false;
        int wgid = (int)L; { const int q = nwg / NXCD, r = nwg % NXCD, xcd = wgid % NXCD, off = wgid / NXCD; wgid = (xcd < r ? xcd * (q + 1) : r * (q + 1) + (xcd - r) * q) + off; }
        const int nig = WGM * nN, gid = wgid / nig, fm = gid * WGM, gsz = (nM - fm) < WGM ? (nM - fm) : WGM;
        const int pm = fm + ((wgid % nig) % gsz), pn = (wgid % nig) / gsz;
        u.a = A + (size_t)pm * tsA; u.b = Bt + (size_t)pn * tsB; u.orow = pm * BM; u.ocol = pn * BM; u.e = 0; u.s0 = 0; u.cnt = 0; return true;
    }
    __device__ __forceinline__ unsigned row_off(const Unit&, int) const { return 0u; }
};

template <class Epi, class Sched, bool ALIGN_EPI, bool GATHER>
__device__ __forceinline__ void gemm_phase(PG8_LAS unsigned char* lds, const int nt, const int lda, const int ldb, const Sched& S, const Epi& E) {
    const int tid = threadIdx.x, wid = __builtin_amdgcn_readfirstlane(tid >> 6), lane = tid & 63, wr = wid >> 2, wc = wid & 3, fr = lane & 15, fq = lane >> 4;
    unsigned voffA[2], voffB[2]; int rA[2]; unsigned cA2[2];
#pragma unroll
    for (int i = 0; i < 2; ++i) { int R, C; stage_rc(tid * 16 + i * 8192, R, C); const int Rb = Epi::PERM ? ((R & ~31) + perm32(R & 31)) : R;
        voffA[i] = (unsigned)(R * lda + C) * 2u; voffB[i] = (unsigned)(Rb * ldb + C) * 2u; rA[i] = R; cA2[i] = (unsigned)C * 2u; }
    const size_t kstep = (size_t)(BK * 2);
    const size_t hstepA = (size_t)HALF * lda * 2, hstepB = (size_t)HALF * ldb * 2;
    const unsigned ldsw = (unsigned)wid * 1024u;
    const int aoff = lds_byte(wr * 64 + fr, fq * 8), boff = lds_byte(wc * 32 + fr, fq * 8);
#define PG8_SA(b, h) (((b) * 2 + (h)) * HTB)
#define PG8_SB(b, h) ((4 + (b) * 2 + (h)) * HTB)
#define PG8_STAGE_O(bufoff, gbase, o0, o1) do { \
        __builtin_amdgcn_global_load_lds((const unsigned*)((const char*)(gbase) + (o0)), (PG8_LAS unsigned*)(lds + (bufoff) + ldsw), 16, 0, 0); \
        __builtin_amdgcn_global_load_lds((const unsigned*)((const char*)(gbase) + (o1)), (PG8_LAS unsigned*)(lds + (bufoff) + ldsw + 8192), 16, 0, 0); } while (0)
#define PG8_STB(b, h, bptr) PG8_STAGE_O(PG8_SB(b, h), (bptr) + (h) * hstepB, voffB[0], voffB[1])
#define PG8_STA(b, h, aptr, O) do { if constexpr (GATHER) { PG8_STAGE_O(PG8_SA(b, h), (aptr), O[h][0], O[h][1]); } else { PG8_STAGE_O(PG8_SA(b, h), (aptr) + (h) * hstepA, voffA[0], voffA[1]); } } while (0)
#define PG8_LDA(dst, b, h) do { _Pragma("unroll") for (int m = 0; m < 4; ++m) _Pragma("unroll") for (int k = 0; k < 2; ++k) dst[m][k] = *(const PG8_LAS bf16x8*)(lds + PG8_SA(b, h) + aoff + m * 2048 + k * 1024); } while (0)
#define PG8_LDB(dst, b, h) do { _Pragma("unroll") for (int n = 0; n < 2; ++n) _Pragma("unroll") for (int k = 0; k < 2; ++k) dst[n][k] = *(const PG8_LAS bf16x8*)(lds + PG8_SB(b, h) + boff + n * 2048 + k * 1024); } while (0)
#define PG8_MMA(ai, bj, At, Bt) do { __builtin_amdgcn_s_setprio(1); _Pragma("unroll") for (int m = 0; m < 4; ++m) _Pragma("unroll") for (int n = 0; n < 2; ++n) _Pragma("unroll") for (int k = 0; k < 2; ++k) \
        acc[ai][bj][m][n] = __builtin_amdgcn_mfma_f32_16x16x32_bf16(Bt[n][k], At[m][k], acc[ai][bj][m][n], 0, 0, 0); __builtin_amdgcn_s_setprio(0); } while (0)
#define PG8_WAIT_V(n) asm volatile("s_waitcnt vmcnt(" #n ")" ::: "memory")
#define PG8_WAIT_L(n) asm volatile("s_waitcnt lgkmcnt(" #n ")" ::: "memory")
#define PG8_BAR __builtin_amdgcn_s_barrier()
#define PG8_SCHED __builtin_amdgcn_sched_barrier(0)
#define PG8_FETCH(u, O) do { _Pragma("unroll") for (int h_ = 0; h_ < 2; ++h_) _Pragma("unroll") for (int i_ = 0; i_ < 2; ++i_) O[h_][i_] = S.row_off(u, h_ * HALF + rA[i_]) + cA2[i_]; } while (0)
    Unit cur, nxt; int ui = 0;
    if (!S.next(0, cur)) return;
    f32x4 acc[2][2][4][2];
#pragma unroll
    for (int a = 0; a < 2; ++a)
#pragma unroll
        for (int b = 0; b < 2; ++b)
#pragma unroll
            for (int m = 0; m < 4; ++m)
#pragma unroll
                for (int n = 0; n < 2; ++n) acc[a][b][m][n] = (f32x4){0.f, 0.f, 0.f, 0.f};
    bf16x8 At[4][2], B0[2][2], B1[2][2];
    unsigned oC[2][2] = {{0u, 0u}, {0u, 0u}}, oN[2][2] = {{0u, 0u}, {0u, 0u}}, o2[2][2] = {{0u, 0u}, {0u, 0u}};
    if constexpr (GATHER) { PG8_FETCH(cur, oC); }
    const char* cA = cur.a; const char* cB = cur.b;
    PG8_STB(0, 0, cB); PG8_STB(0, 1, cB); PG8_STA(0, 0, cA, oC); PG8_STA(0, 1, cA, oC);
    if (wr == 1) PG8_BAR;
    PG8_WAIT_V(2); PG8_BAR;
    PG8_STB(1, 0, cB + kstep); PG8_STA(1, 0, cA + kstep, oC); PG8_STB(1, 1, cB + kstep);
    PG8_WAIT_V(6); PG8_BAR;
    for (;;) {
        const bool has_next = S.next(ui + 1, nxt);
        const char* nA = has_next ? nxt.a : cA; const char* nB = has_next ? nxt.b : cB;
        if constexpr (GATHER) { if (has_next) { PG8_FETCH(nxt, oN); } else {
#pragma unroll
            for (int h_ = 0; h_ < 2; ++h_)
#pragma unroll
                for (int i_ = 0; i_ < 2; ++i_) oN[h_][i_] = oC[h_][i_]; } }
        for (int t = 0; t < nt; t += 2) {
            const bool last = (t == nt - 2);
            const char* a1 = cA + (size_t)(t + 1) * kstep;
            const char* a2 = last ? nA : cA + (size_t)(t + 2) * kstep; const char* b2 = last ? nB : cB + (size_t)(t + 2) * kstep;
            const char* a3 = a2 + kstep; const char* b3 = b2 + kstep;
            if constexpr (GATHER) {
#pragma unroll
                for (int h_ = 0; h_ < 2; ++h_)
#pragma unroll
                    for (int i_ = 0; i_ < 2; ++i_) o2[h_][i_] = last ? oN[h_][i_] : oC[h_][i_]; }
            PG8_LDB(B0, 0, 0); PG8_LDB(B1, 0, 1); PG8_SCHED; PG8_LDA(At, 0, 0); PG8_STA(1, 1, a1, oC);
            PG8_WAIT_V(8); PG8_WAIT_L(0); PG8_BAR; PG8_MMA(0, 0, At, B0); PG8_MMA(0, 1, At, B1); PG8_BAR; PG8_SCHED;
            PG8_LDA(At, 0, 1); PG8_STB(0, 0, b2); PG8_STB(0, 1, b2); PG8_STA(0, 0, a2, o2);
            PG8_WAIT_V(8); PG8_WAIT_L(0); PG8_BAR; PG8_MMA(1, 0, At, B0); PG8_MMA(1, 1, At, B1); PG8_BAR; PG8_SCHED;
            PG8_LDB(B0, 1, 0); PG8_LDB(B1, 1, 1); PG8_SCHED; PG8_LDA(At, 1, 0); PG8_STA(0, 1, a2, o2);
            PG8_WAIT_V(8); PG8_WAIT_L(0); PG8_BAR; PG8_MMA(0, 0, At, B0); PG8_MMA(0, 1, At, B1); PG8_BAR; PG8_SCHED;
            PG8_LDA(At, 1, 1); PG8_STB(1, 0, b3); PG8_STB(1, 1, b3); PG8_STA(1, 0, a3, o2);
            PG8_WAIT_V(8); PG8_WAIT_L(0); PG8_BAR; PG8_MMA(1, 0, At, B0); PG8_MMA(1, 1, At, B1); PG8_BAR; PG8_SCHED;
        }
        if constexpr (ALIGN_EPI) { if (wr == 0) PG8_BAR; }
        E(acc, cur, wr, wc, fr, fq);
        if (!has_next) break;
#pragma unroll
        for (int a = 0; a < 2; ++a)
#pragma unroll
            for (int b = 0; b < 2; ++b)
#pragma unroll
                for (int m = 0; m < 4; ++m)
#pragma unroll
                    for (int n = 0; n < 2; ++n) acc[a][b][m][n] = (f32x4){0.f, 0.f, 0.f, 0.f};
        cur = nxt; cA = nA; cB = nB; ++ui;
        if constexpr (GATHER) {
#pragma unroll
            for (int h_ = 0; h_ < 2; ++h_)
#pragma unroll
                for (int i_ = 0; i_ < 2; ++i_) oC[h_][i_] = oN[h_][i_]; }
        if constexpr (ALIGN_EPI) { if (wr == 1) PG8_BAR; }
    }
    PG8_WAIT_V(0);
    if constexpr (!ALIGN_EPI) { if (wr == 0) PG8_BAR; }
    PG8_BAR;
#undef PG8_SA
#undef PG8_SB
#undef PG8_STAGE_O
#undef PG8_STB
#undef PG8_STA
#undef PG8_LDA
#undef PG8_LDB
#undef PG8_MMA
#undef PG8_WAIT_V
#undef PG8_WAIT_L
#undef PG8_BAR
#undef PG8_SCHED
#undef PG8_FETCH
}

struct EpiStoreBf16 {
    static constexpr bool PERM = true;
    bf16_t* O; int ldc; int split_cols; size_t split_stride; float scale0;
    __device__ __forceinline__ void operator()(const f32x4 (&acc)[2][2][4][2], const Unit& u, int wr, int wc, int fr, int fq) const {
        const int row0 = u.orow + wr * 64 + fr; int colt = u.ocol; bf16_t* base = O;
        float sc = 1.f; if (split_cols) { const int t = colt / split_cols; base += (size_t)t * split_stride; colt -= t * split_cols; if (t == 0) sc = scale0; }
        const int col0 = colt + wc * 32 + 8 * fq;
#pragma unroll
        for (int ai = 0; ai < 2; ++ai)
#pragma unroll
            for (int m = 0; m < 4; ++m) { bf16_t* rowp = base + (size_t)(row0 + ai * HALF + m * 16) * ldc + col0;
#pragma unroll
                for (int bj = 0; bj < 2; ++bj) { const f32x4 v0 = acc[ai][bj][m][0] * sc, v1 = acc[ai][bj][m][1] * sc;
                    u32x4 w; w.x = cvt_pk_bf16(v0[0], v0[1]); w.y = cvt_pk_bf16(v0[2], v0[3]); w.z = cvt_pk_bf16(v1[0], v1[1]); w.w = cvt_pk_bf16(v1[2], v1[3]);
                    *(u32x4*)(rowp + bj * HALF) = w; } }
    }
};
struct EpiResid {
    static constexpr bool PERM = false;
    const float* x; float* out; bf16_t* hb;
    __device__ __forceinline__ void operator()(const f32x4 (&acc)[2][2][4][2], const Unit& u, int wr, int wc, int fr, int fq) const {
        const int row0 = u.orow + wr * 64 + fr, col0 = u.ocol + wc * 32 + 4 * fq;
#pragma unroll
        for (int ai = 0; ai < 2; ++ai)
#pragma unroll
            for (int m = 0; m < 4; ++m) { const size_t off = (size_t)(row0 + ai * HALF + m * 16) * D + col0;
#pragma unroll
                for (int bj = 0; bj < 2; ++bj)
#pragma unroll
                    for (int n = 0; n < 2; ++n) { const size_t o = off + bj * HALF + n * 16; const f32x4 xv = *(const f32x4*)(x + o); const f32x4 hv = xv + acc[ai][bj][m][n];
                        *(f32x4*)(out + o) = hv; v2u w; w.x = cvt_pk_bf16(hv[0], hv[1]); w.y = cvt_pk_bf16(hv[2], hv[3]); *(v2u*)(hb + o) = w; } }
    }
};
struct EpiGateUp {
    static constexpr bool PERM = true;
    bf16_t* hmid; const f32x2* sw;
    __device__ __forceinline__ void operator()(const f32x4 (&acc)[2][2][4][2], const Unit& u, int wr, int wc, int fr, int fq) const {
        const int col0 = u.ocol + wc * 32 + 8 * fq;
#pragma unroll
        for (int ai = 0; ai < 2; ++ai)
#pragma unroll
            for (int m = 0; m < 4; ++m) { const int r = ai * HALF + wr * 64 + m * 16 + fr; const int slot = u.s0 + r; const bool valid = slot < u.cnt;
                f32x2 rw = (f32x2){0.f, 0.f}; if (valid) rw = sw[(size_t)u.e * 8192 + slot];
                float hv[8];
#pragma unroll
                for (int n = 0; n < 2; ++n)
#pragma unroll
                    for (int j = 0; j < 4; ++j) { const float g = acc[ai][0][m][n][j] * rw.x, up = acc[ai][1][m][n][j] * rw.x;
                        const float e = __builtin_amdgcn_exp2f(-g * LOG2E); const float s = g * __builtin_amdgcn_rcpf(1.0f + e); hv[n * 4 + j] = valid ? s * up * rw.y : 0.f; }
                u32x4 w; w.x = cvt_pk_bf16(hv[0], hv[1]); w.y = cvt_pk_bf16(hv[2], hv[3]); w.z = cvt_pk_bf16(hv[4], hv[5]); w.w = cvt_pk_bf16(hv[6], hv[7]);
                *(u32x4*)(hmid + (size_t)(u.orow + r) * FF + col0) = w; }
    }
};
struct EpiDown {
    static constexpr bool PERM = true;
    bf16_t* y; const unsigned* tok;
    __device__ __forceinline__ void operator()(const f32x4 (&acc)[2][2][4][2], const Unit& u, int wr, int wc, int fr, int fq) const {
        const int col0 = u.ocol + wc * 32 + 8 * fq;
#pragma unroll
        for (int ai = 0; ai < 2; ++ai)
#pragma unroll
            for (int m = 0; m < 4; ++m) { const int r = ai * HALF + wr * 64 + m * 16 + fr; const int slot = u.s0 + r;
                if (slot < u.cnt) { const unsigned ti = tok[(size_t)u.e * 8192 + slot]; const unsigned token = ti & 0xffffu, ks = ti >> 16;
                    bf16_t* rowp = y + ((size_t)ks * T + token) * D + col0;
#pragma unroll
                    for (int bj = 0; bj < 2; ++bj) { const f32x4 v0 = acc[ai][bj][m][0], v1 = acc[ai][bj][m][1];
                        u32x4 w; w.x = cvt_pk_bf16(v0[0], v0[1]); w.y = cvt_pk_bf16(v0[2], v0[3]); w.z = cvt_pk_bf16(v1[0], v1[1]); w.w = cvt_pk_bf16(v1[2], v1[3]);
                        *(u32x4*)(rowp + bj * HALF) = w; } } }
    }
};
struct W2Order {
    int G, c; const char* A; const char* Bt;
    __device__ bool next(int i, Unit& u) const { const int L = i * G + c; if (L >= 32) return false; const int g = L & 3, dt = L >> 2;
        u.a = A + ((size_t)dt * 256 * D + 1024 + 256 * g) * 2; u.b = Bt + (size_t)g * 65536 * 2; u.orow = dt * 256; u.ocol = 1024 + 256 * g; u.e = 0; u.s0 = 0; u.cnt = 0; return true; }
    __device__ __forceinline__ unsigned row_off(const Unit&, int) const { return 0u; }
};
template <int NPN, bool UP> struct MoeOrder {
    int G, c; const PG8_LAS int* tab; const char* A; const char* W; const unsigned* tok;
    __device__ bool next(int i, Unit& u) const {
        const int total = __builtin_amdgcn_readfirstlane(tab[32]) * NPN; const int L = i * G + c; if (L >= total) return false;
        const int Tt = L / NPN, pn = L % NPN; int e = 0;
        for (int k = 1; k < 32; ++k) e = (tab[k] <= Tt) ? k : e;
        e = __builtin_amdgcn_readfirstlane(e);
        const int mt = Tt - __builtin_amdgcn_readfirstlane(tab[e]);
        u.e = e; u.s0 = mt * 256; u.cnt = __builtin_amdgcn_readfirstlane(tab[40 + e]); u.orow = Tt * 256;
        if (UP) { u.a = A; u.b = W + ((size_t)(e * 4 + pn) * 256) * D * 2; u.ocol = pn * 128; }
        else { u.a = A + (size_t)Tt * 256 * FF * 2; u.b = W + ((size_t)e * D + pn * 256) * FF * 2; u.ocol = pn * 256; }
        return true;
    }
    __device__ __forceinline__ unsigned row_off(const Unit& u, int R) const {
        const int slot = u.s0 + R; unsigned token = 0u; if (slot < u.cnt) token = tok[(size_t)u.e * 8192 + slot] & 0xffffu; return token * (unsigned)(D * 2);
    }
};
}

namespace att {
constexpr int PITCH = 1024, QB = 128, KVB = 64, BUFB = 32768;
__device__ __forceinline__ int crow(int r, int hi) { return (r & 3) + 8 * (r >> 2) + 4 * hi; }
__device__ __forceinline__ unsigned cvtpk(float lo, float hi) { unsigned r; asm volatile("v_cvt_pk_bf16_f32 %0, %1, %2" : "=v"(r) : "v"(lo), "v"(hi)); return r; }
typedef short v4i16_t __attribute__((ext_vector_type(4)));
__device__ __forceinline__ s16x4 vtr(const LAS char* p) { return __builtin_bit_cast(s16x4, __builtin_amdgcn_ds_read_tr16_b64_v4i16((LAS v4i16_t*)p)); }
__device__ __forceinline__ float hswap_max(float m) { auto rr = __builtin_amdgcn_permlane32_swap(__float_as_uint(m), __float_as_uint(m), false, false); return fmaxf(__uint_as_float(rr[0]), __uint_as_float(rr[1])); }
__device__ __forceinline__ float hswap_sum(float m) { auto rr = __builtin_amdgcn_permlane32_swap(__float_as_uint(m), __float_as_uint(m), false, false); return __uint_as_float(rr[0]) + __uint_as_float(rr[1]); }

__device__ __forceinline__ void attn_unit(int b, int h, int qb, const bf16* Q, const bf16* K, const bf16* V, bf16* A3, const float* subg, float lam, LAS unsigned char* lds, LAS float* wsf_all) {
    const int tid = threadIdx.x, lane = tid & 63, r32 = lane & 31, hi = lane >> 5; const int wid = __builtin_amdgcn_readfirstlane(tid >> 6);
    const int jm = wid >> 2, rg = wid & 3;
    const long rowbase = (long)b * SEQ; const int q0 = qb * QB, qmin = q0 + 32 * rg, qmax = qmin + 31;
    const float slope2 = exp2f(-(float)(h + 1)) * LOG2E;
    LAS float* wsf = wsf_all + wid * 64;
    const bf16* Kh = K + rowbase * PITCH + h * 128; const bf16* Vh = V + rowbase * PITCH + h * 128;
    const int NT = (q0 + QB) / KVB;
    const bf16* ksrc = Kh + (long)lane * PITCH + wid * 8;
    const bf16* vsrc = Vh + (long)(16 * (wid & 3) + (lane >> 2)) * PITCH + (wid >> 2) * 32 + (lane & 3) * 8;
#define ATT_DMA(t, bsel) do { const long to_ = (long)(t) * KVB * PITCH; LAS unsigned char* bb_ = lds + (bsel) * BUFB; \
        __builtin_amdgcn_global_load_lds((const unsigned*)(ksrc + to_), (LAS unsigned*)(bb_ + wid * 1024), 16, 0, 0); \
        __builtin_amdgcn_global_load_lds((const unsigned*)(ksrc + to_ + 64), (LAS unsigned*)(bb_ + 8192 + wid * 1024), 16, 0, 0); \
        __builtin_amdgcn_global_load_lds((const unsigned*)(vsrc + to_), (LAS unsigned*)(bb_ + 16384 + (wid >> 2) * 4096 + (wid & 3) * 1024), 16, 0, 0); \
        __builtin_amdgcn_global_load_lds((const unsigned*)(vsrc + to_ + 64), (LAS unsigned*)(bb_ + 16384 + (2 + (wid >> 2)) * 4096 + (wid & 3) * 1024), 16, 0, 0); } while (0)
    ATT_DMA(0, 0);
    const bf16* Qw = Q + (rowbase + qmin) * PITCH + h * 128 + jm * 64;
    bf16x8 qr[4];
#pragma unroll
    for (int d0 = 0; d0 < 4; ++d0) qr[d0] = *(const bf16x8*)(Qw + (long)r32 * PITCH + d0 * 16 + hi * 8);
    float bias0[16];
#pragma unroll
    for (int r = 0; r < 16; ++r) bias0[r] = slope2 * (float)(crow(r, hi) - r32);
    const float s32 = 32.f * slope2;
    float mrow = -INFINITY, lsum = 0.f;
    f32x16 o[4];
#pragma unroll
    for (int d0 = 0; d0 < 4; ++d0)
#pragma unroll
        for (int r = 0; r < 16; ++r) o[d0][r] = 0.f;
    for (int t = 0; t < NT; ++t) {
        VM_WAIT(); __syncthreads();
        if (t + 1 < NT) ATT_DMA(t + 1, (t + 1) & 1);
        if (KVB * t <= qmax) {
            const LAS unsigned char* bb = lds + (t & 1) * BUFB;
            const LAS unsigned char* kb = bb + jm * 8192 + hi * 1024 + r32 * 16;
            f32x16 p0, p1;
#pragma unroll
            for (int r = 0; r < 16; ++r) { p0[r] = 0.f; p1[r] = 0.f; }
#pragma unroll
            for (int d0 = 0; d0 < 4; ++d0) {
                const bf16x8 k0 = *(const LAS bf16x8*)(kb + d0 * 2048), k1 = *(const LAS bf16x8*)(kb + d0 * 2048 + 512);
                p0 = __builtin_amdgcn_mfma_f32_32x32x16_bf16(k0, qr[d0], p0, 0, 0, 0);
                p1 = __builtin_amdgcn_mfma_f32_32x32x16_bf16(k1, qr[d0], p1, 0, 0, 0);
            }
#pragma unroll
            for (int r = 0; r < 16; ++r) { p0[r] += bias0[r]; p1[r] += bias0[r]; }
            if (KVB * t + 63 > qmin) {
                const int dq = qmin + r32 - KVB * t - 4 * hi;
#pragma unroll
                for (int r = 0; r < 16; ++r) { const int kk = (r & 3) + 8 * (r >> 2); if (kk > dq) p0[r] = -INFINITY; if (kk + 32 > dq) p1[r] = -INFINITY; }
            }
            const float tb = slope2 * (float)(KVB * t - qmin);
            float m0 = p0[0], m1 = p1[0];
#pragma unroll
            for (int r = 1; r < 16; ++r) { m0 = fmaxf(m0, p0[r]); m1 = fmaxf(m1, p1[r]); }
            float rmt = fmaxf(m0, m1 + s32) + tb; rmt = hswap_max(rmt);
            const float mnew = fmaxf(mrow, rmt);
            const float alpha = __builtin_amdgcn_exp2f(mrow - mnew);
            mrow = mnew;
            const float e0 = mnew - tb, e1 = e0 - s32;
            float sacc = 0.f;
#pragma unroll
            for (int r = 0; r < 16; ++r) { p0[r] = __builtin_amdgcn_exp2f(p0[r] - e0); p1[r] = __builtin_amdgcn_exp2f(p1[r] - e1); sacc += p0[r] + p1[r]; }
            lsum = lsum * alpha + sacc;
            if (!__all(alpha == 1.0f)) {
                if (hi == 0) wsf[r32] = alpha;
                LDS_WAIT();
                float al[16];
#pragma unroll
                for (int r = 0; r < 16; ++r) al[r] = wsf[crow(r, hi)];
#pragma unroll
                for (int d0 = 0; d0 < 4; ++d0)
#pragma unroll
                    for (int r = 0; r < 16; ++r) o[d0][r] *= al[r];
            }
            v4u pw[4];
            pw[0] = (v4u){cvtpk(p0[0], p0[1]), cvtpk(p0[2], p0[3]), cvtpk(p0[4], p0[5]), cvtpk(p0[6], p0[7])};
            pw[1] = (v4u){cvtpk(p0[8], p0[9]), cvtpk(p0[10], p0[11]), cvtpk(p0[12], p0[13]), cvtpk(p0[14], p0[15])};
            pw[2] = (v4u){cvtpk(p1[0], p1[1]), cvtpk(p1[2], p1[3]), cvtpk(p1[4], p1[5]), cvtpk(p1[6], p1[7])};
            pw[3] = (v4u){cvtpk(p1[8], p1[9]), cvtpk(p1[10], p1[11]), cvtpk(p1[12], p1[13]), cvtpk(p1[14], p1[15])};
            const LAS char* vb = (const LAS char*)(bb + 16384) + ((lane >> 4) & 1) * 32 + (lane & 3) * 8 + (4 * hi + ((lane & 15) >> 2)) * 64;
#pragma unroll
            for (int d0 = 0; d0 < 4; ++d0) {
#pragma unroll
                for (int ks = 0; ks < 4; ++ks) {
                    const s16x4 lo = vtr(vb + d0 * 4096 + ks * 1024), hh = vtr(vb + d0 * 4096 + ks * 1024 + 512);
                    const bf16x8 vf = (bf16x8){lo[0], lo[1], lo[2], lo[3], hh[0], hh[1], hh[2], hh[3]};
                    o[d0] = __builtin_amdgcn_mfma_f32_32x32x16_bf16(__builtin_bit_cast(bf16x8, pw[ks]), vf, o[d0], 0, 0, 0);
                }
            }
        }
    }
#undef ATT_DMA
    lsum = hswap_sum(lsum);
    if (hi == 0) wsf[r32] = __builtin_amdgcn_rcpf(lsum);
    LDS_WAIT();
    {
        float rl[16];
#pragma unroll
        for (int r = 0; r < 16; ++r) rl[r] = wsf[crow(r, hi)];
#pragma unroll
        for (int d0 = 0; d0 < 4; ++d0)
#pragma unroll
            for (int r = 0; r < 16; ++r) o[d0][r] *= rl[r];
    }
    __syncthreads();
    LAS float* X = (LAS float*)lds + rg * 4096;
    if (jm == 1) {
#pragma unroll
        for (int d0 = 0; d0 < 4; ++d0)
#pragma unroll
            for (int r = 0; r < 16; ++r) X[(d0 * 16 + r) * 64 + lane] = o[d0][r];
    }
    __syncthreads();
    if (jm == 0) {
        float ss[16];
#pragma unroll
        for (int r = 0; r < 16; ++r) ss[r] = 0.f;
#pragma unroll
        for (int d0 = 0; d0 < 4; ++d0)
#pragma unroll
            for (int r = 0; r < 16; ++r) { const float dv = o[d0][r] - lam * X[(d0 * 16 + r) * 64 + lane]; o[d0][r] = dv; ss[r] += dv * dv; }
#pragma unroll
        for (int r = 0; r < 16; ++r) {
#pragma unroll
            for (int off = 1; off < 32; off <<= 1) ss[r] += __shfl_xor(ss[r], off);
            ss[r] = rsqrtf(ss[r] * (1.0f / 128.0f) + RMS_EPS) * 0.8f;
        }
        bf16* Ow = A3 + (rowbase + qmin) * D + h * 128 + r32;
#pragma unroll
        for (int d0 = 0; d0 < 4; ++d0) { const float gg = subg[d0 * 32 + r32];
#pragma unroll
            for (int r = 0; r < 16; ++r) { const float v = o[d0][r] * ss[r] * gg; const unsigned pk = cvtpk(v, v); Ow[(long)crow(r, hi) * D + d0 * 32] = (bf16)(pk & 0xffffu); } }
    }
    __syncthreads();
}
}

#define XB_TMO      128
#define XB_XCNT(j)  (256  + 64 * (j))
#define XB_XSUB(j)  (1280 + 64 * (j))
#define XB_XGEN(j)  (2304 + 64 * (j))
#define XB_TOP      3328
#define XB_TOPGEN   3392
#define XCD_BAR_WORDS 3456
#define XB_SPIN_CAP (1u << 18)

__device__ __forceinline__ unsigned xb_ld(unsigned* p)              { return __hip_atomic_load(p, __ATOMIC_RELAXED, __HIP_MEMORY_SCOPE_AGENT); }
__device__ __forceinline__ unsigned xb_add(unsigned* p, unsigned v) { return __hip_atomic_fetch_add(p, v, __ATOMIC_RELAXED, __HIP_MEMORY_SCOPE_AGENT); }
__device__ __forceinline__ unsigned xb_xcc_id() { return (unsigned)__builtin_amdgcn_s_getreg((3 << 11) | 20) & 0xFu; }
#define XB_SPIN(cond, bar) do { unsigned _sp = 0; while (cond) { __builtin_amdgcn_s_sleep(1); \
    if ((++_sp & 255u) == 0u) { if (xb_ld(&(bar)[XB_TMO])) break; if (_sp > XB_SPIN_CAP) { atomicAdd(&(bar)[XB_TMO], 1u); break; } } } } while (0)

struct XcdBarrier { unsigned* bar; unsigned x; volatile LAS unsigned* st; };

__device__ __forceinline__ XcdBarrier xcd_barrier_post(unsigned* bar, volatile LAS unsigned* st) {
    XcdBarrier b; b.bar = bar; b.x = xb_xcc_id(); b.st = st;
    if (threadIdx.x == 0) (void)xb_add(&bar[XB_XCNT(b.x)], 1u);
    return b;
}
__device__ __forceinline__ void xcd_barrier_complete(unsigned* bar, unsigned x, unsigned& nloc, unsigned& nx) {
    const unsigned G = gridDim.x * gridDim.y * gridDim.z;
    unsigned sum, cnt, mine, sp = 0u;
    for (;;) {
        sum = 0u; cnt = 0u; mine = 0u;
#pragma unroll
        for (unsigned j = 0; j < 16; ++j) { const unsigned c = xb_ld(&bar[XB_XCNT(j)]); sum += c; cnt += (c > 0u) ? 1u : 0u; mine = (j == x) ? c : mine; }
        if (sum == G) break;
        __builtin_amdgcn_s_sleep(1);
        if ((++sp & 255u) == 0u) { if (xb_ld(&bar[XB_TMO])) break; if (sp > XB_SPIN_CAP) { atomicAdd(&bar[XB_TMO], 1u); break; } }
    }
    nloc = mine > 0u ? mine : 1u; nx = cnt > 0u ? cnt : 1u;
}
__device__ __forceinline__ void xcd_barrier(const XcdBarrier& b) {
    asm volatile("s_waitcnt vmcnt(0)" ::: "memory");
    __syncthreads();
    if (threadIdx.x == 0) {
        unsigned* bar = b.bar;
        __builtin_amdgcn_s_waitcnt(0);
        unsigned nloc = b.st[0], nx = b.st[1];
        if (nloc == 0u) { xcd_barrier_complete(bar, b.x, nloc, nx); b.st[0] = nloc; b.st[1] = nx; }
        const unsigned old = xb_add(&bar[XB_XSUB(b.x)], 1u);
        const unsigned gen = old / nloc;
        if (old + 1u == (gen + 1u) * nloc) {
            __builtin_amdgcn_fence(__ATOMIC_RELEASE, "agent");
            asm volatile("s_waitcnt vmcnt(0)" ::: "memory");
            const unsigned og = xb_add(&bar[XB_TOP], 1u);
            const unsigned tg = og / nx;
            if (og + 1u == (tg + 1u) * nx) xb_add(&bar[XB_TOPGEN], 1u);
            else XB_SPIN(xb_ld(&bar[XB_TOPGEN]) == tg, bar);
            __builtin_amdgcn_fence(__ATOMIC_ACQUIRE, "agent");
            xb_add(&bar[XB_XGEN(b.x)], 1u);
            asm volatile("s_waitcnt vmcnt(0)" ::: "memory");
        } else {
            XB_SPIN(xb_ld(&bar[XB_XGEN(b.x)]) == gen, bar);
            __builtin_amdgcn_fence(__ATOMIC_ACQUIRE, "agent");
            asm volatile("s_waitcnt vmcnt(0)" ::: "memory");
        }
    }
    __syncthreads();
}

__device__ __forceinline__ unsigned f2bf(float f) { unsigned u = __builtin_bit_cast(unsigned, f); return (u + 0x7fffu + ((u >> 16) & 1u)) >> 16; }
__device__ __forceinline__ unsigned pk2(float lo, float hi) { return f2bf(lo) | (f2bf(hi) << 16); }
__device__ __forceinline__ float bf2f(unsigned short v) { return __uint_as_float(((unsigned)v) << 16); }
__device__ __forceinline__ float wave_sum(float v) {
#pragma unroll
    for (int o = 1; o < 64; o <<= 1) v += __shfl_xor(v, o);
    return v;
}
__device__ __forceinline__ void p0_transpose_item(const float* src, int N, bf16* dst, int ldt, const float* ks, LAS unsigned* scr, int lane) {
    const int kq = lane >> 4, nq = lane & 15;
    const float* sp = src + (size_t)(2 * kq) * N + 4 * nq;
    f32x4 v[16];
#pragma unroll
    for (int i = 0; i < 8; ++i) { v[2 * i] = *(const f32x4*)(sp + (size_t)(8 * i) * N); v[2 * i + 1] = *(const f32x4*)(sp + (size_t)(8 * i + 1) * N); }
    if (ks) {
#pragma unroll
        for (int i = 0; i < 8; ++i) { const float s0 = ks[8 * i + 2 * kq], s1 = ks[8 * i + 2 * kq + 1]; v[2 * i] = v[2 * i] * s0; v[2 * i + 1] = v[2 * i + 1] * s1; }
    }
#pragma unroll
    for (int i = 0; i < 8; ++i)
#pragma unroll
        for (int j = 0; j < 4; ++j) scr[(4 * nq + j) * 33 + 4 * i + kq] = pk2(v[2 * i][j], v[2 * i + 1][j]);
    LDS_WAIT(); asm volatile("" ::: "memory");
    const int c = lane & 7;
#pragma unroll
    for (int jj = 0; jj < 8; ++jj) { const int n = (lane >> 3) + 8 * jj; const LAS unsigned* s = scr + n * 33 + 4 * c;
        v4u o; o.x = s[0]; o.y = s[1]; o.z = s[2]; o.w = s[3];
        *(GAS v4u*)(dst + (size_t)n * ldt + 8 * c) = o; }
    LDS_WAIT(); asm volatile("" ::: "memory");
}

template <int IDX> __device__ __forceinline__ const float* ldarg_ptr() {
    auto ka = __builtin_amdgcn_kernarg_segment_ptr();
    unsigned long long v; asm volatile("s_load_dwordx2 %0, %1, %2\n\ts_waitcnt lgkmcnt(0)" : "=s"(v) : "s"(ka), "i"(IDX * 8) : "memory"); return (const float*)v;
}
struct Args { const float* in[20]; float* out; unsigned char* ws; int ph_lo, ph_hi, li, pad; };
constexpr int NPH = 8;

__global__ void __launch_bounds__(512, 2) hymba_fwd(Args args) {
    extern __shared__ __attribute__((aligned(16))) unsigned char lds_raw[];
    LAS unsigned char* lds = (LAS unsigned char*)lds_raw;
    const int tid = threadIdx.x, lane = tid & 63, wave = __builtin_amdgcn_readfirstlane(tid >> 6);
    const int G = gridDim.x; const int bx = blockIdx.x; const int vcu = (G % 8 == 0) ? (bx % 8) * (G / 8) + bx / 8 : bx;
    gu32* ctl = (gu32*)(args.ws + WS_CTL);
#define LDARG(i) ldarg_ptr<i>()
#define WSPTR(name, off) bf16* name = (bf16*)(ws + (off))
#define PHASE_WS() unsigned char* ws = args.ws; asm volatile("" : "+s"(ws)); float* out = args.out; asm volatile("" : "+s"(out)); (void)out
    volatile LAS unsigned* MISC = (volatile LAS unsigned*)(lds + MISC_OFF);
    if (tid < 4) MISC[tid] = 0u;
    __syncthreads();
    const int lo = args.ph_lo, hi_ph = args.ph_hi;
    const bool use_bar = (hi_ph - lo) > 1;
    XcdBarrier bar; bar.bar = (unsigned*)(ctl + CW_BAR); bar.x = 0; bar.st = nullptr;
    if (use_bar) bar = xcd_barrier_post((unsigned*)(ctl + CW_BAR), MISC);
#ifndef PHASE_MASK
#define PHASE_MASK 0xFF
#endif
#define IN(k) (((PHASE_MASK >> (k)) & 1) && lo <= (k) && (k) < hi_ph)
#define BOTH(k) (IN(k) && IN((k) + 1))
#define GRID_BAR() do { xcd_barrier(bar); } while (0)
    const int gw = vcu * 8 + wave, NGW = G * 8;

    if (IN(0)) {
        PHASE_WS(); WSPTR(wfrag, WS_WFRAG); WSPTR(bt2, WS_BT2); WSPTR(win_t, WS_WIN); WSPTR(wout_t, WS_WOUT); WSPTR(wout_t2, WS_WOUT2); WSPTR(wgu_t, WS_WGU); WSPTR(wd_t, WS_WD); WSPTR(XN, WS_XN);
        const float* x = LDARG(0); const float* norm1_g = LDARG(1); const float* w_in = LDARG(2); const float* pool_w = LDARG(8); const float* pool_scale = LDARG(9); const float* w_out = LDARG(10);
        const float* norm2_g = LDARG(11); const float* w_coarse = LDARG(12); const float* w_fine = LDARG(14); const float* w_gate = LDARG(16); const float* w_up = LDARG(17); const float* w_down = LDARG(18);
        LAS unsigned* scr = (LAS unsigned*)(lds + wave * 16384);
        constexpr int I_IN = 32 * 64, I_OUT = 32 * 32, I_OUT2 = 16 * 32, I_G = 32 * 8 * 32, I_U = I_G, I_D = 8 * 32 * 32;
        constexpr int NITEMS = I_IN + I_OUT + I_OUT2 + I_G + I_U + I_D;
        for (int it = gw; it < NITEMS; it += NGW) {
            int r = it;
            if (r < I_IN) { const int kb = r / 64, nb = r % 64, k0 = 64 * kb, n0 = 64 * nb; p0_transpose_item(w_in + (size_t)k0 * INW + n0, INW, win_t + (size_t)n0 * D + k0, D, nullptr, scr, lane); continue; } r -= I_IN;
            if (r < I_OUT) { const int kb = r / 32, nb = r % 32, k0 = 64 * kb, n0 = 64 * nb; p0_transpose_item(w_out + (size_t)k0 * D + n0, D, wout_t + (size_t)n0 * D + k0, D, nullptr, scr, lane); continue; } r -= I_OUT;
            if (r < I_OUT2) { const int kb = r / 32, nb = r % 32, k0 = 64 * kb, n0 = 64 * nb; p0_transpose_item(w_out + (size_t)k0 * D + n0, D, wout_t2 + (size_t)n0 * D + k0, D, nullptr, scr, lane); continue; } r -= I_OUT2;
            if (r < I_G + I_U) { const bool up = r >= I_G; if (up) r -= I_G; const int e = r / 256, q = r % 256, kb = q / 8, nb = q % 8, k0 = 64 * kb, n0 = 64 * nb;
                const float* W = (up ? w_up : w_gate) + (size_t)e * D * FF; const int drow = (n0 >> 7) * 256 + (up ? 128 : 0) + (n0 & 127);
                p0_transpose_item(W + (size_t)k0 * FF + n0, FF, wgu_t + ((size_t)e * 1024 + drow) * D + k0, D, norm2_g + k0, scr, lane); continue; } r -= I_G + I_U;
            { const int e = r / 256, q = r % 256, kb = q / 32, nb = q % 32, k0 = 64 * kb, n0 = 64 * nb;
                p0_transpose_item(w_down + (size_t)e * FF * D + (size_t)k0 * D + n0, D, wd_t + ((size_t)e * D + n0) * FF + k0, FF, nullptr, scr, lane); }
        }
        for (int i = blockIdx.x * 512 + tid; i < 4 * 256 * 256 / 4; i += G * 512) { const int e4 = (i & 63) * 4, gc = i >> 6, g = gc >> 8;
            const f32x4 w = *(const f32x4*)(pool_w + (size_t)gc * 256 + e4); const f32x4 s = *(const f32x4*)(pool_scale + g * 256 + e4);
            v2u o; o.x = pk2(w[0] * s[0], w[1] * s[1]); o.y = pk2(w[2] * s[2], w[3] * s[3]); *(v2u*)(bt2 + (size_t)gc * 256 + e4) = o; }
        for (int i = blockIdx.x * 512 + tid; i < 128 * 2 * 64; i += G * 512) { const int ln = i & 63, nt_ = (i >> 6) & 1, gs = i >> 7; const int n = ln & 31;
            unsigned hw[4], lw[4];
#pragma unroll
            for (int jp = 0; jp < 4; ++jp) { float v[2];
#pragma unroll
                for (int q = 0; q < 2; ++q) { const int k = 16 * gs + 8 * (ln >> 5) + 2 * jp + q; float w = 0.f;
                    if (nt_ == 0) w = w_fine[((size_t)(n >> 3) * D + k) * 8 + (n & 7)]; else if (n < 4) w = w_coarse[(size_t)k * 4 + n];
                    v[q] = w * norm2_g[k]; }
                const unsigned h0 = f2bf(v[0]), h1 = f2bf(v[1]); hw[jp] = h0 | (h1 << 16);
                lw[jp] = f2bf(v[0] - __uint_as_float(h0 << 16)) | (f2bf(v[1] - __uint_as_float(h1 << 16)) << 16); }
            *(v4u*)(wfrag + ((size_t)((gs * 2 + nt_) * 2 + 0) * 64 + ln) * 8) = (v4u){hw[0], hw[1], hw[2], hw[3]};
            *(v4u*)(wfrag + ((size_t)((gs * 2 + nt_) * 2 + 1) * 64 + ln) * 8) = (v4u){lw[0], lw[1], lw[2], lw[3]}; }
        for (int m = gw; m < T; m += NGW) {
            const f32x4* xr = (const f32x4*)(x + (size_t)m * D) + lane; f32x4 v[8]; float s = 0.f;
#pragma unroll
            for (int j = 0; j < 8; ++j) { v[j] = xr[64 * j]; s += (v[j].x * v[j].x + v[j].y * v[j].y) + (v[j].z * v[j].z + v[j].w * v[j].w); }
            const float rstd = rsqrtf(wave_sum(s) * (1.f / D) + RMS_EPS);
            unsigned long long* o8 = (unsigned long long*)(XN + (size_t)m * D) + lane;
#pragma unroll
            for (int j = 0; j < 8; ++j) { const f32x4 gg = ((const f32x4*)norm1_g)[lane + 64 * j];
                o8[64 * j] = (unsigned long long)pk2(v[j].x * rstd * gg.x, v[j].y * rstd * gg.y) | ((unsigned long long)pk2(v[j].z * rstd * gg.z, v[j].w * rstd * gg.w) << 32); }
        }
        if (BOTH(0)) GRID_BAR();
    }

    if (IN(1)) {
        PHASE_WS(); WSPTR(bt2, WS_BT2); WSPTR(win_t, WS_WIN); WSPTR(wout_t, WS_WOUT); WSPTR(wout_t2, WS_WOUT2); WSPTR(XN, WS_XN); WSPTR(Qb, WS_Q);
        { pg8::DenseOrder S; S.init(T, INW, G, bx, XN, win_t, D, D);
          pg8::EpiStoreBf16 E{Qb, AW, AW, (size_t)T * AW, C2};
          pg8::gemm_phase<pg8::EpiStoreBf16, pg8::DenseOrder, true, false>(lds, D / 64, D, D, S, E); }
        { pg8::W2Order S{G, bx, (const char*)wout_t, (const char*)bt2};
          pg8::EpiStoreBf16 E{wout_t2, D, 0, 0, 1.f};
          int nt_w2 = 256 / 64; asm volatile("" : "+s"(nt_w2));
          pg8::gemm_phase<pg8::EpiStoreBf16, pg8::W2Order, true, false>(lds, nt_w2, D, 256, S, E); }
        if (BOTH(1)) GRID_BAR();
    }

    if (IN(2)) {
        PHASE_WS(); WSPTR(Qb, WS_Q); WSPTR(Kb, WS_K); WSPTR(Vb, WS_V); WSPTR(Ub, WS_U); WSPTR(A3, WS_A3);
        for (int tb = vcu; tb < T / 32; tb += G) {
#pragma unroll 1
            for (int k = 0; k < 8; ++k) { const int item = tid + 512 * k, tk = item >> 7, ch = item & 127, c0 = ch * 8, gi = ch >> 5, w = 2 << gi;
                const int t = tb * 32 + tk, pos = t & (SEQ - 1); const int cw = (pos + 1 < w) ? pos + 1 : w;
                float a[8];
#pragma unroll
                for (int j = 0; j < 8; ++j) a[j] = 0.f;
                const bf16* up = Ub + (size_t)t * AW + c0;
                v4u self = *(const v4u*)up;
                for (int i = 0; i < cw; ++i) { const v4u v = *(const v4u*)(up - (size_t)i * AW);
#pragma unroll
                    for (int j = 0; j < 4; ++j) { a[2 * j] += __uint_as_float(v[j] << 16); a[2 * j + 1] += __uint_as_float(v[j] & 0xffff0000u); } }
                const float inv = 1.0f / (float)cw; v4u o;
#pragma unroll
                for (int j = 0; j < 4; ++j) { const float s0 = __uint_as_float(self[j] << 16), s1 = __uint_as_float(self[j] & 0xffff0000u); o[j] = pk2(a[2 * j] * inv - s0, a[2 * j + 1] * inv - s1); }
                *(v4u*)(A3 + (size_t)t * D + AW + c0) = o; }
        }
        const float* lq1 = LDARG(3); const float* lk1 = LDARG(4); const float* lq2 = LDARG(5); const float* lk2 = LDARG(6); const float* subln_g = LDARG(7);
        float lam;
        { const float p1 = wave_sum(lq1[lane] * lk1[lane]), p2 = wave_sum(lq2[lane] * lk2[lane]); lam = expf(p1) - expf(p2) + 0.2f; }
        LAS float* wsf = (LAS float*)(lds + WSF_OFF);
        for (int p = vcu; p < 256; p += G) {
            const int bh = p >> 3, s = p & 7;
#pragma unroll 1
            for (int ui = 0; ui < 2; ++ui) att::attn_unit(bh >> 3, bh & 7, ui ? s : 15 - s, Qb, Kb, Vb, A3, subln_g, lam, lds, wsf);
        }
        if (BOTH(2)) GRID_BAR();
    }

    if (IN(3)) {
        PHASE_WS(); WSPTR(wout_t2, WS_WOUT2); WSPTR(A3, WS_A3); WSPTR(hb, WS_HB);
        pg8::DenseOrder S; S.init(T, D, G, bx, A3, wout_t2, D, D);
        const float* x = LDARG(0);
        pg8::EpiResid E{x, out, hb};
        pg8::gemm_phase<pg8::EpiResid, pg8::DenseOrder, true, false>(lds, D / 64, D, D, S, E);
        if (BOTH(3)) GRID_BAR();
    }

    if (IN(4)) {
        PHASE_WS(); WSPTR(wfrag, WS_WFRAG); unsigned* tokl = (unsigned*)(ws + WS_TOK); f32x2* swl = (f32x2*)(ws + WS_SW);
        const float* b_coarse = LDARG(13); const float* b_fine = LDARG(15);
        LAS float* part = (LAS float*)lds;
        LAS float* ssqs = (LAS float*)(lds + 65536);
        LAS float* logit = (LAS float*)(lds + 65536 + 1024);
        const int r32 = lane & 31, hi = lane >> 5;
        for (int rb = vcu; rb < T / 32; rb += G) {
            const int R0 = rb * 32;
            const float* hp = out + (size_t)(R0 + r32) * D + wave * 256 + 8 * hi;
            f32x16 acc0, acc1;
#pragma unroll
            for (int r = 0; r < 16; ++r) { acc0[r] = 0.f; acc1[r] = 0.f; }
            float ssq = 0.f;
#pragma unroll 4
            for (int s = 0; s < 16; ++s) {
                const f32x4 a = *(const f32x4*)(hp + 16 * s), b = *(const f32x4*)(hp + 16 * s + 4);
                ssq += (a.x * a.x + a.y * a.y) + (a.z * a.z + a.w * a.w) + (b.x * b.x + b.y * b.y) + (b.z * b.z + b.w * b.w);
                const float v[8] = {a.x, a.y, a.z, a.w, b.x, b.y, b.z, b.w};
                unsigned hw[4], lw[4];
#pragma unroll
                for (int jp = 0; jp < 4; ++jp) { const unsigned h0 = f2bf(v[2 * jp]), h1 = f2bf(v[2 * jp + 1]); hw[jp] = h0 | (h1 << 16);
                    lw[jp] = f2bf(v[2 * jp] - __uint_as_float(h0 << 16)) | (f2bf(v[2 * jp + 1] - __uint_as_float(h1 << 16)) << 16); }
                const bf16x8 ah = __builtin_bit_cast(bf16x8, (v4u){hw[0], hw[1], hw[2], hw[3]}), al = __builtin_bit_cast(bf16x8, (v4u){lw[0], lw[1], lw[2], lw[3]});
                const int gs = wave * 16 + s;
                const bf16x8* wf = (const bf16x8*)wfrag + (size_t)gs * 256 + lane;
                const bf16x8 bh0 = wf[0], bl0 = wf[64], bh1 = wf[128], bl1 = wf[192];
                acc0 = __builtin_amdgcn_mfma_f32_32x32x16_bf16(ah, bh0, acc0, 0, 0, 0);
                acc0 = __builtin_amdgcn_mfma_f32_32x32x16_bf16(al, bh0, acc0, 0, 0, 0);
                acc0 = __builtin_amdgcn_mfma_f32_32x32x16_bf16(ah, bl0, acc0, 0, 0, 0);
                acc1 = __builtin_amdgcn_mfma_f32_32x32x16_bf16(ah, bh1, acc1, 0, 0, 0);
                acc1 = __builtin_amdgcn_mfma_f32_32x32x16_bf16(al, bh1, acc1, 0, 0, 0);
                acc1 = __builtin_amdgcn_mfma_f32_32x32x16_bf16(ah, bl1, acc1, 0, 0, 0);
            }
            ssq += __shfl_xor(ssq, 32);
            __syncthreads();
#pragma unroll
            for (int r = 0; r < 16; ++r) { part[((wave * 2 + 0) * 16 + r) * 64 + lane] = acc0[r]; part[((wave * 2 + 1) * 16 + r) * 64 + lane] = acc1[r]; }
            if (hi == 0) ssqs[wave * 32 + r32] = ssq;
            __syncthreads();
#pragma unroll
            for (int q = 0; q < 4; ++q) { const int idx = tid + 512 * q; float sm = 0.f;
#pragma unroll
                for (int w = 0; w < 8; ++w) sm += part[w * 2048 + idx];
                const int nt_ = idx >> 10, r = (idx >> 6) & 15, ln = idx & 63; const int row = att::crow(r, ln >> 5), n = nt_ * 32 + (ln & 31);
                logit[row * 64 + n] = sm; }
            __syncthreads();
            if (tid < 32) {
                const int row = tid, token = R0 + row; float ss = 0.f;
#pragma unroll
                for (int w = 0; w < 8; ++w) ss += ssqs[w * 32 + row];
                const float rs = rsqrtf(ss * (1.f / D) + RMS_EPS);
                const LAS float* lg = logit + row * 64;
                float c[4];
#pragma unroll
                for (int k = 0; k < 4; ++k) c[k] = lg[32 + k] * rs + b_coarse[k];
                float cb = c[0]; int g = 0;
#pragma unroll
                for (int k = 1; k < 4; ++k) if (c[k] > cb) { cb = c[k]; g = k; }
                float den = 0.f;
#pragma unroll
                for (int k = 0; k < 4; ++k) den += expf(c[k] - cb);
                const float pg = 1.0f / den;
                float f[8];
#pragma unroll
                for (int k = 0; k < 8; ++k) f[k] = lg[g * 8 + k] * rs + b_fine[g * 8 + k];
                float v0 = f[0]; int i0 = 0;
#pragma unroll
                for (int k = 1; k < 8; ++k) if (f[k] > v0) { v0 = f[k]; i0 = k; }
                float v1 = -INFINITY; int i1 = 0;
#pragma unroll
                for (int k = 0; k < 8; ++k) if (k != i0 && f[k] > v1) { v1 = f[k]; i1 = k; }
                const float ex = expf(v1 - v0); const float w0 = pg / (1.0f + ex), w1 = pg * ex / (1.0f + ex);
                const int e0 = g * 8 + i0, e1 = g * 8 + i1;
                const unsigned s0 = __hip_atomic_fetch_add((unsigned*)(ctl + CW_CNT + 64 * e0), 1u, RLX_AGENT);
                const unsigned s1 = __hip_atomic_fetch_add((unsigned*)(ctl + CW_CNT + 64 * e1), 1u, RLX_AGENT);
                tokl[(size_t)e0 * 8192 + s0] = (unsigned)token; swl[(size_t)e0 * 8192 + s0] = (f32x2){rs, w0};
                tokl[(size_t)e1 * 8192 + s1] = (unsigned)token | 0x10000u; swl[(size_t)e1 * 8192 + s1] = (f32x2){rs, w1};
            }
        }
        __syncthreads();
        if (BOTH(4)) GRID_BAR();
    }

    if (IN(5) || IN(6)) {
        PHASE_WS(); WSPTR(hb, WS_HB); WSPTR(wgu_t, WS_WGU); WSPTR(wd_t, WS_WD); WSPTR(hmid, WS_HMID); WSPTR(yb, WS_Y); unsigned* tokl = (unsigned*)(ws + WS_TOK); f32x2* swl = (f32x2*)(ws + WS_SW);
        LAS int* tab = (LAS int*)(lds + TAB_OFF);
        if (tid < 32) tab[40 + tid] = (int)__hip_atomic_load((unsigned*)(ctl + CW_CNT + 64 * tid), RLX_AGENT);
        __syncthreads();
        if (tid == 0) { int acc = 0; for (int e = 0; e < 32; ++e) { tab[e] = acc; acc += (tab[40 + e] + 255) >> 8; } tab[32] = acc; }
        __syncthreads();
        if (IN(5)) {
            pg8::MoeOrder<4, true> S{G, bx, tab, (const char*)hb, (const char*)wgu_t, tokl};
            pg8::EpiGateUp E{hmid, swl};
            pg8::gemm_phase<pg8::EpiGateUp, pg8::MoeOrder<4, true>, true, true>(lds, D / 64, D, D, S, E);
            if (BOTH(5)) GRID_BAR();
        }
        if (IN(6)) {
            pg8::MoeOrder<8, false> S{G, bx, tab, (const char*)hmid, (const char*)wd_t, tokl};
            pg8::EpiDown E{yb, tokl};
            pg8::gemm_phase<pg8::EpiDown, pg8::MoeOrder<8, false>, true, false>(lds, FF / 64, FF, FF, S, E);
            if (BOTH(6)) GRID_BAR();
        }
    }

    if (IN(7)) {
        PHASE_WS(); WSPTR(yb, WS_Y);
        const float* final_g = LDARG(19);
        for (int m = gw; m < T; m += NGW) {
            f32x4* hr = (f32x4*)(out + (size_t)m * D) + lane; f32x4 v[8]; float s = 0.f;
            const v2u* y0 = (const v2u*)(yb + (size_t)m * D) + lane; const v2u* y1 = (const v2u*)(yb + ((size_t)T + m) * D) + lane;
#pragma unroll
            for (int j = 0; j < 8; ++j) { v[j] = hr[64 * j]; const v2u a = y0[64 * j], b = y1[64 * j];
                v[j].x += __uint_as_float(a.x << 16) + __uint_as_float(b.x << 16); v[j].y += __uint_as_float(a.x & 0xffff0000u) + __uint_as_float(b.x & 0xffff0000u);
                v[j].z += __uint_as_float(a.y << 16) + __uint_as_float(b.y << 16); v[j].w += __uint_as_float(a.y & 0xffff0000u) + __uint_as_float(b.y & 0xffff0000u);
                s += (v[j].x * v[j].x + v[j].y * v[j].y) + (v[j].z * v[j].z + v[j].w * v[j].w); }
            const float rstd = rsqrtf(wave_sum(s) * (1.f / D) + RMS_EPS);
#pragma unroll
            for (int j = 0; j < 8; ++j) { const f32x4 gg = ((const f32x4*)final_g)[lane + 64 * j]; hr[64 * j] = v[j] * rstd * gg; }
        }
    }
#undef IN
#undef BOTH
#undef GRID_BAR
}

extern "C" void kernel_launch(void* const* d_in, const int* in_sizes, int n_in, void* d_out, int out_size, void* d_ws, size_t ws_size, hipStream_t stream) {
    static int grid = 0;
    if (grid == 0) {
        if (n_in != 20 || out_size != T * D || ws_size < WS_END) { fprintf(stderr, "kernel_launch: unexpected shapes (n_in %d out %d ws %zu)\n", n_in, out_size, ws_size); grid = -1; return; }
        int dev = 0, cus = 0, per_cu = 0;
        if (hipGetDevice(&dev) != hipSuccess || hipDeviceGetAttribute(&cus, hipDeviceAttributeMultiprocessorCount, dev) != hipSuccess) { grid = -1; return; }
        if (hipFuncSetAttribute((const void*)hymba_fwd, hipFuncAttributeMaxDynamicSharedMemorySize, LDS_BYTES) != hipSuccess) { fprintf(stderr, "kernel_launch: hipFuncSetAttribute failed\n"); grid = -1; return; }
        if (hipOccupancyMaxActiveBlocksPerMultiprocessor(&per_cu, (const void*)hymba_fwd, 512, LDS_BYTES) != hipSuccess || per_cu < 1) fprintf(stderr, "kernel_launch: occupancy query reports %d\n", per_cu);
        (void)hipGetLastError();
        grid = cus;
    }
    if (grid < 0) return;
    (void)hipMemsetAsync((char*)d_ws + WS_CTL, 0, CTL_ZERO_BYTES, stream);
    Args a{};
    for (int i = 0; i < 20; ++i) a.in[i] = (const float*)d_in[i];
    a.out = (float*)d_out; a.ws = (unsigned char*)d_ws;
    if (MK_N_LAUNCHES == 1) { a.ph_lo = 0; a.ph_hi = NPH; a.li = 0; hipLaunchKernelGGL(hymba_fwd, dim3(grid), dim3(512), LDS_BYTES, stream, a); }
    else { for (int p = 0; p < NPH; ++p) { a.ph_lo = p; a.ph_hi = p + 1; a.li = p; hipLaunchKernelGGL(hymba_fwd, dim3(grid), dim3(512), LDS_BYTES, stream, a);
            if (p == PROBE_DUP) hipLaunchKernelGGL(hymba_fwd, dim3(grid), dim3(512), LDS_BYTES, stream, a); } }
}
```

```cpp
#include <hip/hip_runtime.h>
#include <hip/hip_bf16.h>
#include <cstdio>
#include <cstdint>

#ifndef MK_N_LAUNCHES
#define MK_N_LAUNCHES 1
#endif
#ifndef PROBE_DUP
#define PROBE_DUP -1
#endif

#define GAS __attribute__((address_space(1)))
#define LAS __attribute__((address_space(3)))
typedef unsigned short bf16;
typedef unsigned v4u __attribute__((ext_vector_type(4)));
typedef unsigned v2u __attribute__((ext_vector_type(2)));
typedef float f32x4 __attribute__((ext_vector_type(4)));
typedef float f32x2 __attribute__((ext_vector_type(2)));
typedef float f32x16 __attribute__((ext_vector_type(16)));
typedef short bf16x8 __attribute__((ext_vector_type(8)));
typedef short s16x4 __attribute__((ext_vector_type(4)));
typedef GAS unsigned gu32;
#define RLX_AGENT __ATOMIC_RELAXED, __HIP_MEMORY_SCOPE_AGENT
#define LDS_WAIT() asm volatile("s_waitcnt lgkmcnt(0)" ::: "memory")
#define VM_WAIT() asm volatile("s_waitcnt vmcnt(0)" ::: "memory")

constexpr int T = 8192, SEQ = 2048, D = 2048, INW = 4096, AW = 1024, NH = 8, NE = 32, FF = 512;
constexpr float RMS_EPS = 1e-6f;
constexpr float LOG2E = 1.4426950408889634f;
constexpr float C2 = 0.125f * LOG2E;

constexpr size_t MiB = 1u << 20;
constexpr size_t WS_CTL = 0, CTL_ZERO_BYTES = 1 * MiB;
constexpr size_t WS_WFRAG = 1 * MiB;
constexpr size_t WS_BT2 = 1 * MiB + 512 * 1024;
constexpr size_t WS_WIN = 2 * MiB;
constexpr size_t WS_WOUT = 18 * MiB;
constexpr size_t WS_WOUT2 = 26 * MiB;
constexpr size_t WS_TOK = 34 * MiB;
constexpr size_t WS_SW = 35 * MiB;
constexpr size_t WS_WGU = 40 * MiB;
constexpr size_t WS_WD = 168 * MiB;
constexpr size_t WS_XN = 232 * MiB;
constexpr size_t WS_HMID = 232 * MiB;
constexpr size_t WS_Q = 264 * MiB, WS_K = 280 * MiB, WS_V = 296 * MiB, WS_U = 312 * MiB;
constexpr size_t WS_Y = 264 * MiB;
constexpr size_t WS_A3 = 328 * MiB;
constexpr size_t WS_HB = 360 * MiB;
constexpr size_t WS_END = 392 * MiB;
constexpr int CW_CNT = 1024;
constexpr int CW_QATT = 3072, CW_QCVT = 3136;
constexpr int CW_BAR = 4096;

constexpr int RING_BYTES = 131072;
constexpr int WSF_OFF = RING_BYTES;
constexpr int TAB_OFF = WSF_OFF + 2048;
constexpr int MISC_OFF = TAB_OFF + 512;
constexpr int LDS_BYTES = 147456;

namespace pg8 {
#define PG8_LAS __attribute__((address_space(3)))
typedef unsigned short bf16_t;
typedef unsigned u32x4 __attribute__((ext_vector_type(4)));
constexpr int BM = 256, BK = 64, HALF = 128, HTB = HALF * BK * 2, STAGE_BYTES = 8 * HTB, NXCD = 8, WGM = 8;

__host__ __device__ __forceinline__ int lds_byte(int r, int c) { const int st = (r >> 4) * 2 + (c >> 5), rr = r & 15, cc = c & 31, ob = rr * 64 + cc * 2; return st * 1024 + (ob ^ (((ob >> 9) & 1) << 5)); }
__host__ __device__ __forceinline__ void stage_rc(int b, int& R, int& C) { const int st = b / 1024, sb = b % 1024, swz = sb ^ (((sb >> 9) & 1) << 5); R = (st >> 1) * 16 + swz / 64; C = (st & 1) * 32 + (swz % 64) / 2; }
__host__ __device__ __forceinline__ int perm32(int rho) { const int n = rho >> 4, i = rho & 15; return 8 * (i >> 2) + 4 * n + (i & 3); }

struct Unit { const char* a; const char* b; int orow, ocol, e, s0, cnt; };

__device__ __forceinline__ unsigned cvt_pk_bf16(float lo, float hi) { unsigned r; asm volatile("v_cvt_pk_bf16_f32 %0, %1, %2" : "=v"(r) : "v"(lo), "v"(hi)); return r; }

struct DenseOrder {
    int nM, nN, nwg, G, c; const char* A; const char* Bt; size_t tsA, tsB;
    __device__ void init(int M, int N, int G_, int c_, const void* A_, const void* Bt_, int lda, int ldb) { nM = M / BM; nN = N / BM; nwg = nM * nN; G = G_; c = c_; A = (const char*)A_; Bt = (const char*)Bt_; tsA = (size_t)BM * lda * 2; tsB = (size_t)BM * ldb * 2; }
    __device__ bool next(int i, Unit& u) const {
        const long L = (long)i * G + c; if (L >= nwg) return false;
        int wgid = (int)L; { const int q = nwg / NXCD, r = nwg % NXCD, xcd = wgid % NXCD, off = wgid / NXCD; wgid = (xcd < r ? xcd * (q + 1) : r * (q + 1) + (xcd - r) * q) + off; }
        const int nig = WGM * nN, gid = wgid / nig, fm = gid * WGM, gsz = (nM - fm) < WGM ? (nM - fm) : WGM;
        const int pm = fm + ((wgid % nig) % gsz), pn = (wgid % nig) / gsz;
        u.a = A + (size_t)pm * tsA; u.b = Bt + (size_t)pn * tsB; u.orow = pm * BM; u.ocol = pn * BM; u.e = 0; u.s0 = 0; u.cnt = 0; return true;
    }
    __device__ __forceinline__ unsigned row_off(const Unit&, int) const { return 0u; }
};

template <class Epi, class Sched, bool ALIGN_EPI, bool GATHER>
__device__ __forceinline__ void gemm_phase(PG8_LAS unsigned char* lds, const int nt, const int lda, const int ldb, const Sched& S, const Epi& E) {
    const int tid = threadIdx.x, wid = __builtin_amdgcn_readfirstlane(tid >> 6), lane = tid & 63, wr = wid >> 2, wc = wid & 3, fr = lane & 15, fq = lane >> 4;
    unsigned voffA[2], voffB[2]; int rA[2]; unsigned cA2[2];
#pragma unroll
    for (int i = 0; i < 2; ++i) { int R, C; stage_rc(tid * 16 + i * 8192, R, C); const int Rb = Epi::PERM ? ((R & ~31) + perm32(R & 31)) : R;
        voffA[i] = (unsigned)(R * lda + C) * 2u; voffB[i] = (unsigned)(Rb * ldb + C) * 2u; rA[i] = R; cA2[i] = (unsigned)C * 2u; }
    const size_t kstep = (size_t)(BK * 2);
    const size_t hstepA = (size_t)HALF * lda * 2, hstepB = (size_t)HALF * ldb * 2;
    const unsigned ldsw = (unsigned)wid * 1024u;
    const int aoff = lds_byte(wr * 64 + fr, fq * 8), boff = lds_byte(wc * 32 + fr, fq * 8);
#define PG8_SA(b, h) (((b) * 2 + (h)) * HTB)
#define PG8_SB(b, h) ((4 + (b) * 2 + (h)) * HTB)
#define PG8_STAGE_O(bufoff, gbase, o0, o1) do { \
        __builtin_amdgcn_global_load_lds((const unsigned*)((const char*)(gbase) + (o0)), (PG8_LAS unsigned*)(lds + (bufoff) + ldsw), 16, 0, 0); \
        __builtin_amdgcn_global_load_lds((const unsigned*)((const char*)(gbase) + (o1)), (PG8_LAS unsigned*)(lds + (bufoff) + ldsw + 8192), 16, 0, 0); } while (0)
#define PG8_STB(b, h, bptr) PG8_STAGE_O(PG8_SB(b, h), (bptr) + (h) * hstepB, voffB[0], voffB[1])
#define PG8_STA(b, h, aptr, O) do { if constexpr (GATHER) { PG8_STAGE_O(PG8_SA(b, h), (aptr), O[h][0], O[h][1]); } else { PG8_STAGE_O(PG8_SA(b, h), (aptr) + (h) * hstepA, voffA[0], voffA[1]); } } while (0)
#define PG8_LDA(dst, b, h) do { _Pragma("unroll") for (int m = 0; m < 4; ++m) _Pragma("unroll") for (int k = 0; k < 2; ++k) dst[m][k] = *(const PG8_LAS bf16x8*)(lds + PG8_SA(b, h) + aoff + m * 2048 + k * 1024); } while (0)
#define PG8_LDB(dst, b, h) do { _Pragma("unroll") for (int n = 0; n < 2; ++n) _Pragma("unroll") for (int k = 0; k < 2; ++k) dst[n][k] = *(const PG8_LAS bf16x8*)(lds + PG8_SB(b, h) + boff + n * 2048 + k * 1024); } while (0)
#define PG8_MMA(ai, bj, At, Bt) do { __builtin_amdgcn_s_setprio(1); _Pragma("unroll") for (int m = 0; m < 4; ++m) _Pragma("unroll") for (int n = 0; n < 2; ++n) _Pragma("unroll") for (int k = 0; k < 2; ++k) \
        acc[ai][bj][m][n] = __builtin_amdgcn_mfma_f32_16x16x32_bf16(Bt[n][k], At[m][k], acc[ai][bj][m][n], 0, 0, 0); __builtin_amdgcn_s_setprio(0); } while (0)
#define PG8_WAIT_V(n) asm volatile("s_waitcnt vmcnt(" #n ")" ::: "memory")
#define PG8_WAIT_L(n) asm volatile("s_waitcnt lgkmcnt(" #n ")" ::: "memory")
#define PG8_BAR __builtin_amdgcn_s_barrier()
#define PG8_SCHED __builtin_amdgcn_sched_barrier(0)
#define PG8_FETCH(u, O) do { _Pragma("unroll") for (int h_ = 0; h_ < 2; ++h_) _Pragma("unroll") for (int i_ = 0; i_ < 2; ++i_) O[h_][i_] = S.row_off(u, h_ * HALF + rA[i_]) + cA2[i_]; } while (0)
    Unit cur, nxt; int ui = 0;
    if (!S.next(0, cur)) return;
    f32x4 acc[2][2][4][2];
#pragma unroll
    for (int a = 0; a < 2; ++a)
#pragma unroll
        for (int b = 0; b < 2; ++b)
#pragma unroll
            for (int m = 0; m < 4; ++m)
#pragma unroll
                for (int n = 0; n < 2; ++n) acc[a][b][m][n] = (f32x4){0.f, 0.f, 0.f, 0.f};
    bf16x8 At[4][2], B0[2][2], B1[2][2];
    unsigned oC[2][2] = {{0u, 0u}, {0u, 0u}}, oN[2][2] = {{0u, 0u}, {0u, 0u}}, o2[2][2] = {{0u, 0u}, {0u, 0u}};
    if constexpr (GATHER) { PG8_FETCH(cur, oC); }
    const char* cA = cur.a; const char* cB = cur.b;
    PG8_STB(0, 0, cB); PG8_STB(0, 1, cB); PG8_STA(0, 0, cA, oC); PG8_STA(0, 1, cA, oC);
    if (wr == 1) PG8_BAR;
    PG8_WAIT_V(2); PG8_BAR;
    PG8_STB(1, 0, cB + kstep); PG8_STA(1, 0, cA + kstep, oC); PG8_STB(1, 1, cB + kstep);
    PG8_WAIT_V(6); PG8_BAR;
    for (;;) {
        const bool has_next = S.next(ui + 1, nxt);
        const char* nA = has_next ? nxt.a : cA; const char* nB = has_next ? nxt.b : cB;
        if constexpr (GATHER) { if (has_next) { PG8_FETCH(nxt, oN); } else {
#pragma unroll
            for (int h_ = 0; h_ < 2; ++h_)
#pragma unroll
                for (int i_ = 0; i_ < 2; ++i_) oN[h_][i_] = oC[h_][i_]; } }
        for (int t = 0; t < nt; t += 2) {
            const bool last = (t == nt - 2);
            const char* a1 = cA + (size_t)(t + 1) * kstep;
            const char* a2 = last ? nA : cA + (size_t)(t + 2) * kstep; const char* b2 = last ? nB : cB + (size_t)(t + 2) * kstep;
            const char* a3 = a2 + kstep; const char* b3 = b2 + kstep;
            if constexpr (GATHER) {
#pragma unroll
                for (int h_ = 0; h_ < 2; ++h_)
#pragma unroll
                    for (int i_ = 0; i_ < 2; ++i_) o2[h_][i_] = last ? oN[h_][i_] : oC[h_][i_]; }
            PG8_LDB(B0, 0, 0); PG8_LDB(B1, 0, 1); PG8_SCHED; PG8_LDA(At, 0, 0); PG8_STA(1, 1, a1, oC);
            PG8_WAIT_V(8); PG8_WAIT_L(0); PG8_BAR; PG8_MMA(0, 0, At, B0); PG8_MMA(0, 1, At, B1); PG8_BAR; PG8_SCHED;
            PG8_LDA(At, 0, 1); PG8_STB(0, 0, b2); PG8_STB(0, 1, b2); PG8_STA(0, 0, a2, o2);
            PG8_WAIT_V(8); PG8_WAIT_L(0); PG8_BAR; PG8_MMA(1, 0, At, B0); PG8_MMA(1, 1, At, B1); PG8_BAR; PG8_SCHED;
            PG8_LDB(B0, 1, 0); PG8_LDB(B1, 1, 1); PG8_SCHED; PG8_LDA(At, 1, 0); PG8_STA(0, 1, a2, o2);
            PG8_WAIT_V(8); PG8_WAIT_L(0); PG8_BAR; PG8_MMA(0, 0, At, B0); PG8_MMA(0, 1, At, B1); PG8_BAR; PG8_SCHED;
            PG8_LDA(At, 1, 1); PG8_STB(1, 0, b3); PG8_STB(1, 1, b3); PG8_STA(1, 0, a3, o2);
            PG8_WAIT_V(8); PG8_WAIT_L(0); PG8_BAR; PG8_MMA(1, 0, At, B0); PG8_MMA(1, 1, At, B1); PG8_BAR; PG8_SCHED;
        }
        if constexpr (ALIGN_EPI) { if (wr == 0) PG8_BAR; }
        E(acc, cur, wr, wc, fr, fq);
        if (!has_next) break;
#pragma unroll
        for (int a = 0; a < 2; ++a)
#pragma unroll
            for (int b = 0; b < 2; ++b)
#pragma unroll
                for (int m = 0; m < 4; ++m)
#pragma unroll
                    for (int n = 0; n < 2; ++n) acc[a][b][m][n] = (f32x4){0.f, 0.f, 0.f, 0.f};
        cur = nxt; cA = nA; cB = nB; ++ui;
        if constexpr (GATHER) {
#pragma unroll
            for (int h_ = 0; h_ < 2; ++h_)
#pragma unroll
                for (int i_ = 0; i_ < 2; ++i_) oC[h_][i_] = oN[h_][i_]; }
        if constexpr (ALIGN_EPI) { if (wr == 1) PG8_BAR; }
    }
    PG8_WAIT_V(0);
    if constexpr (!ALIGN_EPI) { if (wr == 0) PG8_BAR; }
    PG8_BAR;
#undef PG8_SA
#undef PG8_SB
#undef PG8_STAGE_O
#undef PG8_STB
#undef PG8_STA
#undef PG8_LDA
#undef PG8_LDB
#undef PG8_MMA
#undef PG8_WAIT_V
#undef PG8_WAIT_L
#undef PG8_BAR
#undef PG8_SCHED
#undef PG8_FETCH
}

struct EpiStoreBf16 {
    static constexpr bool PERM = true;
    bf16_t* O; int ldc; int split_cols; size_t split_stride; float scale0;
    __device__ __forceinline__ void operator()(const f32x4 (&acc)[2][2][4][2], const Unit& u, int wr, int wc, int fr, int fq) const {
        const int row0 = u.orow + wr * 64 + fr; int colt = u.ocol; bf16_t* base = O;
        float sc = 1.f; if (split_cols) { const int t = colt / split_cols; base += (size_t)t * split_stride; colt -= t * split_cols; if (t == 0) sc = scale0; }
        const int col0 = colt + wc * 32 + 8 * fq;
#pragma unroll
        for (int ai = 0; ai < 2; ++ai)
#pragma unroll
            for (int m = 0; m < 4; ++m) { bf16_t* rowp = base + (size_t)(row0 + ai * HALF + m * 16) * ldc + col0;
#pragma unroll
                for (int bj = 0; bj < 2; ++bj) { const f32x4 v0 = acc[ai][bj][m][0] * sc, v1 = acc[ai][bj][m][1] * sc;
                    u32x4 w; w.x = cvt_pk_bf16(v0[0], v0[1]); w.y = cvt_pk_bf16(v0[2], v0[3]); w.z = cvt_pk_bf16(v1[0], v1[1]); w.w = cvt_pk_bf16(v1[2], v1[3]);
                    *(u32x4*)(rowp + bj * HALF) = w; } }
    }
};
struct EpiResid {
    static constexpr bool PERM = false;
    const float* x; float* out; bf16_t* hb;
    __device__ __forceinline__ void operator()(const f32x4 (&acc)[2][2][4][2], const Unit& u, int wr, int wc, int fr, int fq) const {
        const int row0 = u.orow + wr * 64 + fr, col0 = u.ocol + wc * 32 + 4 * fq;
#pragma unroll
        for (int ai = 0; ai < 2; ++ai)
#pragma unroll
            for (int m = 0; m < 4; ++m) { const size_t off = (size_t)(row0 + ai * HALF + m * 16) * D + col0;
#pragma unroll
                for (int bj = 0; bj < 2; ++bj)
#pragma unroll
                    for (int n = 0; n < 2; ++n) { const size_t o = off + bj * HALF + n * 16; const f32x4 xv = *(const f32x4*)(x + o); const f32x4 hv = xv + acc[ai][bj][m][n];
                        *(f32x4*)(out + o) = hv; v2u w; w.x = cvt_pk_bf16(hv[0], hv[1]); w.y = cvt_pk_bf16(hv[2], hv[3]); *(v2u*)(hb + o) = w; } }
    }
};
struct EpiGateUp {
    static constexpr bool PERM = true;
    bf16_t* hmid; const f32x2* sw;
    __device__ __forceinline__ void operator()(const f32x4 (&acc)[2][2][4][2], const Unit& u, int wr, int wc, int fr, int fq) const {
        const int col0 = u.ocol + wc * 32 + 8 * fq;
#pragma unroll
        for (int ai = 0; ai < 2; ++ai)
#pragma unroll
            for (int m = 0; m < 4; ++m) { const int r = ai * HALF + wr * 64 + m * 16 + fr; const int slot = u.s0 + r; const bool valid = slot < u.cnt;
                f32x2 rw = (f32x2){0.f, 0.f}; if (valid) rw = sw[(size_t)u.e * 8192 + slot];
                float hv[8];
#pragma unroll
                for (int n = 0; n < 2; ++n)
#pragma unroll
                    for (int j = 0; j < 4; ++j) { const float g = acc[ai][0][m][n][j] * rw.x, up = acc[ai][1][m][n][j] * rw.x;
                        const float e = __builtin_amdgcn_exp2f(-g * LOG2E); const float s = g * __builtin_amdgcn_rcpf(1.0f + e); hv[n * 4 + j] = valid ? s * up * rw.y : 0.f; }
                u32x4 w; w.x = cvt_pk_bf16(hv[0], hv[1]); w.y = cvt_pk_bf16(hv[2], hv[3]); w.z = cvt_pk_bf16(hv[4], hv[5]); w.w = cvt_pk_bf16(hv[6], hv[7]);
                *(u32x4*)(hmid + (size_t)(u.orow + r) * FF + col0) = w; }
    }
};
struct EpiDown {
    static constexpr bool PERM = true;
    bf16_t* y; const unsigned* tok;
    __device__ __forceinline__ void operator()(const f32x4 (&acc)[2][2][4][2], const Unit& u, int wr, int wc, int fr, int fq) const {
        const int col0 = u.ocol + wc * 32 + 8 * fq;
#pragma unroll
        for (int ai = 0; ai < 2; ++ai)
#pragma unroll
            for (int m = 0; m < 4; ++m) { const int r = ai * HALF + wr * 64 + m * 16 + fr; const int slot = u.s0 + r;
                if (slot < u.cnt) { const unsigned ti = tok[(size_t)u.e * 8192 + slot]; const unsigned token = ti & 0xffffu, ks = ti >> 16;
                    bf16_t* rowp = y + ((size_t)ks * T + token) * D + col0;
#pragma unroll
                    for (int bj = 0; bj < 2; ++bj) { const f32x4 v0 = acc[ai][bj][m][0], v1 = acc[ai][bj][m][1];
                        u32x4 w; w.x = cvt_pk_bf16(v0[0], v0[1]); w.y = cvt_pk_bf16(v0[2], v0[3]); w.z = cvt_pk_bf16(v1[0], v1[1]); w.w = cvt_pk_bf16(v1[2], v1[3]);
                        *(u32x4*)(rowp + bj * HALF) = w; } } }
    }
};
struct W2Order {
    int G, c; const char* A; const char* Bt;
    __device__ bool next(int i, Unit& u) const { const int L = i * G + c; if (L >= 32) return false; const int g = L & 3, dt = L >> 2;
        u.a = A + ((size_t)dt * 256 * D + 1024 + 256 * g) * 2; u.b = Bt + (size_t)g * 65536 * 2; u.orow = dt * 256; u.ocol = 1024 + 256 * g; u.e = 0; u.s0 = 0; u.cnt = 0; return true; }
    __device__ __forceinline__ unsigned row_off(const Unit&, int) const { return 0u; }
};
template <int NPN, bool UP> struct MoeOrder {
    int G, c; const PG8_LAS int* tab; const char* A; const char* W; const unsigned* tok;
    __device__ bool next(int i, Unit& u) const {
        const int total = __builtin_amdgcn_readfirstlane(tab[32]) * NPN; const int L = i * G + c; if (L >= total) return false;
        const int Tt = L / NPN, pn = L % NPN; int e = 0;
        for (int k = 1; k < 32; ++k) e = (tab[k] <= Tt) ? k : e;
        e = __builtin_amdgcn_readfirstlane(e);
        const int mt = Tt - __builtin_amdgcn_readfirstlane(tab[e]);
        u.e = e; u.s0 = mt * 256; u.cnt = __builtin_amdgcn_readfirstlane(tab[40 + e]); u.orow = Tt * 256;
        if (UP) { u.a = A; u.b = W + ((size_t)(e * 4 + pn) * 256) * D * 2; u.ocol = pn * 128; }
        else { u.a = A + (size_t)Tt * 256 * FF * 2; u.b = W + ((size_t)e * D + pn * 256) * FF * 2; u.ocol = pn * 256; }
        return true;
    }
    __device__ __forceinline__ unsigned row_off(const Unit& u, int R) const {
        const int slot = u.s0 + R; unsigned token = 0u; if (slot < u.cnt) token = tok[(size_t)u.e * 8192 + slot] & 0xffffu; return token * (unsigned)(D * 2);
    }
};
}

namespace att {
constexpr int PITCH = 1024, QB = 128, KVB = 64, BUFB = 32768;
__device__ __forceinline__ int crow(int r, int hi) { return (r & 3) + 8 * (r >> 2) + 4 * hi; }
__device__ __forceinline__ unsigned cvtpk(float lo, float hi) { unsigned r; asm volatile("v_cvt_pk_bf16_f32 %0, %1, %2" : "=v"(r) : "v"(lo), "v"(hi)); return r; }
typedef short v4i16_t __attribute__((ext_vector_type(4)));
__device__ __forceinline__ s16x4 vtr(const LAS char* p) { return __builtin_bit_cast(s16x4, __builtin_amdgcn_ds_read_tr16_b64_v4i16((LAS v4i16_t*)p)); }
__device__ __forceinline__ float hswap_max(float m) { auto rr = __builtin_amdgcn_permlane32_swap(__float_as_uint(m), __float_as_uint(m), false, false); return fmaxf(__uint_as_float(rr[0]), __uint_as_float(rr[1])); }
__device__ __forceinline__ float hswap_sum(float m) { auto rr = __builtin_amdgcn_permlane32_swap(__float_as_uint(m), __float_as_uint(m), false, false); return __uint_as_float(rr[0]) + __uint_as_float(rr[1]); }

__device__ __forceinline__ void attn_unit(int b, int h, int qb, const bf16* Q, const bf16* K, const bf16* V, bf16* A3, const float* subg, float lam, LAS unsigned char* lds, LAS float* wsf_all) {
    int lane_ = threadIdx.x & 63; asm volatile("" : "+v"(lane_));
    const int tid = threadIdx.x, lane = lane_, r32 = lane & 31, hi = lane >> 5; const int wid = __builtin_amdgcn_readfirstlane(tid >> 6);
    const int jm = wid >> 2, rg = wid & 3;
    const long rowbase = (long)b * SEQ; const int q0 = qb * QB, qmin = q0 + 32 * rg, qmax = qmin + 31;
    const float slope2 = exp2f(-(float)(h + 1)) * LOG2E;
    LAS float* wsf = wsf_all + wid * 64;
    const bf16* Kh = K + rowbase * PITCH + h * 128; const bf16* Vh = V + rowbase * PITCH + h * 128;
    const int NT = (q0 + QB) / KVB;
    const bf16* ksrc = Kh + (long)lane * PITCH + wid * 8;
    const bf16* vsrc = Vh + (long)(16 * (wid & 3) + (lane >> 2)) * PITCH + (wid >> 2) * 32 + (lane & 3) * 8;
#define ATT_DMA(t, bsel) do { const long to_ = (long)(t) * KVB * PITCH; LAS unsigned char* bb_ = lds + (bsel) * BUFB; \
        __builtin_amdgcn_global_load_lds((const unsigned*)(ksrc + to_), (LAS unsigned*)(bb_ + wid * 1024), 16, 0, 0); \
        __builtin_amdgcn_global_load_lds((const unsigned*)(ksrc + to_ + 64), (LAS unsigned*)(bb_ + 8192 + wid * 1024), 16, 0, 0); \
        __builtin_amdgcn_global_load_lds((const unsigned*)(vsrc + to_), (LAS unsigned*)(bb_ + 16384 + (wid >> 2) * 4096 + (wid & 3) * 1024), 16, 0, 0); \
        __builtin_amdgcn_global_load_lds((const unsigned*)(vsrc + to_ + 64), (LAS unsigned*)(bb_ + 16384 + (2 + (wid >> 2)) * 4096 + (wid & 3) * 1024), 16, 0, 0); } while (0)
    ATT_DMA(0, 0);
    const bf16* Qw = Q + (rowbase + qmin) * PITCH + h * 128 + jm * 64;
    bf16x8 qr[4];
#pragma unroll
    for (int d0 = 0; d0 < 4; ++d0) qr[d0] = *(const bf16x8*)(Qw + (long)r32 * PITCH + d0 * 16 + hi * 8);
    float bias0[16];
#pragma unroll
    for (int r = 0; r < 16; ++r) bias0[r] = slope2 * (float)(crow(r, hi) - r32);
    const float s32 = 32.f * slope2;
    float mrow = -INFINITY, lsum = 0.f;
    f32x16 o[4];
#pragma unroll
    for (int d0 = 0; d0 < 4; ++d0)
#pragma unroll
        for (int r = 0; r < 16; ++r) o[d0][r] = 0.f;
    for (int t = 0; t < NT; ++t) {
        VM_WAIT(); __syncthreads();
        if (t + 1 < NT) ATT_DMA(t + 1, (t + 1) & 1);
        if (KVB * t <= qmax) {
            const LAS unsigned char* bb = lds + (t & 1) * BUFB;
            const LAS unsigned char* kb = bb + jm * 8192 + hi * 1024 + r32 * 16;
            f32x16 p0, p1;
#pragma unroll
            for (int r = 0; r < 16; ++r) { p0[r] = 0.f; p1[r] = 0.f; }
#pragma unroll
            for (int d0 = 0; d0 < 4; ++d0) {
                const bf16x8 k0 = *(const LAS bf16x8*)(kb + d0 * 2048), k1 = *(const LAS bf16x8*)(kb + d0 * 2048 + 512);
                p0 = __builtin_amdgcn_mfma_f32_32x32x16_bf16(k0, qr[d0], p0, 0, 0, 0);
                p1 = __builtin_amdgcn_mfma_f32_32x32x16_bf16(k1, qr[d0], p1, 0, 0, 0);
            }
#pragma unroll
            for (int r = 0; r < 16; ++r) { p0[r] += bias0[r]; p1[r] += bias0[r]; }
            if (KVB * t + 63 > qmin) {
                const int dq = qmin + r32 - KVB * t - 4 * hi;
#pragma unroll
                for (int r = 0; r < 16; ++r) { const int kk = (r & 3) + 8 * (r >> 2); if (kk > dq) p0[r] = -INFINITY; if (kk + 32 > dq) p1[r] = -INFINITY; }
            }
            const float tb = slope2 * (float)(KVB * t - qmin);
            float m0 = p0[0], m1 = p1[0];
#pragma unroll
            for (int r = 1; r < 16; ++r) { m0 = fmaxf(m0, p0[r]); m1 = fmaxf(m1, p1[r]); }
            float rmt = fmaxf(m0, m1 + s32) + tb; rmt = hswap_max(rmt);
            const float mnew = fmaxf(mrow, rmt);
            const float alpha = __builtin_amdgcn_exp2f(mrow - mnew);
            mrow = mnew;
            const float e0 = mnew - tb, e1 = e0 - s32;
            float sacc = 0.f;
#pragma unroll
            for (int r = 0; r < 16; ++r) { p0[r] = __builtin_amdgcn_exp2f(p0[r] - e0); p1[r] = __builtin_amdgcn_exp2f(p1[r] - e1); sacc += p0[r] + p1[r]; }
            lsum = lsum * alpha + sacc;
            if (!__all(alpha == 1.0f)) {
                if (hi == 0) wsf[r32] = alpha;
                LDS_WAIT();
                float al[16];
#pragma unroll
                for (int r = 0; r < 16; ++r) al[r] = wsf[crow(r, hi)];
#pragma unroll
                for (int d0 = 0; d0 < 4; ++d0)
#pragma unroll
                    for (int r = 0; r < 16; ++r) o[d0][r] *= al[r];
            }
            v4u pw[4];
            pw[0] = (v4u){cvtpk(p0[0], p0[1]), cvtpk(p0[2], p0[3]), cvtpk(p0[4], p0[5]), cvtpk(p0[6], p0[7])};
            pw[1] = (v4u){cvtpk(p0[8], p0[9]), cvtpk(p0[10], p0[11]), cvtpk(p0[12], p0[13]), cvtpk(p0[14], p0[15])};
            pw[2] = (v4u){cvtpk(p1[0], p1[1]), cvtpk(p1[2], p1[3]), cvtpk(p1[4], p1[5]), cvtpk(p1[6], p1[7])};
            pw[3] = (v4u){cvtpk(p1[8], p1[9]), cvtpk(p1[10], p1[11]), cvtpk(p1[12], p1[13]), cvtpk(p1[14], p1[15])};
            const LAS char* vb = (const LAS char*)(bb + 16384) + ((lane >> 4) & 1) * 32 + (lane & 3) * 8 + (4 * hi + ((lane & 15) >> 2)) * 64;
#pragma unroll
            for (int d0 = 0; d0 < 4; ++d0) {
#pragma unroll
                for (int ks = 0; ks < 4; ++ks) {
                    const s16x4 lo = vtr(vb + d0 * 4096 + ks * 1024), hh = vtr(vb + d0 * 4096 + ks * 1024 + 512);
                    const bf16x8 vf = (bf16x8){lo[0], lo[1], lo[2], lo[3], hh[0], hh[1], hh[2], hh[3]};
                    o[d0] = __builtin_amdgcn_mfma_f32_32x32x16_bf16(__builtin_bit_cast(bf16x8, pw[ks]), vf, o[d0], 0, 0, 0);
                }
            }
        }
    }
#undef ATT_DMA
    lsum = hswap_sum(lsum);
    if (hi == 0) wsf[r32] = __builtin_amdgcn_rcpf(lsum);
    LDS_WAIT();
    {
        float rl[16];
#pragma unroll
        for (int r = 0; r < 16; ++r) rl[r] = wsf[crow(r, hi)];
#pragma unroll
        for (int d0 = 0; d0 < 4; ++d0)
#pragma unroll
            for (int r = 0; r < 16; ++r) o[d0][r] *= rl[r];
    }
    __syncthreads();
    LAS float* X = (LAS float*)lds + rg * 4096;
    if (jm == 1) {
#pragma unroll
        for (int d0 = 0; d0 < 4; ++d0)
#pragma unroll
            for (int r = 0; r < 16; ++r) X[(d0 * 16 + r) * 64 + lane] = o[d0][r];
    }
    __syncthreads();
    if (jm == 0) {
        float ss[16];
#pragma unroll
        for (int r = 0; r < 16; ++r) ss[r] = 0.f;
#pragma unroll
        for (int d0 = 0; d0 < 4; ++d0)
#pragma unroll
            for (int r = 0; r < 16; ++r) { const float dv = o[d0][r] - lam * X[(d0 * 16 + r) * 64 + lane]; o[d0][r] = dv; ss[r] += dv * dv; }
#pragma unroll
        for (int r = 0; r < 16; ++r) {
#pragma unroll
            for (int off = 1; off < 32; off <<= 1) ss[r] += __shfl_xor(ss[r], off);
            ss[r] = rsqrtf(ss[r] * (1.0f / 128.0f) + RMS_EPS) * 0.8f;
        }
        bf16* Ow = A3 + (rowbase + qmin) * D + h * 128 + r32;
#pragma unroll
        for (int d0 = 0; d0 < 4; ++d0) { const float gg = subg[d0 * 32 + r32];
#pragma unroll
            for (int r = 0; r < 16; ++r) { const float v = o[d0][r] * ss[r] * gg; const unsigned pk = cvtpk(v, v); Ow[(long)crow(r, hi) * D + d0 * 32] = (bf16)(pk & 0xffffu); } }
    }
    __syncthreads();
}
}

#define XB_TMO      128
#define XB_XCNT(j)  (256  + 64 * (j))
#define XB_XSUB(j)  (1280 + 64 * (j))
#define XB_XGEN(j)  (2304 + 64 * (j))
#define XB_TOP      3328
#define XB_TOPGEN   3392
#define XCD_BAR_WORDS 3456
#define XB_SPIN_CAP (1u << 18)

__device__ __forceinline__ unsigned xb_ld(unsigned* p)              { return __hip_atomic_load(p, __ATOMIC_RELAXED, __HIP_MEMORY_SCOPE_AGENT); }
__device__ __forceinline__ unsigned xb_add(unsigned* p, unsigned v) { return __hip_atomic_fetch_add(p, v, __ATOMIC_RELAXED, __HIP_MEMORY_SCOPE_AGENT); }
__device__ __forceinline__ unsigned xb_xcc_id() { return (unsigned)__builtin_amdgcn_s_getreg((3 << 11) | 20) & 0xFu; }
#define XB_SPIN(cond, bar) do { unsigned _sp = 0; while (cond) { __builtin_amdgcn_s_sleep(1); \
    if ((++_sp & 255u) == 0u) { if (xb_ld(&(bar)[XB_TMO])) break; if (_sp > XB_SPIN_CAP) { atomicAdd(&(bar)[XB_TMO], 1u); break; } } } } while (0)

struct XcdBarrier { unsigned* bar; unsigned x; volatile LAS unsigned* st; };

__device__ __forceinline__ XcdBarrier xcd_barrier_post(unsigned* bar, volatile LAS unsigned* st) {
    XcdBarrier b; b.bar = bar; b.x = xb_xcc_id(); b.st = st;
    if (threadIdx.x == 0) (void)xb_add(&bar[XB_XCNT(b.x)], 1u);
    return b;
}
__device__ __forceinline__ void xcd_barrier_complete(unsigned* bar, unsigned x, unsigned& nloc, unsigned& nx) {
    const unsigned G = gridDim.x * gridDim.y * gridDim.z;
    unsigned sum, cnt, mine, sp = 0u;
    for (;;) {
        sum = 0u; cnt = 0u; mine = 0u;
#pragma unroll
        for (unsigned j = 0; j < 16; ++j) { const unsigned c = xb_ld(&bar[XB_XCNT(j)]); sum += c; cnt += (c > 0u) ? 1u : 0u; mine = (j == x) ? c : mine; }
        if (sum == G) break;
        __builtin_amdgcn_s_sleep(1);
        if ((++sp & 255u) == 0u) { if (xb_ld(&bar[XB_TMO])) break; if (sp > XB_SPIN_CAP) { atomicAdd(&bar[XB_TMO], 1u); break; } }
    }
    nloc = mine > 0u ? mine : 1u; nx = cnt > 0u ? cnt : 1u;
}
__device__ __forceinline__ void xcd_barrier(const XcdBarrier& b) {
    asm volatile("s_waitcnt vmcnt(0)" ::: "memory");
    __syncthreads();
    if (threadIdx.x == 0) {
        unsigned* bar = b.bar;
        __builtin_amdgcn_s_waitcnt(0);
        unsigned nloc = b.st[0], nx = b.st[1];
        if (nloc == 0u) { xcd_barrier_complete(bar, b.x, nloc, nx); b.st[0] = nloc; b.st[1] = nx; }
        const unsigned old = xb_add(&bar[XB_XSUB(b.x)], 1u);
        const unsigned gen = old / nloc;
        if (old + 1u == (gen + 1u) * nloc) {
            __builtin_amdgcn_fence(__ATOMIC_RELEASE, "agent");
            asm volatile("s_waitcnt vmcnt(0)" ::: "memory");
            const unsigned og = xb_add(&bar[XB_TOP], 1u);
            const unsigned tg = og / nx;
            if (og + 1u == (tg + 1u) * nx) xb_add(&bar[XB_TOPGEN], 1u);
            else XB_SPIN(xb_ld(&bar[XB_TOPGEN]) == tg, bar);
            __builtin_amdgcn_fence(__ATOMIC_ACQUIRE, "agent");
            xb_add(&bar[XB_XGEN(b.x)], 1u);
            asm volatile("s_waitcnt vmcnt(0)" ::: "memory");
        } else {
            XB_SPIN(xb_ld(&bar[XB_XGEN(b.x)]) == gen, bar);
            __builtin_amdgcn_fence(__ATOMIC_ACQUIRE, "agent");
            asm volatile("s_waitcnt vmcnt(0)" ::: "memory");
        }
    }
    __syncthreads();
}

__device__ __forceinline__ unsigned f2bf(float f) { unsigned u = __builtin_bit_cast(unsigned, f); return (u + 0x7fffu + ((u >> 16) & 1u)) >> 16; }
__device__ __forceinline__ unsigned pk2(float lo, float hi) { return f2bf(lo) | (f2bf(hi) << 16); }
__device__ __forceinline__ float bf2f(unsigned short v) { return __uint_as_float(((unsigned)v) << 16); }
__device__ __forceinline__ float wave_sum(float v) {
#pragma unroll
    for (int o = 1; o < 64; o <<= 1) v += __shfl_xor(v, o);
    return v;
}
__device__ __forceinline__ void p0_transpose_item(const float* src, int N, bf16* dst, int ldt, const float* ks, LAS unsigned* scr, int lane) {
    asm volatile("" : "+v"(lane));
    const int kq = lane >> 4, nq = lane & 15;
    const float* sp = src + (size_t)(2 * kq) * N + 4 * nq;
    f32x4 v[16];
#pragma unroll
    for (int i = 0; i < 8; ++i) { v[2 * i] = *(const f32x4*)(sp + (size_t)(8 * i) * N); v[2 * i + 1] = *(const f32x4*)(sp + (size_t)(8 * i + 1) * N); }
    if (ks) {
#pragma unroll
        for (int i = 0; i < 8; ++i) { const float s0 = ks[8 * i + 2 * kq], s1 = ks[8 * i + 2 * kq + 1]; v[2 * i] = v[2 * i] * s0; v[2 * i + 1] = v[2 * i + 1] * s1; }
    }
#pragma unroll
    for (int i = 0; i < 8; ++i)
#pragma unroll
        for (int j = 0; j < 4; ++j) scr[(4 * nq + j) * 33 + 4 * i + kq] = pk2(v[2 * i][j], v[2 * i + 1][j]);
    LDS_WAIT(); asm volatile("" ::: "memory");
    const int c = lane & 7;
#pragma unroll
    for (int jj = 0; jj < 8; ++jj) { const int n = (lane >> 3) + 8 * jj; const LAS unsigned* s = scr + n * 33 + 4 * c;
        v4u o; o.x = s[0]; o.y = s[1]; o.z = s[2]; o.w = s[3];
        *(GAS v4u*)(dst + (size_t)n * ldt + 8 * c) = o; }
    LDS_WAIT(); asm volatile("" ::: "memory");
}

template <int IDX> __device__ __forceinline__ const float* ldarg_ptr() {
    auto ka = __builtin_amdgcn_kernarg_segment_ptr();
    unsigned long long v; asm volatile("s_load_dwordx2 %0, %1, %2\n\ts_waitcnt lgkmcnt(0)" : "=s"(v) : "s"(ka), "i"(IDX * 8) : "memory"); return (const float*)v;
}
struct Args { const float* in[20]; float* out; unsigned char* ws; int ph_lo, ph_hi, li, pad; };
constexpr int NPH = 8;

__global__ void __launch_bounds__(512, 2) hymba_fwd(Args args) {
    extern __shared__ __attribute__((aligned(16))) unsigned char lds_raw[];
    LAS unsigned char* lds = (LAS unsigned char*)lds_raw;
    const int tid = threadIdx.x, lane = tid & 63, wave = __builtin_amdgcn_readfirstlane(tid >> 6);
    const int G = gridDim.x; const int bx = blockIdx.x; const int vcu = (G % 8 == 0) ? (bx % 8) * (G / 8) + bx / 8 : bx;
    gu32* ctl = (gu32*)(args.ws + WS_CTL);
#define LDARG(i) ldarg_ptr<i>()
#define WSPTR(name, off) bf16* name = (bf16*)(ws + (off))
#define PHASE_WS() unsigned char* ws = args.ws; asm volatile("" : "+s"(ws)); float* out = args.out; asm volatile("" : "+s"(out)); (void)out
    volatile LAS unsigned* MISC = (volatile LAS unsigned*)(lds + MISC_OFF);
    if (tid < 4) MISC[tid] = 0u;
    __syncthreads();
    const int lo = args.ph_lo, hi_ph = args.ph_hi;
    const bool use_bar = (hi_ph - lo) > 1;
    XcdBarrier bar; bar.bar = (unsigned*)(ctl + CW_BAR); bar.x = 0; bar.st = nullptr;
    if (use_bar) bar = xcd_barrier_post((unsigned*)(ctl + CW_BAR), MISC);
#ifndef PHASE_MASK
#define PHASE_MASK 0xFF
#endif
#define IN(k) (((PHASE_MASK >> (k)) & 1) && lo <= (k) && (k) < hi_ph)
#define BOTH(k) (IN(k) && IN((k) + 1))
#define GRID_BAR() do { xcd_barrier(bar); } while (0)
    const int gw = vcu * 8 + wave, NGW = G * 8;

    if (IN(0)) {
        PHASE_WS(); WSPTR(wfrag, WS_WFRAG); WSPTR(bt2, WS_BT2); WSPTR(win_t, WS_WIN); WSPTR(wout_t, WS_WOUT); WSPTR(wout_t2, WS_WOUT2); WSPTR(XN, WS_XN);
        const float* x = LDARG(0); const float* norm1_g = LDARG(1); const float* w_in = LDARG(2); const float* pool_w = LDARG(8); const float* pool_scale = LDARG(9); const float* w_out = LDARG(10);
        const float* norm2_g = LDARG(11); const float* w_coarse = LDARG(12); const float* w_fine = LDARG(14);
        LAS unsigned* scr = (LAS unsigned*)(lds + wave * 16384);
        constexpr int I_IN = 32 * 64, I_OUT = 32 * 32, I_OUT2 = 16 * 32;
        constexpr int NITEMS = I_IN + I_OUT + I_OUT2;
        for (int it = gw; it < NITEMS; it += NGW) {
            int r = it;
            if (r < I_IN) { const int kb = r / 64, nb = r % 64, k0 = 64 * kb, n0 = 64 * nb; p0_transpose_item(w_in + (size_t)k0 * INW + n0, INW, win_t + (size_t)n0 * D + k0, D, nullptr, scr, lane); continue; } r -= I_IN;
            if (r < I_OUT) { const int kb = r / 32, nb = r % 32, k0 = 64 * kb, n0 = 64 * nb; p0_transpose_item(w_out + (size_t)k0 * D + n0, D, wout_t + (size_t)n0 * D + k0, D, nullptr, scr, lane); continue; } r -= I_OUT;
            { const int kb = r / 32, nb = r % 32, k0 = 64 * kb, n0 = 64 * nb; p0_transpose_item(w_out + (size_t)k0 * D + n0, D, wout_t2 + (size_t)n0 * D + k0, D, nullptr, scr, lane); }
        }
        for (int i = blockIdx.x * 512 + tid; i < 4 * 256 * 256 / 4; i += G * 512) { const int e4 = (i & 63) * 4, gc = i >> 6, g = gc >> 8;
            const f32x4 w = *(const f32x4*)(pool_w + (size_t)gc * 256 + e4); const f32x4 s = *(const f32x4*)(pool_scale + g * 256 + e4);
            v2u o; o.x = pk2(w[0] * s[0], w[1] * s[1]); o.y = pk2(w[2] * s[2], w[3] * s[3]); *(v2u*)(bt2 + (size_t)gc * 256 + e4) = o; }
        for (int i = blockIdx.x * 512 + tid; i < 128 * 2 * 64; i += G * 512) { const int ln = i & 63, nt_ = (i >> 6) & 1, gs = i >> 7; const int n = ln & 31;
            unsigned hw[4], lw[4];
#pragma unroll
            for (int jp = 0; jp < 4; ++jp) { float v[2];
#pragma unroll
                for (int q = 0; q < 2; ++q) { const int k = 16 * gs + 8 * (ln >> 5) + 2 * jp + q; float w = 0.f;
                    if (nt_ == 0) w = w_fine[((size_t)(n >> 3) * D + k) * 8 + (n & 7)]; else if (n < 4) w = w_coarse[(size_t)k * 4 + n];
                    v[q] = w * norm2_g[k]; }
                const unsigned h0 = f2bf(v[0]), h1 = f2bf(v[1]); hw[jp] = h0 | (h1 << 16);
                lw[jp] = f2bf(v[0] - __uint_as_float(h0 << 16)) | (f2bf(v[1] - __uint_as_float(h1 << 16)) << 16); }
            *(v4u*)(wfrag + ((size_t)((gs * 2 + nt_) * 2 + 0) * 64 + ln) * 8) = (v4u){hw[0], hw[1], hw[2], hw[3]};
            *(v4u*)(wfrag + ((size_t)((gs * 2 + nt_) * 2 + 1) * 64 + ln) * 8) = (v4u){lw[0], lw[1], lw[2], lw[3]}; }
        for (int m = gw; m < T; m += NGW) {
            const f32x4* xr = (const f32x4*)(x + (size_t)m * D) + lane; f32x4 v[8]; float s = 0.f;
#pragma unroll
            for (int j = 0; j < 8; ++j) { v[j] = xr[64 * j]; s += (v[j].x * v[j].x + v[j].y * v[j].y) + (v[j].z * v[j].z + v[j].w * v[j].w); }
            const float rstd = rsqrtf(wave_sum(s) * (1.f / D) + RMS_EPS);
            unsigned long long* o8 = (unsigned long long*)(XN + (size_t)m * D) + lane;
#pragma unroll
            for (int j = 0; j < 8; ++j) { const f32x4 gg = ((const f32x4*)norm1_g)[lane + 64 * j];
                o8[64 * j] = (unsigned long long)pk2(v[j].x * rstd * gg.x, v[j].y * rstd * gg.y) | ((unsigned long long)pk2(v[j].z * rstd * gg.z, v[j].w * rstd * gg.w) << 32); }
        }
        if (BOTH(0)) GRID_BAR();
    }

    if (IN(1)) {
        PHASE_WS(); WSPTR(bt2, WS_BT2); WSPTR(win_t, WS_WIN); WSPTR(wout_t, WS_WOUT); WSPTR(wout_t2, WS_WOUT2); WSPTR(XN, WS_XN); WSPTR(Qb, WS_Q);
        { pg8::DenseOrder S; S.init(T, INW, G, bx, XN, win_t, D, D);
          pg8::EpiStoreBf16 E{Qb, AW, AW, (size_t)T * AW, C2};
          pg8::gemm_phase<pg8::EpiStoreBf16, pg8::DenseOrder, true, false>(lds, D / 64, D, D, S, E); }
        { pg8::W2Order S{G, bx, (const char*)wout_t, (const char*)bt2};
          pg8::EpiStoreBf16 E{wout_t2, D, 0, 0, 1.f};
          int nt_w2 = 256 / 64; asm volatile("" : "+s"(nt_w2));
          pg8::gemm_phase<pg8::EpiStoreBf16, pg8::W2Order, true, false>(lds, nt_w2, D, 256, S, E); }
        if (BOTH(1)) GRID_BAR();
    }

    if (IN(2)) {
        PHASE_WS(); WSPTR(Qb, WS_Q); WSPTR(Kb, WS_K); WSPTR(Vb, WS_V); WSPTR(Ub, WS_U); WSPTR(A3, WS_A3);
        for (int tb = vcu; tb < T / 32; tb += G) {
#pragma unroll 1
            for (int k = 0; k < 8; ++k) { const int item = tid + 512 * k, tk = item >> 7, ch = item & 127, c0 = ch * 8, gi = ch >> 5, w = 2 << gi;
                const int t = tb * 32 + tk, pos = t & (SEQ - 1); const int cw = (pos + 1 < w) ? pos + 1 : w;
                float a[8];
#pragma unroll
                for (int j = 0; j < 8; ++j) a[j] = 0.f;
                const bf16* up = Ub + (size_t)t * AW + c0;
                v4u self = *(const v4u*)up;
                for (int i = 0; i < cw; ++i) { const v4u v = *(const v4u*)(up - (size_t)i * AW);
#pragma unroll
                    for (int j = 0; j < 4; ++j) { a[2 * j] += __uint_as_float(v[j] << 16); a[2 * j + 1] += __uint_as_float(v[j] & 0xffff0000u); } }
                const float inv = 1.0f / (float)cw; v4u o;
#pragma unroll
                for (int j = 0; j < 4; ++j) { const float s0 = __uint_as_float(self[j] << 16), s1 = __uint_as_float(self[j] & 0xffff0000u); o[j] = pk2(a[2 * j] * inv - s0, a[2 * j + 1] * inv - s1); }
                *(v4u*)(A3 + (size_t)t * D + AW + c0) = o; }
        }
        const float* lq1 = LDARG(3); const float* lk1 = LDARG(4); const float* lq2 = LDARG(5); const float* lk2 = LDARG(6); const float* subln_g = LDARG(7);
        float lam;
        { const float p1 = wave_sum(lq1[lane] * lk1[lane]), p2 = wave_sum(lq2[lane] * lk2[lane]); lam = expf(p1) - expf(p2) + 0.2f; }
        LAS float* wsf = (LAS float*)(lds + WSF_OFF);
        {
            volatile LAS int* qslot = (volatile LAS int*)(lds + MISC_OFF + 32);
            LAS unsigned* scr = (LAS unsigned*)(lds + wave * 16384);
            const bool prefer_cvt = (vcu & 7) < 3;
            bool att_left = true, cvt_left = true;
            constexpr int NATT = 512, NCH = 768, I_GU = 2 * 32 * 8 * 32;
            for (;;) {
                int kind = -1, idx = 0;
#pragma unroll 1
                for (int pass = 0; pass < 2 && kind < 0; ++pass) {
                    const bool try_cvt = (pass == 0) ? prefer_cvt : !prefer_cvt;
                    if (try_cvt ? cvt_left : att_left) {
                        if (tid == 0) qslot[0] = (int)__hip_atomic_fetch_add((unsigned*)(ctl + (try_cvt ? CW_QCVT : CW_QATT)), 1u, RLX_AGENT);
                        __syncthreads();
                        idx = qslot[0];
                        __syncthreads();
                        if (idx < (try_cvt ? NCH : NATT)) kind = try_cvt ? 1 : 0; else { if (try_cvt) cvt_left = false; else att_left = false; }
                    }
                }
                if (kind < 0) break;
                if (kind == 1) {
                    const float* norm2_g = LDARG(11); const float* w_gate = LDARG(16); const float* w_up = LDARG(17); const float* w_down = LDARG(18);
                    unsigned char* ws2 = args.ws; asm volatile("" : "+s"(ws2)); bf16* wgu_t = (bf16*)(ws2 + WS_WGU); bf16* wd_t = (bf16*)(ws2 + WS_WD);
#pragma unroll 1
                    for (int i = 0; i < 4; ++i) { int r = idx * 32 + wave * 4 + i;
                        if (r < I_GU) { const bool up = r >= I_GU / 2; if (up) r -= I_GU / 2; const int e = r / 256, q = r % 256, kb = q / 8, nb = q % 8, k0 = 64 * kb, n0 = 64 * nb;
                            const float* W = (up ? w_up : w_gate) + (size_t)e * D * FF; const int drow = (n0 >> 7) * 256 + (up ? 128 : 0) + (n0 & 127);
                            p0_transpose_item(W + (size_t)k0 * FF + n0, FF, wgu_t + ((size_t)e * 1024 + drow) * D + k0, D, norm2_g + k0, scr, lane); }
                        else { r -= I_GU; const int e = r / 256, q = r % 256, kb = q / 32, nb = q % 32, k0 = 64 * kb, n0 = 64 * nb;
                            p0_transpose_item(w_down + (size_t)e * FF * D + (size_t)k0 * D + n0, D, wd_t + ((size_t)e * D + n0) * FF + k0, FF, nullptr, scr, lane); } }
                } else {
                    const int qb = 15 - (idx >> 5), bh = idx & 31;
                    att::attn_unit(bh >> 3, bh & 7, qb, Qb, Kb, Vb, A3, subln_g, lam, lds, wsf);
                }
            }
        }
        if (BOTH(2)) GRID_BAR();
    }

    if (IN(3)) {
        PHASE_WS(); WSPTR(wout_t2, WS_WOUT2); WSPTR(A3, WS_A3); WSPTR(hb, WS_HB);
        pg8::DenseOrder S; S.init(T, D, G, bx, A3, wout_t2, D, D);
        const float* x = LDARG(0);
        pg8::EpiResid E{x, out, hb};
        pg8::gemm_phase<pg8::EpiResid, pg8::DenseOrder, true, false>(lds, D / 64, D, D, S, E);
        if (BOTH(3)) GRID_BAR();
    }

    if (IN(4)) {
        PHASE_WS(); WSPTR(wfrag, WS_WFRAG); unsigned* tokl = (unsigned*)(ws + WS_TOK); f32x2* swl = (f32x2*)(ws + WS_SW);
        const float* b_coarse = LDARG(13); const float* b_fine = LDARG(15);
        LAS float* part = (LAS float*)lds;
        LAS float* ssqs = (LAS float*)(lds + 65536);
        LAS float* logit = (LAS float*)(lds + 65536 + 1024);
        const int r32 = lane & 31, hi = lane >> 5;
        for (int rb = vcu; rb < T / 32; rb += G) {
            const int R0 = rb * 32;
            const float* hp = out + (size_t)(R0 + r32) * D + wave * 256 + 8 * hi;
            f32x16 acc0, acc1;
#pragma unroll
            for (int r = 0; r < 16; ++r) { acc0[r] = 0.f; acc1[r] = 0.f; }
            float ssq = 0.f;
#pragma unroll 4
            for (int s = 0; s < 16; ++s) {
                const f32x4 a = *(const f32x4*)(hp + 16 * s), b = *(const f32x4*)(hp + 16 * s + 4);
                ssq += (a.x * a.x + a.y * a.y) + (a.z * a.z + a.w * a.w) + (b.x * b.x + b.y * b.y) + (b.z * b.z + b.w * b.w);
                const float v[8] = {a.x, a.y, a.z, a.w, b.x, b.y, b.z, b.w};
                unsigned hw[4], lw[4];
#pragma unroll
                for (int jp = 0; jp < 4; ++jp) { const unsigned h0 = f2bf(v[2 * jp]), h1 = f2bf(v[2 * jp + 1]); hw[jp] = h0 | (h1 << 16);
                    lw[jp] = f2bf(v[2 * jp] - __uint_as_float(h0 << 16)) | (f2bf(v[2 * jp + 1] - __uint_as_float(h1 << 16)) << 16); }
                const bf16x8 ah = __builtin_bit_cast(bf16x8, (v4u){hw[0], hw[1], hw[2], hw[3]}), al = __builtin_bit_cast(bf16x8, (v4u){lw[0], lw[1], lw[2], lw[3]});
                const int gs = wave * 16 + s;
                const bf16x8* wf = (const bf16x8*)wfrag + (size_t)gs * 256 + lane;
                const bf16x8 bh0 = wf[0], bl0 = wf[64], bh1 = wf[128], bl1 = wf[192];
                acc0 = __builtin_amdgcn_mfma_f32_32x32x16_bf16(ah, bh0, acc0, 0, 0, 0);
                acc0 = __builtin_amdgcn_mfma_f32_32x32x16_bf16(al, bh0, acc0, 0, 0, 0);
                acc0 = __builtin_amdgcn_mfma_f32_32x32x16_bf16(ah, bl0, acc0, 0, 0, 0);
                acc1 = __builtin_amdgcn_mfma_f32_32x32x16_bf16(ah, bh1, acc1, 0, 0, 0);
                acc1 = __builtin_amdgcn_mfma_f32_32x32x16_bf16(al, bh1, acc1, 0, 0, 0);
                acc1 = __builtin_amdgcn_mfma_f32_32x32x16_bf16(ah, bl1, acc1, 0, 0, 0);
            }
            ssq += __shfl_xor(ssq, 32);
            __syncthreads();
#pragma unroll
            for (int r = 0; r < 16; ++r) { part[((wave * 2 + 0) * 16 + r) * 64 + lane] = acc0[r]; part[((wave * 2 + 1) * 16 + r) * 64 + lane] = acc1[r]; }
            if (hi == 0) ssqs[wave * 32 + r32] = ssq;
            __syncthreads();
#pragma unroll
            for (int q = 0; q < 4; ++q) { const int idx = tid + 512 * q; float sm = 0.f;
#pragma unroll
                for (int w = 0; w < 8; ++w) sm += part[w * 2048 + idx];
                const int nt_ = idx >> 10, r = (idx >> 6) & 15, ln = idx & 63; const int row = att::crow(r, ln >> 5), n = nt_ * 32 + (ln & 31);
                logit[row * 64 + n] = sm; }
            __syncthreads();
            if (tid < 32) {
                const int row = tid, token = R0 + row; float ss = 0.f;
#pragma unroll
                for (int w = 0; w < 8; ++w) ss += ssqs[w * 32 + row];
                const float rs = rsqrtf(ss * (1.f / D) + RMS_EPS);
                const LAS float* lg = logit + row * 64;
                float c[4];
#pragma unroll
                for (int k = 0; k < 4; ++k) c[k] = lg[32 + k] * rs + b_coarse[k];
                float cb = c[0]; int g = 0;
#pragma unroll
                for (int k = 1; k < 4; ++k) if (c[k] > cb) { cb = c[k]; g = k; }
                float den = 0.f;
#pragma unroll
                for (int k = 0; k < 4; ++k) den += expf(c[k] - cb);
                const float pg = 1.0f / den;
                float f[8];
#pragma unroll
                for (int k = 0; k < 8; ++k) f[k] = lg[g * 8 + k] * rs + b_fine[g * 8 + k];
                float v0 = f[0]; int i0 = 0;
#pragma unroll
                for (int k = 1; k < 8; ++k) if (f[k] > v0) { v0 = f[k]; i0 = k; }
                float v1 = -INFINITY; int i1 = 0;
#pragma unroll
                for (int k = 0; k < 8; ++k) if (k != i0 && f[k] > v1) { v1 = f[k]; i1 = k; }
                const float ex = expf(v1 - v0); const float w0 = pg / (1.0f + ex), w1 = pg * ex / (1.0f + ex);
                const int e0 = g * 8 + i0, e1 = g * 8 + i1;
                const unsigned s0 = __hip_atomic_fetch_add((unsigned*)(ctl + CW_CNT + 64 * e0), 1u, RLX_AGENT);
                const unsigned s1 = __hip_atomic_fetch_add((unsigned*)(ctl + CW_CNT + 64 * e1), 1u, RLX_AGENT);
                tokl[(size_t)e0 * 8192 + s0] = (unsigned)token; swl[(size_t)e0 * 8192 + s0] = (f32x2){rs, w0};
                tokl[(size_t)e1 * 8192 + s1] = (unsigned)token | 0x10000u; swl[(size_t)e1 * 8192 + s1] = (f32x2){rs, w1};
            }
        }
        __syncthreads();
        if (BOTH(4)) GRID_BAR();
    }

    if (IN(5) || IN(6)) {
        PHASE_WS(); WSPTR(hb, WS_HB); WSPTR(wgu_t, WS_WGU); WSPTR(wd_t, WS_WD); WSPTR(hmid, WS_HMID); WSPTR(yb, WS_Y); unsigned* tokl = (unsigned*)(ws + WS_TOK); f32x2* swl = (f32x2*)(ws + WS_SW);
        LAS int* tab = (LAS int*)(lds + TAB_OFF);
        if (tid < 32) tab[40 + tid] = (int)__hip_atomic_load((unsigned*)(ctl + CW_CNT + 64 * tid), RLX_AGENT);
        __syncthreads();
        if (tid == 0) { int acc = 0; for (int e = 0; e < 32; ++e) { tab[e] = acc; acc += (tab[40 + e] + 255) >> 8; } tab[32] = acc; }
        __syncthreads();
        if (IN(5)) {
            pg8::MoeOrder<4, true> S{G, bx, tab, (const char*)hb, (const char*)wgu_t, tokl};
            pg8::EpiGateUp E{hmid, swl};
            pg8::gemm_phase<pg8::EpiGateUp, pg8::MoeOrder<4, true>, true, true>(lds, D / 64, D, D, S, E);
            if (BOTH(5)) GRID_BAR();
        }
        if (IN(6)) {
            pg8::MoeOrder<8, false> S{G, bx, tab, (const char*)hmid, (const char*)wd_t, tokl};
            pg8::EpiDown E{yb, tokl};
            pg8::gemm_phase<pg8::EpiDown, pg8::MoeOrder<8, false>, true, false>(lds, FF / 64, FF, FF, S, E);
            if (BOTH(6)) GRID_BAR();
        }
    }

    if (IN(7)) {
        PHASE_WS(); WSPTR(yb, WS_Y);
        const float* final_g = LDARG(19);
        for (int m = gw; m < T; m += NGW) {
            f32x4* hr = (f32x4*)(out + (size_t)m * D) + lane; f32x4 v[8]; float s = 0.f;
            const v2u* y0 = (const v2u*)(yb + (size_t)m * D) + lane; const v2u* y1 = (const v2u*)(yb + ((size_t)T + m) * D) + lane;
#pragma unroll
            for (int j = 0; j < 8; ++j) { v[j] = hr[64 * j]; const v2u a = y0[64 * j], b = y1[64 * j];
                v[j].x += __uint_as_float(a.x << 16) + __uint_as_float(b.x << 16); v[j].y += __uint_as_float(a.x & 0xffff0000u) + __uint_as_float(b.x & 0xffff0000u);
                v[j].z += __uint_as_float(a.y << 16) + __uint_as_float(b.y << 16); v[j].w += __uint_as_float(a.y & 0xffff0000u) + __uint_as_float(b.y & 0xffff0000u);
                s += (v[j].x * v[j].x + v[j].y * v[j].y) + (v[j].z * v[j].z + v[j].w * v[j].w); }
            const float rstd = rsqrtf(wave_sum(s) * (1.f / D) + RMS_EPS);
#pragma unroll
            for (int j = 0; j < 8; ++j) { const f32x4 gg = ((const f32x4*)final_g)[lane + 64 * j]; hr[64 * j] = v[j] * rstd * gg; }
        }
    }
#undef IN
#undef BOTH
#undef GRID_BAR
}

extern "C" void kernel_launch(void* const* d_in, const int* in_sizes, int n_in, void* d_out, int out_size, void* d_ws, size_t ws_size, hipStream_t stream) {
    static int grid = 0;
    if (grid == 0) {
        if (n_in != 20 || out_size != T * D || ws_size < WS_END) { fprintf(stderr, "kernel_launch: unexpected shapes (n_in %d out %d ws %zu)\n", n_in, out_size, ws_size); grid = -1; return; }
        int dev = 0, cus = 0, per_cu = 0;
        if (hipGetDevice(&dev) != hipSuccess || hipDeviceGetAttribute(&cus, hipDeviceAttributeMultiprocessorCount, dev) != hipSuccess) { grid = -1; return; }
        if (hipFuncSetAttribute((const void*)hymba_fwd, hipFuncAttributeMaxDynamicSharedMemorySize, LDS_BYTES) != hipSuccess) { fprintf(stderr, "kernel_launch: hipFuncSetAttribute failed\n"); grid = -1; return; }
        if (hipOccupancyMaxActiveBlocksPerMultiprocessor(&per_cu, (const void*)hymba_fwd, 512, LDS_BYTES) != hipSuccess || per_cu < 1) fprintf(stderr, "kernel_launch: occupancy query reports %d\n", per_cu);
        (void)hipGetLastError();
        grid = cus;
    }
    if (grid < 0) return;
    (void)hipMemsetAsync((char*)d_ws + WS_CTL, 0, CTL_ZERO_BYTES, stream);
    Args a{};
    for (int i = 0; i < 20; ++i) a.in[i] = (const float*)d_in[i];
    a.out = (float*)d_out; a.ws = (unsigned char*)d_ws;
    if (MK_N_LAUNCHES == 1) { a.ph_lo = 0; a.ph_hi = NPH; a.li = 0; hipLaunchKernelGGL(hymba_fwd, dim3(grid), dim3(512), LDS_BYTES, stream, a); }
    else { for (int p = 0; p < NPH; ++p) { a.ph_lo = p; a.ph_hi = p + 1; a.li = p; hipLaunchKernelGGL(hymba_fwd, dim3(grid), dim3(512), LDS_BYTES, stream, a);
            if (p == PROBE_DUP) hipLaunchKernelGGL(hymba_fwd, dim3(grid), dim3(512), LDS_BYTES, stream, a); } }
}
```

```cpp
#include <hip/hip_runtime.h>
#include <hip/hip_bf16.h>
#include <cstdio>
#include <cstdint>

#ifndef MK_N_LAUNCHES
#define MK_N_LAUNCHES 1
#endif
#ifndef PROBE_DUP
#define PROBE_DUP -1
#endif

#define GAS __attribute__((address_space(1)))
#define LAS __attribute__((address_space(3)))
typedef unsigned short bf16;
typedef unsigned v4u __attribute__((ext_vector_type(4)));
typedef unsigned v2u __attribute__((ext_vector_type(2)));
typedef float f32x4 __attribute__((ext_vector_type(4)));
typedef float f32x2 __attribute__((ext_vector_type(2)));
typedef float f32x16 __attribute__((ext_vector_type(16)));
typedef short bf16x8 __attribute__((ext_vector_type(8)));
typedef short s16x4 __attribute__((ext_vector_type(4)));
typedef GAS unsigned gu32;
#define RLX_AGENT __ATOMIC_RELAXED, __HIP_MEMORY_SCOPE_AGENT
#define LDS_WAIT() asm volatile("s_waitcnt lgkmcnt(0)" ::: "memory")
#define VM_WAIT() asm volatile("s_waitcnt vmcnt(0)" ::: "memory")

constexpr int T = 8192, SEQ = 2048, D = 2048, INW = 4096, AW = 1024, NH = 8, NE = 32, FF = 512;
constexpr float RMS_EPS = 1e-6f;
constexpr float LOG2E = 1.4426950408889634f;
constexpr float C2 = 0.125f * LOG2E;

constexpr size_t MiB = 1u << 20;
constexpr size_t WS_CTL = 0, CTL_ZERO_BYTES = 32768;
constexpr size_t WS_WFRAG = 1 * MiB;
constexpr size_t WS_BT2 = 1 * MiB + 512 * 1024;
constexpr size_t WS_WIN = 2 * MiB;
constexpr size_t WS_WOUT = 18 * MiB;
constexpr size_t WS_WOUT2 = 26 * MiB;
constexpr size_t WS_TOK = 34 * MiB;
constexpr size_t WS_SW = 35 * MiB;
constexpr size_t WS_WGU = 40 * MiB;
constexpr size_t WS_WD = 168 * MiB;
constexpr size_t WS_XN = 232 * MiB;
constexpr size_t WS_HMID = 232 * MiB;
constexpr size_t WS_Q = 264 * MiB, WS_K = 280 * MiB, WS_V = 296 * MiB, WS_U = 312 * MiB;
constexpr size_t WS_Y = 264 * MiB;
constexpr size_t WS_A3 = 328 * MiB;
constexpr size_t WS_HB = 360 * MiB;
constexpr size_t WS_RB = 392 * MiB;
constexpr size_t WS_END = 424 * MiB;
constexpr int CW_CNT = 1024;
constexpr int CW_QATT = 3072, CW_QCVT = 3584;
constexpr int CW_BAR = 4096;

constexpr int RING_BYTES = 131072;
constexpr int WSF_OFF = RING_BYTES;
constexpr int TAB_OFF = WSF_OFF + 2048;
constexpr int MISC_OFF = TAB_OFF + 512;
constexpr int LDS_BYTES = 147456;

namespace pg8 {
#define PG8_LAS __attribute__((address_space(3)))
typedef unsigned short bf16_t;
typedef unsigned u32x4 __attribute__((ext_vector_type(4)));
constexpr int BM = 256, BK = 64, HALF = 128, HTB = HALF * BK * 2, STAGE_BYTES = 8 * HTB, NXCD = 8, WGM = 8;

__host__ __device__ __forceinline__ int lds_byte(int r, int c) { const int st = (r >> 4) * 2 + (c >> 5), rr = r & 15, cc = c & 31, ob = rr * 64 + cc * 2; return st * 1024 + (ob ^ (((ob >> 9) & 1) << 5)); }
__host__ __device__ __forceinline__ void stage_rc(int b, int& R, int& C) { const int st = b / 1024, sb = b % 1024, swz = sb ^ (((sb >> 9) & 1) << 5); R = (st >> 1) * 16 + swz / 64; C = (st & 1) * 32 + (swz % 64) / 2; }
__host__ __device__ __forceinline__ int perm32(int rho) { const int n = rho >> 4, i = rho & 15; return 8 * (i >> 2) + 4 * n + (i & 3); }

struct Unit { const char* a; const char* b; int orow, ocol, e, s0, cnt; };

__device__ __forceinline__ unsigned cvt_pk_bf16(float lo, float hi) { unsigned r; asm volatile("v_cvt_pk_bf16_f32 %0, %1, %2" : "=v"(r) : "v"(lo), "v"(hi)); return r; }

struct DenseOrder {
    int nM, nN, nwg, G, c; const char* A; const char* Bt; size_t tsA, tsB;
    __device__ void init(int M, int N, int G_, int c_, const void* A_, const void* Bt_, int lda, int ldb) { nM = M / BM; nN = N / BM; nwg = nM * nN; G = G_; c = c_; A = (const char*)A_; Bt = (const char*)Bt_; tsA = (size_t)BM * lda * 2; tsB = (size_t)BM * ldb * 2; }
    __device__ bool next(int i, Unit& u) const {
        const long L = (long)i * G + c; if (L >= nwg) return false;
        int wgid = (int)L; { const int q = nwg / NXCD, r = nwg % NXCD, xcd = wgid % NXCD, off = wgid / NXCD; wgid = (xcd < r ? xcd * (q + 1) : r * (q + 1) + (xcd - r) * q) + off; }
        const int nig = WGM * nN, gid = wgid / nig, fm = gid * WGM, gsz = (nM - fm) < WGM ? (nM - fm) : WGM;
        const int pm = fm + ((wgid % nig) % gsz), pn = (wgid % nig) / gsz;
        u.a = A + (size_t)pm * tsA; u.b = Bt + (size_t)pn * tsB; u.orow = pm * BM; u.ocol = pn * BM; u.e = 0; u.s0 = 0; u.cnt = 0; return true;
    }
    __device__ __forceinline__ unsigned row_off(const Unit&, int) const { return 0u; }
};

template <class Epi, class Sched, bool ALIGN_EPI, bool GATHER>
__device__ __forceinline__ void gemm_phase(PG8_LAS unsigned char* lds, const int nt, const int lda, const int ldb, const Sched& S, const Epi& E) {
    const int tid = threadIdx.x, wid = __builtin_amdgcn_readfirstlane(tid >> 6), lane = tid & 63, wr = wid >> 2, wc = wid & 3, fr = lane & 15, fq = lane >> 4;
    unsigned voffA[2], voffB[2]; int rA[2]; unsigned cA2[2];
#pragma unroll
    for (int i = 0; i < 2; ++i) { int R, C; stage_rc(tid * 16 + i * 8192, R, C); const int Rb = Epi::PERM ? ((R & ~31) + perm32(R & 31)) : R;
        voffA[i] = (unsigned)(R * lda + C) * 2u; voffB[i] = (unsigned)(Rb * ldb + C) * 2u; rA[i] = R; cA2[i] = (unsigned)C * 2u; }
    const size_t kstep = (size_t)(BK * 2);
    const size_t hstepA = (size_t)HALF * lda * 2, hstepB = (size_t)HALF * ldb * 2;
    const unsigned ldsw = (unsigned)wid * 1024u;
    const int aoff = lds_byte(wr * 64 + fr, fq * 8), boff = lds_byte(wc * 32 + fr, fq * 8);
#define PG8_SA(b, h) (((b) * 2 + (h)) * HTB)
#define PG8_SB(b, h) ((4 + (b) * 2 + (h)) * HTB)
#define PG8_STAGE_O(bufoff, gbase, o0, o1) do { \
        __builtin_amdgcn_global_load_lds((const unsigned*)((const char*)(gbase) + (o0)), (PG8_LAS unsigned*)(lds + (bufoff) + ldsw), 16, 0, 0); \
        __builtin_amdgcn_global_load_lds((const unsigned*)((const char*)(gbase) + (o1)), (PG8_LAS unsigned*)(lds + (bufoff) + ldsw + 8192), 16, 0, 0); } while (0)
#define PG8_STB(b, h, bptr) PG8_STAGE_O(PG8_SB(b, h), (bptr) + (h) * hstepB, voffB[0], voffB[1])
#define PG8_STA(b, h, aptr, O) do { if constexpr (GATHER) { PG8_STAGE_O(PG8_SA(b, h), (aptr), O[h][0], O[h][1]); } else { PG8_STAGE_O(PG8_SA(b, h), (aptr) + (h) * hstepA, voffA[0], voffA[1]); } } while (0)
#define PG8_LDA(dst, b, h) do { _Pragma("unroll") for (int m = 0; m < 4; ++m) _Pragma("unroll") for (int k = 0; k < 2; ++k) dst[m][k] = *(const PG8_LAS bf16x8*)(lds + PG8_SA(b, h) + aoff + m * 2048 + k * 1024); } while (0)
#define PG8_LDB(dst, b, h) do { _Pragma("unroll") for (int n = 0; n < 2; ++n) _Pragma("unroll") for (int k = 0; k < 2; ++k) dst[n][k] = *(const PG8_LAS bf16x8*)(lds + PG8_SB(b, h) + boff + n * 2048 + k * 1024); } while (0)
#define PG8_MMA(ai, bj, At, Bt) do { __builtin_amdgcn_s_setprio(1); _Pragma("unroll") for (int m = 0; m < 4; ++m) _Pragma("unroll") for (int n = 0; n < 2; ++n) _Pragma("unroll") for (int k = 0; k < 2; ++k) \
        acc[ai][bj][m][n] = __builtin_amdgcn_mfma_f32_16x16x32_bf16(Bt[n][k], At[m][k], acc[ai][bj][m][n], 0, 0, 0); __builtin_amdgcn_s_setprio(0); } while (0)
#define PG8_WAIT_V(n) asm volatile("s_waitcnt vmcnt(" #n ")" ::: "memory")
#define PG8_WAIT_L(n) asm volatile("s_waitcnt lgkmcnt(" #n ")" ::: "memory")
#define PG8_BAR __builtin_amdgcn_s_barrier()
#define PG8_SCHED __builtin_amdgcn_sched_barrier(0)
#define PG8_FETCH(u, O) do { _Pragma("unroll") for (int h_ = 0; h_ < 2; ++h_) _Pragma("unroll") for (int i_ = 0; i_ < 2; ++i_) O[h_][i_] = S.row_off(u, h_ * HALF + rA[i_]) + cA2[i_]; } while (0)
    Unit cur, nxt; int ui = 0;
    if (!S.next(0, cur)) return;
    f32x4 acc[2][2][4][2];
#pragma unroll
    for (int a = 0; a < 2; ++a)
#pragma unroll
        for (int b = 0; b < 2; ++b)
#pragma unroll
            for (int m = 0; m < 4; ++m)
#pragma unroll
                for (int n = 0; n < 2; ++n) acc[a][b][m][n] = (f32x4){0.f, 0.f, 0.f, 0.f};
    bf16x8 At[4][2], B0[2][2], B1[2][2];
    unsigned oC[2][2] = {{0u, 0u}, {0u, 0u}}, oN[2][2] = {{0u, 0u}, {0u, 0u}}, o2[2][2] = {{0u, 0u}, {0u, 0u}};
    if constexpr (GATHER) { PG8_FETCH(cur, oC); }
    const char* cA = cur.a; const char* cB = cur.b;
    PG8_STB(0, 0, cB); PG8_STB(0, 1, cB); PG8_STA(0, 0, cA, oC); PG8_STA(0, 1, cA, oC);
    if (wr == 1) PG8_BAR;
    PG8_WAIT_V(2); PG8_BAR;
    PG8_STB(1, 0, cB + kstep); PG8_STA(1, 0, cA + kstep, oC); PG8_STB(1, 1, cB + kstep);
    PG8_WAIT_V(6); PG8_BAR;
    for (;;) {
        const bool has_next = S.next(ui + 1, nxt);
        const char* nA = has_next ? nxt.a : cA; const char* nB = has_next ? nxt.b : cB;
        if constexpr (GATHER) { if (has_next) { PG8_FETCH(nxt, oN); } else {
#pragma unroll
            for (int h_ = 0; h_ < 2; ++h_)
#pragma unroll
                for (int i_ = 0; i_ < 2; ++i_) oN[h_][i_] = oC[h_][i_]; } }
        for (int t = 0; t < nt; t += 2) {
            const bool last = (t == nt - 2);
            const char* a1 = cA + (size_t)(t + 1) * kstep;
            const char* a2 = last ? nA : cA + (size_t)(t + 2) * kstep; const char* b2 = last ? nB : cB + (size_t)(t + 2) * kstep;
            const char* a3 = a2 + kstep; const char* b3 = b2 + kstep;
            if constexpr (GATHER) {
#pragma unroll
                for (int h_ = 0; h_ < 2; ++h_)
#pragma unroll
                    for (int i_ = 0; i_ < 2; ++i_) o2[h_][i_] = last ? oN[h_][i_] : oC[h_][i_]; }
            PG8_LDB(B0, 0, 0); PG8_LDB(B1, 0, 1); PG8_SCHED; PG8_LDA(At, 0, 0); PG8_STA(1, 1, a1, oC);
            PG8_WAIT_V(8); PG8_WAIT_L(0); PG8_BAR; PG8_MMA(0, 0, At, B0); PG8_MMA(0, 1, At, B1); PG8_BAR; PG8_SCHED;
            PG8_LDA(At, 0, 1); PG8_STB(0, 0, b2); PG8_STB(0, 1, b2); PG8_STA(0, 0, a2, o2);
            PG8_WAIT_V(8); PG8_WAIT_L(0); PG8_BAR; PG8_MMA(1, 0, At, B0); PG8_MMA(1, 1, At, B1); PG8_BAR; PG8_SCHED;
            PG8_LDB(B0, 1, 0); PG8_LDB(B1, 1, 1); PG8_SCHED; PG8_LDA(At, 1, 0); PG8_STA(0, 1, a2, o2);
            PG8_WAIT_V(8); PG8_WAIT_L(0); PG8_BAR; PG8_MMA(0, 0, At, B0); PG8_MMA(0, 1, At, B1); PG8_BAR; PG8_SCHED;
            PG8_LDA(At, 1, 1); PG8_STB(1, 0, b3); PG8_STB(1, 1, b3); PG8_STA(1, 0, a3, o2);
            PG8_WAIT_V(8); PG8_WAIT_L(0); PG8_BAR; PG8_MMA(1, 0, At, B0); PG8_MMA(1, 1, At, B1); PG8_BAR; PG8_SCHED;
        }
        if constexpr (ALIGN_EPI) { if (wr == 0) PG8_BAR; }
        E(acc, cur, wr, wc, fr, fq);
        if (!has_next) break;
#pragma unroll
        for (int a = 0; a < 2; ++a)
#pragma unroll
            for (int b = 0; b < 2; ++b)
#pragma unroll
                for (int m = 0; m < 4; ++m)
#pragma unroll
                    for (int n = 0; n < 2; ++n) acc[a][b][m][n] = (f32x4){0.f, 0.f, 0.f, 0.f};
        cur = nxt; cA = nA; cB = nB; ++ui;
        if constexpr (GATHER) {
#pragma unroll
            for (int h_ = 0; h_ < 2; ++h_)
#pragma unroll
                for (int i_ = 0; i_ < 2; ++i_) oC[h_][i_] = oN[h_][i_]; }
        if constexpr (ALIGN_EPI) { if (wr == 1) PG8_BAR; }
    }
    PG8_WAIT_V(0);
    if constexpr (!ALIGN_EPI) { if (wr == 0) PG8_BAR; }
    PG8_BAR;
#undef PG8_SA
#undef PG8_SB
#undef PG8_STAGE_O
#undef PG8_STB
#undef PG8_STA
#undef PG8_LDA
#undef PG8_LDB
#undef PG8_MMA
#undef PG8_WAIT_V
#undef PG8_WAIT_L
#undef PG8_BAR
#undef PG8_SCHED
#undef PG8_FETCH
}

struct EpiStoreBf16 {
    static constexpr bool PERM = true;
    bf16_t* O; int ldc; int split_cols; size_t split_stride; float scale0;
    __device__ __forceinline__ void operator()(const f32x4 (&acc)[2][2][4][2], const Unit& u, int wr, int wc, int fr, int fq) const {
        const int row0 = u.orow + wr * 64 + fr; int colt = u.ocol; bf16_t* base = O;
        float sc = 1.f; if (split_cols) { const int t = colt / split_cols; base += (size_t)t * split_stride; colt -= t * split_cols; if (t == 0) sc = scale0; }
        const int col0 = colt + wc * 32 + 8 * fq;
#pragma unroll
        for (int ai = 0; ai < 2; ++ai)
#pragma unroll
            for (int m = 0; m < 4; ++m) { bf16_t* rowp = base + (size_t)(row0 + ai * HALF + m * 16) * ldc + col0;
#pragma unroll
                for (int bj = 0; bj < 2; ++bj) { const f32x4 v0 = acc[ai][bj][m][0] * sc, v1 = acc[ai][bj][m][1] * sc;
                    u32x4 w; w.x = cvt_pk_bf16(v0[0], v0[1]); w.y = cvt_pk_bf16(v0[2], v0[3]); w.z = cvt_pk_bf16(v1[0], v1[1]); w.w = cvt_pk_bf16(v1[2], v1[3]);
                    *(u32x4*)(rowp + bj * HALF) = w; } }
    }
};
struct EpiResid {
    static constexpr bool PERM = false;
    const float* x; float* out; bf16_t* hb;
    __device__ __forceinline__ void operator()(const f32x4 (&acc)[2][2][4][2], const Unit& u, int wr, int wc, int fr, int fq) const {
        const int row0 = u.orow + wr * 64 + fr, col0 = u.ocol + wc * 32 + 4 * fq;
#pragma unroll
        for (int ai = 0; ai < 2; ++ai)
#pragma unroll
            for (int m = 0; m < 4; ++m) { const size_t off = (size_t)(row0 + ai * HALF + m * 16) * D + col0;
#pragma unroll
                for (int bj = 0; bj < 2; ++bj)
#pragma unroll
                    for (int n = 0; n < 2; ++n) { const size_t o = off + bj * HALF + n * 16; const f32x4 xv = *(const f32x4*)(x + o); const f32x4 hv = xv + acc[ai][bj][m][n];
                        *(f32x4*)(out + o) = hv; v2u w; w.x = cvt_pk_bf16(hv[0], hv[1]); w.y = cvt_pk_bf16(hv[2], hv[3]); *(v2u*)(hb + o) = w; } }
    }
};
struct EpiGateUp {
    static constexpr bool PERM = true;
    bf16_t* hmid; const f32x2* sw;
    __device__ __forceinline__ void operator()(const f32x4 (&acc)[2][2][4][2], const Unit& u, int wr, int wc, int fr, int fq) const {
        const int col0 = u.ocol + wc * 32 + 8 * fq;
        const GAS f32x2* swg = (const GAS f32x2*)sw + (size_t)u.e * 8192 + u.s0 + wr * 64 + fr;
        f32x2 rws[2][4];
#pragma unroll
        for (int ai = 0; ai < 2; ++ai)
#pragma unroll
            for (int m = 0; m < 4; ++m) rws[ai][m] = swg[ai * HALF + m * 16];
#pragma unroll
        for (int ai = 0; ai < 2; ++ai)
#pragma unroll
            for (int m = 0; m < 4; ++m) { const int r = ai * HALF + wr * 64 + m * 16 + fr; const int slot = u.s0 + r; const bool valid = slot < u.cnt;
                const f32x2 rw = rws[ai][m];
                float hv[8];
#pragma unroll
                for (int n = 0; n < 2; ++n)
#pragma unroll
                    for (int j = 0; j < 4; ++j) { const float g = acc[ai][0][m][n][j] * rw.x, up = acc[ai][1][m][n][j] * rw.x;
                        const float e = __builtin_amdgcn_exp2f(-g * LOG2E); const float s = g * __builtin_amdgcn_rcpf(1.0f + e); hv[n * 4 + j] = valid ? s * up * rw.y : 0.f; }
                u32x4 w; w.x = cvt_pk_bf16(hv[0], hv[1]); w.y = cvt_pk_bf16(hv[2], hv[3]); w.z = cvt_pk_bf16(hv[4], hv[5]); w.w = cvt_pk_bf16(hv[6], hv[7]);
                *(GAS u32x4*)(hmid + (size_t)(u.orow + r) * FF + col0) = w; }
    }
};
struct EpiDown {
    static constexpr bool PERM = true;
    bf16_t* y; const unsigned* tok;
    __device__ __forceinline__ void operator()(const f32x4 (&acc)[2][2][4][2], const Unit& u, int wr, int wc, int fr, int fq) const {
        const int col0 = u.ocol + wc * 32 + 8 * fq;
        const GAS unsigned* tg = (const GAS unsigned*)tok + (size_t)u.e * 8192 + u.s0 + wr * 64 + fr;
        unsigned tis[2][4];
#pragma unroll
        for (int ai = 0; ai < 2; ++ai)
#pragma unroll
            for (int m = 0; m < 4; ++m) tis[ai][m] = tg[ai * HALF + m * 16];
#pragma unroll
        for (int ai = 0; ai < 2; ++ai)
#pragma unroll
            for (int m = 0; m < 4; ++m) { const int r = ai * HALF + wr * 64 + m * 16 + fr; const int slot = u.s0 + r;
                if (slot < u.cnt) { const unsigned ti = tis[ai][m]; const unsigned token = ti & 0xffffu, ks = ti >> 16;
                    bf16_t* rowp = y + ((size_t)ks * T + token) * D + col0;
#pragma unroll
                    for (int bj = 0; bj < 2; ++bj) { const f32x4 v0 = acc[ai][bj][m][0], v1 = acc[ai][bj][m][1];
                        u32x4 w; w.x = cvt_pk_bf16(v0[0], v0[1]); w.y = cvt_pk_bf16(v0[2], v0[3]); w.z = cvt_pk_bf16(v1[0], v1[1]); w.w = cvt_pk_bf16(v1[2], v1[3]);
                        *(GAS u32x4*)(rowp + bj * HALF) = w; } } }
    }
};
struct W2Order {
    int G, c; const char* A; const char* Bt;
    __device__ bool next(int i, Unit& u) const { const int L = i * G + c; if (L >= 32) return false; const int g = L & 3, dt = L >> 2;
        u.a = A + ((size_t)dt * 256 * D + 1024 + 256 * g) * 2; u.b = Bt + (size_t)g * 65536 * 2; u.orow = dt * 256; u.ocol = 1024 + 256 * g; u.e = 0; u.s0 = 0; u.cnt = 0; return true; }
    __device__ __forceinline__ unsigned row_off(const Unit&, int) const { return 0u; }
};
template <int NPN, bool UP> struct MoeOrder {
    int c0, ncu, c, t_lo, t_hi; const PG8_LAS int* tab; const char* A; const char* W; const unsigned* tok;
    __device__ bool next(int i, Unit& u) const {
        if (c < c0 || c >= c0 + ncu) return false;
        const int nt_all = __builtin_amdgcn_readfirstlane(tab[32]); const int hi_ = t_hi < nt_all ? t_hi : nt_all; const int total = (hi_ - t_lo) * NPN;
        const int L = i * ncu + (c - c0); if (L >= total) return false;
        const int Tt = t_lo + L / NPN, pn = L % NPN; int e = 0;
        for (int k = 1; k < 32; ++k) e = (tab[k] <= Tt) ? k : e;
        e = __builtin_amdgcn_readfirstlane(e);
        const int mt = Tt - __builtin_amdgcn_readfirstlane(tab[e]);
        u.e = e; u.s0 = mt * 256; u.cnt = __builtin_amdgcn_readfirstlane(tab[40 + e]); u.orow = Tt * 256;
        if (UP) { u.a = A; u.b = W + ((size_t)(e * 4 + pn) * 256) * D * 2; u.ocol = pn * 128; }
        else { u.a = A + (size_t)Tt * 256 * FF * 2; u.b = W + ((size_t)e * D + pn * 256) * FF * 2; u.ocol = pn * 256; }
        return true;
    }
    __device__ __forceinline__ unsigned row_off(const Unit& u, int R) const {
        const int slot = u.s0 + R; unsigned token = ((const GAS unsigned*)tok)[u.e * 8192 + slot] & 0xffffu; token = (slot < u.cnt) ? token : 0u; return token * (unsigned)(D * 2);
    }
};
}

namespace att {
constexpr int PITCH = 1024, QB = 128, KVB = 64;
constexpr int KBUF0 = 0, VBUF0 = 32768, XBUF0 = 65536;
__device__ __forceinline__ int crow(int r, int hi) { return (r & 3) + 8 * (r >> 2) + 4 * hi; }
__device__ __forceinline__ unsigned cvtpk(float lo, float hi) { unsigned r; asm volatile("v_cvt_pk_bf16_f32 %0, %1, %2" : "=v"(r) : "v"(lo), "v"(hi)); return r; }
typedef short v4i16_t __attribute__((ext_vector_type(4)));
__device__ __forceinline__ v2u vtr(const LAS char* p) { return __builtin_bit_cast(v2u, __builtin_amdgcn_ds_read_tr16_b64_v4i16((LAS v4i16_t*)p)); }
__device__ __forceinline__ float opq(float x) { asm("" : "+v"(x)); return x; }
__device__ __forceinline__ float hswap_max(float m) { auto rr = __builtin_amdgcn_permlane32_swap(__float_as_uint(m), __float_as_uint(m), false, false); return fmaxf(__uint_as_float(rr[0]), __uint_as_float(rr[1])); }
__device__ __forceinline__ float hswap_sum(float m) { auto rr = __builtin_amdgcn_permlane32_swap(__float_as_uint(m), __float_as_uint(m), false, false); return __uint_as_float(rr[0]) + __uint_as_float(rr[1]); }

__device__ __forceinline__ void attn_unit(int b, int h, int qb, const bf16* Q, const bf16* K, const bf16* V, bf16* A3, const float* subg, float lam, LAS unsigned char* lds, LAS float* wsf_all) {
    int lane_ = threadIdx.x & 63; asm volatile("" : "+v"(lane_));
    const int tid = threadIdx.x, lane = lane_, r32 = lane & 31, hi = lane >> 5; const int wid = __builtin_amdgcn_readfirstlane(tid >> 6);
    const int mp = wid >> 2, rg = wid & 3;
    const long rowbase = (long)b * SEQ; const int q0 = qb * QB, qmin = q0 + 32 * rg, qmax = qmin + 31;
    const float slope2 = exp2f(-(float)(h + 1)) * LOG2E;
    LAS float* wsf = wsf_all + wid * 64;
    const bf16* Kh = K + rowbase * PITCH + h * 128; const bf16* Vh = V + rowbase * PITCH + h * 128;
    const int NT = (q0 + QB) / KVB;
    const int drow = 4 * wid + (lane >> 4), dslot = lane & 15;
    const bf16* ksrc = Kh + (long)drow * PITCH + ((dslot ^ (drow & 15)) * 8);
    const bf16* vsrc = Vh + (long)drow * PITCH + (((dslot >> 2) ^ (drow & 3)) * 32) + (dslot & 3) * 8;
    const unsigned lds0 = (unsigned)(unsigned long)lds;
#define ATT_GLDS(gsrc, ldst) do { unsigned keep_; asm volatile("s_mov_b32 %0, m0\n\ts_mov_b32 m0, %2\n\ts_nop 0\n\tglobal_load_lds_dwordx4 %1, off\n\ts_mov_b32 m0, %0" : "=&s"(keep_) : "v"(gsrc), "s"(ldst) : "memory"); } while (0)
#define ATT_DMA_K(t) do { const long to_ = (long)(t) * KVB * PITCH; const unsigned bb_ = (unsigned)__builtin_amdgcn_readfirstlane((int)(lds0 + KBUF0 + (unsigned)((t) & 1) * 16384u)); \
        ATT_GLDS(ksrc + to_, bb_ + (unsigned)wid * 1024u); ATT_GLDS(ksrc + to_ + 32 * PITCH, bb_ + 8192u + (unsigned)wid * 1024u); } while (0)
#define ATT_DMA_V(t) do { const long to_ = (long)(t) * KVB * PITCH; const unsigned bb_ = (unsigned)__builtin_amdgcn_readfirstlane((int)(lds0 + VBUF0 + (unsigned)((t) & 1) * 16384u)); \
        ATT_GLDS(vsrc + to_, bb_ + (unsigned)wid * 1024u); ATT_GLDS(vsrc + to_ + 32 * PITCH, bb_ + 8192u + (unsigned)wid * 1024u); } while (0)
    ATT_DMA_K(0);
    bf16x8 qr[4];
    {
        const bf16* Qw = Q + (rowbase + qmin + r32) * PITCH + h * 128 + mp * 64 + hi * 8;
#pragma unroll
        for (int d0 = 0; d0 < 4; ++d0) qr[d0] = *(const bf16x8*)(Qw + d0 * 16);
        asm volatile("" :: "v"(qr[0]), "v"(qr[1]), "v"(qr[2]), "v"(qr[3]));
    }
    const float s32 = 32.f * slope2;
    const float lbase = slope2 * (float)(4 * hi - r32 - qmin);
#ifdef PROBE_TIME
    const unsigned long long pt0_ = __builtin_amdgcn_s_memrealtime();
#endif
    float mrow = -INFINITY, lsum = 0.f;
    f32x16 o[4];
#pragma unroll
    for (int d0 = 0; d0 < 4; ++d0)
#pragma unroll
        for (int r = 0; r < 16; ++r) o[d0][r] = 0.f;
    v4u pw[4] = {(v4u){0u, 0u, 0u, 0u}, (v4u){0u, 0u, 0u, 0u}, (v4u){0u, 0u, 0u, 0u}, (v4u){0u, 0u, 0u, 0u}};
    bool resc = false;
    const int vq = (lane & 15) >> 2;
    for (int s = 0; s <= NT; ++s) {
        VM_WAIT(); __syncthreads();
        if (s + 1 < NT) ATT_DMA_K(s + 1);
        if (s < NT) ATT_DMA_V(s);
        const bool do_s = s < NT && KVB * s <= qmax, do_pv = s >= 1 && KVB * (s - 1) <= qmax;
        f32x16 p0, p1;
        if (do_s) {
            const LAS unsigned char* kb = lds + KBUF0 + (s & 1) * 16384 + r32 * 256;
            bf16x8 kf[8];
#pragma unroll
            for (int d0 = 0; d0 < 4; ++d0) { const int so = ((mp * 8 + 2 * d0 + hi) ^ (r32 & 15)) * 16; kf[2 * d0] = *(const LAS bf16x8*)(kb + so); kf[2 * d0 + 1] = *(const LAS bf16x8*)(kb + so + 8192); }
#pragma unroll
            for (int r = 0; r < 16; ++r) { p0[r] = 0.f; p1[r] = 0.f; }
#pragma unroll
            for (int d0 = 0; d0 < 4; ++d0) {
                p0 = __builtin_amdgcn_mfma_f32_32x32x16_bf16(kf[2 * d0], qr[d0], p0, 0, 0, 0);
                p1 = __builtin_amdgcn_mfma_f32_32x32x16_bf16(kf[2 * d0 + 1], qr[d0], p1, 0, 0, 0);
            }
        }
        if (do_pv) {
            const int t = s - 1;
            if (resc) {
                float al[16];
#pragma unroll
                for (int r = 0; r < 16; ++r) al[r] = wsf[crow(r, hi)];
#pragma unroll
                for (int d0 = 0; d0 < 4; ++d0)
#pragma unroll
                    for (int r = 0; r < 16; ++r) o[d0][r] = opq(o[d0][r] * al[r]);
            }
            const LAS char* vb = (const LAS char*)(lds + VBUF0 + (t & 1) * 16384) + ((lane >> 4) & 1) * 32 + (lane & 3) * 8 + (4 * hi + vq) * 256;
#pragma unroll
            for (int d0 = 0; d0 < 4; ++d0) {
#pragma unroll
                for (int ks = 0; ks < 4; ++ks) { const v2u lo = vtr(vb + ((d0 ^ vq) * 64) + ks * 4096), hh = vtr(vb + ((d0 ^ vq) * 64) + ks * 4096 + 2048);
                    const v4u vf = (v4u){lo.x, lo.y, hh.x, hh.y};
                    o[d0] = __builtin_amdgcn_mfma_f32_32x32x16_bf16(__builtin_bit_cast(bf16x8, pw[ks]), __builtin_bit_cast(bf16x8, vf), o[d0], 0, 0, 0); }
            }
        }
        if (do_s) {
            const float lb = lbase + slope2 * (float)(KVB * s);
#pragma unroll
            for (int r = 0; r < 16; ++r) { const float cr = (float)((r & 3) + 8 * (r >> 2)); p0[r] = opq(fmaf(slope2, cr, p0[r])); p1[r] = opq(fmaf(slope2, cr, p1[r])); }
            if (KVB * s + 63 > qmin) {
                const int dq = qmin + r32 - KVB * s - 4 * hi;
#pragma unroll
                for (int r = 0; r < 16; ++r) { const int kk = (r & 3) + 8 * (r >> 2); if (kk > dq) p0[r] = -INFINITY; if (kk + 32 > dq) p1[r] = -INFINITY; }
            }
            float m0 = p0[0], m1 = p1[0];
#pragma unroll
            for (int r = 1; r < 16; ++r) { m0 = fmaxf(m0, p0[r]); m1 = fmaxf(m1, p1[r]); }
            float rmt = fmaxf(m0, m1 + s32) + lb; rmt = hswap_max(rmt);
            const float mnew = fmaxf(mrow, rmt);
            const float alpha = __builtin_amdgcn_exp2f(mrow - mnew);
            mrow = mnew;
            const float e0 = mnew - lb, e1 = e0 - s32;
            float sacc = 0.f;
#pragma unroll
            for (int r = 0; r < 16; ++r) { p0[r] = __builtin_amdgcn_exp2f(opq(p0[r] - e0)); p1[r] = __builtin_amdgcn_exp2f(opq(p1[r] - e1)); sacc = opq(sacc + p0[r]); sacc = opq(sacc + p1[r]); }
            lsum = lsum * alpha + sacc;
            pw[0] = (v4u){cvtpk(p0[0], p0[1]), cvtpk(p0[2], p0[3]), cvtpk(p0[4], p0[5]), cvtpk(p0[6], p0[7])};
            pw[1] = (v4u){cvtpk(p0[8], p0[9]), cvtpk(p0[10], p0[11]), cvtpk(p0[12], p0[13]), cvtpk(p0[14], p0[15])};
            pw[2] = (v4u){cvtpk(p1[0], p1[1]), cvtpk(p1[2], p1[3]), cvtpk(p1[4], p1[5]), cvtpk(p1[6], p1[7])};
            pw[3] = (v4u){cvtpk(p1[8], p1[9]), cvtpk(p1[10], p1[11]), cvtpk(p1[12], p1[13]), cvtpk(p1[14], p1[15])};
            resc = !__all(alpha == 1.0f);
            if (resc && hi == 0) wsf[r32] = alpha;
        }
    }
#undef ATT_DMA_K
#undef ATT_DMA_V
#undef ATT_GLDS
#ifdef PROBE_TIME
    if (threadIdx.x == 0) { volatile LAS unsigned* pa_ = (volatile LAS unsigned*)(lds + MISC_OFF + 64); pa_[0] += (unsigned)(__builtin_amdgcn_s_memrealtime() - pt0_); pa_[1] += (unsigned)(NT + 1); }
#endif
    lsum = hswap_sum(lsum);
    if (hi == 0) wsf[r32] = __builtin_amdgcn_rcpf(lsum);
    LDS_WAIT();
    {
        float rl[16];
#pragma unroll
        for (int r = 0; r < 16; ++r) rl[r] = wsf[crow(r, hi)];
#pragma unroll
        for (int d0 = 0; d0 < 4; ++d0)
#pragma unroll
            for (int r = 0; r < 16; ++r) o[d0][r] *= rl[r];
    }
    LAS float* X = (LAS float*)(lds + XBUF0) + rg * 4096;
    if (mp == 1) {
#pragma unroll
        for (int d0 = 0; d0 < 4; ++d0)
#pragma unroll
            for (int r = 0; r < 16; ++r) X[(d0 * 16 + r) * 64 + lane] = o[d0][r];
    }
    __syncthreads();
    if (mp == 0) {
        float ss[16];
#pragma unroll
        for (int r = 0; r < 16; ++r) ss[r] = 0.f;
#pragma unroll
        for (int d0 = 0; d0 < 4; ++d0)
#pragma unroll
            for (int r = 0; r < 16; ++r) { const float dv = o[d0][r] - lam * X[(d0 * 16 + r) * 64 + lane]; o[d0][r] = dv; ss[r] += dv * dv; }
#pragma unroll
        for (int r = 0; r < 16; ++r) {
#pragma unroll
            for (int off = 1; off < 32; off <<= 1) ss[r] += __shfl_xor(ss[r], off);
            ss[r] = rsqrtf(ss[r] * (1.0f / 128.0f) + RMS_EPS) * 0.8f;
        }
        LAS bf16* stg = (LAS bf16*)(lds + KBUF0 + rg * 8192);
#pragma unroll
        for (int d0 = 0; d0 < 4; ++d0) { const float gg = subg[d0 * 32 + r32];
#pragma unroll
            for (int r = 0; r < 16; ++r) { const float v = o[d0][r] * ss[r] * gg; const unsigned pk = cvtpk(v, v); stg[crow(r, hi) * 128 + d0 * 32 + r32] = (bf16)(pk & 0xffffu); } }
        LDS_WAIT(); asm volatile("" ::: "memory");
        bf16* Ow = A3 + (rowbase + qmin) * D + h * 128;
#pragma unroll
        for (int i = 0; i < 8; ++i) { const int row = i * 4 + (lane >> 4), ch = lane & 15; const v4u v = *(const LAS v4u*)(stg + row * 128 + ch * 8); *(GAS v4u*)(Ow + (long)row * D + ch * 8) = v; }
    }
    __syncthreads();
}
}

#define XB_TMO      128
#define XB_XCNT(j)  (256  + 64 * (j))
#define XB_XSUB(j)  (1280 + 64 * (j))
#define XB_XGEN(j)  (2304 + 64 * (j))
#define XB_TOP      3328
#define XB_TOPGEN   3392
#define XCD_BAR_WORDS 3456
#define XB_SPIN_CAP (1u << 18)

__device__ __forceinline__ unsigned xb_ld(unsigned* p)              { return __hip_atomic_load(p, __ATOMIC_RELAXED, __HIP_MEMORY_SCOPE_AGENT); }
__device__ __forceinline__ unsigned xb_add(unsigned* p, unsigned v) { return __hip_atomic_fetch_add(p, v, __ATOMIC_RELAXED, __HIP_MEMORY_SCOPE_AGENT); }
__device__ __forceinline__ unsigned xb_xcc_id() { return (unsigned)__builtin_amdgcn_s_getreg((3 << 11) | 20) & 0xFu; }
#define XB_SPIN(cond, bar) do { unsigned _sp = 0; while (cond) { __builtin_amdgcn_s_sleep(1); \
    if ((++_sp & 255u) == 0u) { if (xb_ld(&(bar)[XB_TMO])) break; if (_sp > XB_SPIN_CAP) { atomicAdd(&(bar)[XB_TMO], 1u); break; } } } } while (0)

struct XcdBarrier { unsigned* bar; unsigned x; volatile LAS unsigned* st; };

__device__ __forceinline__ XcdBarrier xcd_barrier_post(unsigned* bar, volatile LAS unsigned* st) {
    XcdBarrier b; b.bar = bar; b.x = xb_xcc_id(); b.st = st;
    if (threadIdx.x == 0) (void)xb_add(&bar[XB_XCNT(b.x)], 1u);
    return b;
}
__device__ __forceinline__ void xcd_barrier_complete(unsigned* bar, unsigned x, unsigned& nloc, unsigned& nx) {
    const unsigned G = gridDim.x * gridDim.y * gridDim.z;
    unsigned sum, cnt, mine, sp = 0u;
    for (;;) {
        sum = 0u; cnt = 0u; mine = 0u;
#pragma unroll
        for (unsigned j = 0; j < 16; ++j) { const unsigned c = xb_ld(&bar[XB_XCNT(j)]); sum += c; cnt += (c > 0u) ? 1u : 0u; mine = (j == x) ? c : mine; }
        if (sum == G) break;
        __builtin_amdgcn_s_sleep(1);
        if ((++sp & 255u) == 0u) { if (xb_ld(&bar[XB_TMO])) break; if (sp > XB_SPIN_CAP) { atomicAdd(&bar[XB_TMO], 1u); break; } }
    }
    nloc = mine > 0u ? mine : 1u; nx = cnt > 0u ? cnt : 1u;
}
__device__ __forceinline__ void xcd_barrier(const XcdBarrier& b) {
    asm volatile("s_waitcnt vmcnt(0)" ::: "memory");
    __syncthreads();
    if (threadIdx.x == 0) {
        unsigned* bar = b.bar;
        __builtin_amdgcn_s_waitcnt(0);
        unsigned nloc = b.st[0], nx = b.st[1];
        if (nloc == 0u) { xcd_barrier_complete(bar, b.x, nloc, nx); b.st[0] = nloc; b.st[1] = nx; }
        const unsigned old = xb_add(&bar[XB_XSUB(b.x)], 1u);
        const unsigned gen = old / nloc;
        if (old + 1u == (gen + 1u) * nloc) {
            __builtin_amdgcn_fence(__ATOMIC_RELEASE, "agent");
            asm volatile("s_waitcnt vmcnt(0)" ::: "memory");
            const unsigned og = xb_add(&bar[XB_TOP], 1u);
            const unsigned tg = og / nx;
            if (og + 1u == (tg + 1u) * nx) xb_add(&bar[XB_TOPGEN], 1u);
            else XB_SPIN(xb_ld(&bar[XB_TOPGEN]) == tg, bar);
            __builtin_amdgcn_fence(__ATOMIC_ACQUIRE, "agent");
            xb_add(&bar[XB_XGEN(b.x)], 1u);
            asm volatile("s_waitcnt vmcnt(0)" ::: "memory");
        } else {
            XB_SPIN(xb_ld(&bar[XB_XGEN(b.x)]) == gen, bar);
            __builtin_amdgcn_fence(__ATOMIC_ACQUIRE, "agent");
            asm volatile("s_waitcnt vmcnt(0)" ::: "memory");
        }
    }
    __syncthreads();
}

__device__ __forceinline__ unsigned f2bf(float f) { unsigned u = __builtin_bit_cast(unsigned, f); return (u + 0x7fffu + ((u >> 16) & 1u)) >> 16; }
__device__ __forceinline__ unsigned pk2(float lo, float hi) { unsigned r; asm volatile("v_cvt_pk_bf16_f32 %0, %1, %2" : "=v"(r) : "v"(lo), "v"(hi)); return r; }
__device__ __forceinline__ float bf2f(unsigned short v) { return __uint_as_float(((unsigned)v) << 16); }
__device__ __forceinline__ float wave_sum(float v) {
#pragma unroll
    for (int o = 1; o < 64; o <<= 1) v += __shfl_xor(v, o);
    return v;
}
struct TrItem { const GAS float* src; int N; GAS bf16* dst; int ldt; const GAS float* ks; };
__device__ __forceinline__ void tr_load(const TrItem& it, f32x4 (&v)[16], f32x2 (&sc)[8], int lane) {
    const int kq = lane >> 4, nq = lane & 15;
    const GAS float* sp = it.src + (size_t)(2 * kq) * it.N + 4 * nq;
#pragma unroll
    for (int i = 0; i < 8; ++i) { v[2 * i] = *(const GAS f32x4*)(sp + (size_t)(8 * i) * it.N); v[2 * i + 1] = *(const GAS f32x4*)(sp + (size_t)(8 * i + 1) * it.N); }
    if (it.ks) {
#pragma unroll
        for (int i = 0; i < 8; ++i) sc[i] = *(const GAS f32x2*)(it.ks + 8 * i + 2 * kq);
    } else {
#pragma unroll
        for (int i = 0; i < 8; ++i) sc[i] = (f32x2){1.f, 1.f};
    }
}
__device__ __forceinline__ void tr_finish(const TrItem& it, f32x4 (&v)[16], f32x2 (&sc)[8], LAS unsigned* scr, int lane) {
    const int kq = lane >> 4, nq = lane & 15;
#pragma unroll
    for (int i = 0; i < 8; ++i)
#pragma unroll
        for (int j = 0; j < 4; ++j) scr[(4 * nq + j) * 33 + 4 * i + kq] = pk2(v[2 * i][j] * sc[i].x, v[2 * i + 1][j] * sc[i].y);
    LDS_WAIT(); asm volatile("" ::: "memory");
    const int c = lane & 7;
#pragma unroll
    for (int jj = 0; jj < 8; ++jj) { const int n = (lane >> 3) + 8 * jj; const LAS unsigned* s = scr + n * 33 + 4 * c;
        v4u o; o.x = s[0]; o.y = s[1]; o.z = s[2]; o.w = s[3];
        *(GAS v4u*)(it.dst + (size_t)n * it.ldt + 8 * c) = o; }
    LDS_WAIT(); asm volatile("" ::: "memory");
}
__device__ __forceinline__ void p0_transpose_item(const float* src, int N, bf16* dst, int ldt, const float* ks, LAS unsigned* scr, int lane) {
    asm volatile("" : "+v"(lane));
    const TrItem it{(const GAS float*)src, N, (GAS bf16*)dst, ldt, (const GAS float*)ks}; f32x4 v[16]; f32x2 sc[8]; tr_load(it, v, sc, lane); tr_finish(it, v, sc, scr, lane);
}

template <int IDX> __device__ __forceinline__ const float* ldarg_ptr() {
    auto ka = __builtin_amdgcn_kernarg_segment_ptr();
    unsigned long long v; asm volatile("s_load_dwordx2 %0, %1, %2\n\ts_waitcnt lgkmcnt(0)" : "=s"(v) : "s"(ka), "i"(IDX * 8) : "memory"); return (const float*)v;
}
struct Args { const float* in[20]; float* out; unsigned char* ws; int ph_lo, ph_hi, li, pad; };
constexpr int NPH = 9;

__global__ void __launch_bounds__(512, 2) hymba_fwd(Args args) {
    extern __shared__ __attribute__((aligned(16))) unsigned char lds_raw[];
    LAS unsigned char* lds = (LAS unsigned char*)lds_raw;
    const int tid = threadIdx.x, lane = tid & 63, wave = __builtin_amdgcn_readfirstlane(tid >> 6);
    const int G = gridDim.x; const int bx = blockIdx.x; const int vcu = (G % 8 == 0) ? (bx % 8) * (G / 8) + bx / 8 : bx;
    gu32* ctl = (gu32*)(args.ws + WS_CTL);
#define LDARG(i) ldarg_ptr<i>()
#define WSPTR(name, off) bf16* name = (bf16*)(ws + (off))
#define PHASE_WS() unsigned char* ws = args.ws; asm volatile("" : "+s"(ws)); float* out = args.out; asm volatile("" : "+s"(out)); (void)out
    volatile LAS unsigned* MISC = (volatile LAS unsigned*)(lds + MISC_OFF);
    if (tid < 4) MISC[tid] = 0u;
    __syncthreads();
    const int lo = args.ph_lo, hi_ph = args.ph_hi;
    const bool use_bar = (hi_ph - lo) > 1;
    XcdBarrier bar; bar.bar = (unsigned*)(ctl + CW_BAR); bar.x = 0; bar.st = nullptr;
    if (use_bar) bar = xcd_barrier_post((unsigned*)(ctl + CW_BAR), MISC);
#ifndef PHASE_MASK
#define PHASE_MASK 0x1FF
#endif
#define IN(k) (((PHASE_MASK >> (k)) & 1) && lo <= (k) && (k) < hi_ph)
#define BOTH(k) (IN(k) && IN((k) + 1))
#define GRID_BAR() do { xcd_barrier(bar); } while (0)
    const int gw = vcu * 8 + wave, NGW = G * 8;

    if (IN(0)) {
        PHASE_WS(); WSPTR(wfrag, WS_WFRAG); WSPTR(bt2, WS_BT2); WSPTR(win_t, WS_WIN); WSPTR(wout_t, WS_WOUT); WSPTR(wout_t2, WS_WOUT2); WSPTR(XN, WS_XN);
        const float* x = LDARG(0); const float* norm1_g = LDARG(1); const float* w_in = LDARG(2); const float* pool_w = LDARG(8); const float* pool_scale = LDARG(9); const float* w_out = LDARG(10);
        const float* norm2_g = LDARG(11); const float* w_coarse = LDARG(12); const float* w_fine = LDARG(14);
        LAS unsigned* scr = (LAS unsigned*)(lds + wave * 16384);
        constexpr int I_IN = 32 * 64, I_OUT = 32 * 32, I_OUT2 = 16 * 32;
        constexpr int NITEMS = I_IN + I_OUT + I_OUT2;
        for (int it = gw; it < NITEMS; it += NGW) {
            int r = it;
            if (r < I_IN) { const int kb = r / 64, nb = r % 64, k0 = 64 * kb, n0 = 64 * nb; p0_transpose_item(w_in + (size_t)k0 * INW + n0, INW, win_t + (size_t)n0 * D + k0, D, nullptr, scr, lane); continue; } r -= I_IN;
            if (r < I_OUT) { const int kb = r / 32, nb = r % 32, k0 = 64 * kb, n0 = 64 * nb; p0_transpose_item(w_out + (size_t)k0 * D + n0, D, wout_t + (size_t)n0 * D + k0, D, nullptr, scr, lane); continue; } r -= I_OUT;
            { const int kb = r / 32, nb = r % 32, k0 = 64 * kb, n0 = 64 * nb; p0_transpose_item(w_out + (size_t)k0 * D + n0, D, wout_t2 + (size_t)n0 * D + k0, D, nullptr, scr, lane); }
        }
        for (int i = blockIdx.x * 512 + tid; i < 4 * 256 * 256 / 4; i += G * 512) { const int e4 = (i & 63) * 4, gc = i >> 6, g = gc >> 8;
            const f32x4 w = *(const f32x4*)(pool_w + (size_t)gc * 256 + e4); const f32x4 s = *(const f32x4*)(pool_scale + g * 256 + e4);
            v2u o; o.x = pk2(w[0] * s[0], w[1] * s[1]); o.y = pk2(w[2] * s[2], w[3] * s[3]); *(v2u*)(bt2 + (size_t)gc * 256 + e4) = o; }
        for (int i = blockIdx.x * 512 + tid; i < 128 * 2 * 64; i += G * 512) { const int ln = i & 63, nt_ = (i >> 6) & 1, gs = i >> 7; const int n = ln & 31;
            unsigned hw[4], lw[4];
#pragma unroll
            for (int jp = 0; jp < 4; ++jp) { float v[2];
#pragma unroll
                for (int q = 0; q < 2; ++q) { const int k = 16 * gs + 8 * (ln >> 5) + 2 * jp + q; float w = 0.f;
                    if (nt_ == 0) w = w_fine[((size_t)(n >> 3) * D + k) * 8 + (n & 7)]; else if (n < 4) w = w_coarse[(size_t)k * 4 + n];
                    v[q] = w * norm2_g[k]; }
                const unsigned h0 = f2bf(v[0]), h1 = f2bf(v[1]); hw[jp] = h0 | (h1 << 16);
                lw[jp] = f2bf(v[0] - __uint_as_float(h0 << 16)) | (f2bf(v[1] - __uint_as_float(h1 << 16)) << 16); }
            *(v4u*)(wfrag + ((size_t)((gs * 2 + nt_) * 2 + 0) * 64 + ln) * 8) = (v4u){hw[0], hw[1], hw[2], hw[3]};
            *(v4u*)(wfrag + ((size_t)((gs * 2 + nt_) * 2 + 1) * 64 + ln) * 8) = (v4u){lw[0], lw[1], lw[2], lw[3]}; }
        for (int m = gw; m < T; m += NGW) {
            const f32x4* xr = (const f32x4*)(x + (size_t)m * D) + 2 * lane; f32x4 v[8]; float s = 0.f;
#pragma unroll
            for (int j = 0; j < 4; ++j) { v[2 * j] = xr[128 * j]; v[2 * j + 1] = xr[128 * j + 1]; }
#pragma unroll
            for (int j = 0; j < 8; ++j) s += (v[j].x * v[j].x + v[j].y * v[j].y) + (v[j].z * v[j].z + v[j].w * v[j].w);
            const float rstd = rsqrtf(wave_sum(s) * (1.f / D) + RMS_EPS);
            v4u* o16 = (v4u*)(XN + (size_t)m * D) + lane;
#pragma unroll
            for (int j = 0; j < 4; ++j) { const f32x4 g0 = ((const f32x4*)norm1_g)[2 * lane + 128 * j], g1 = ((const f32x4*)norm1_g)[2 * lane + 128 * j + 1]; const f32x4 a = v[2 * j] * rstd * g0, c = v[2 * j + 1] * rstd * g1;
                o16[64 * j] = (v4u){pk2(a.x, a.y), pk2(a.z, a.w), pk2(c.x, c.y), pk2(c.z, c.w)}; }
        }
        if (BOTH(0)) GRID_BAR();
    }

    if (IN(1)) {
        PHASE_WS(); WSPTR(win_t, WS_WIN); WSPTR(XN, WS_XN); WSPTR(Qb, WS_Q);
        { pg8::DenseOrder S; S.init(T, INW, G, bx, XN, win_t, D, D);
          pg8::EpiStoreBf16 E{Qb, AW, AW, (size_t)T * AW, C2};
          pg8::gemm_phase<pg8::EpiStoreBf16, pg8::DenseOrder, true, false>(lds, D / 64, D, D, S, E); }
        if (BOTH(1)) GRID_BAR();
    }

    if (IN(2)) {
        PHASE_WS(); WSPTR(Qb, WS_Q); WSPTR(Kb, WS_K); WSPTR(Vb, WS_V); WSPTR(Ub, WS_U); WSPTR(A3, WS_A3);
        for (int tb = vcu; tb < T / 32; tb += G) {
            const int gi = wave & 3, chg = lane & 31;
#pragma unroll 1
            for (int k = 0; k < 8; ++k) {
                const int t = tb * 32 + (wave >> 2) * 16 + 2 * k + (lane >> 5), pos = t & (SEQ - 1);
                const bf16* up = Ub + (size_t)t * AW + gi * 256 + chg * 8;
                float a[8];
#pragma unroll
                for (int j = 0; j < 8; ++j) a[j] = 0.f;
                v4u self;
#define POOL_W(W) do { v4u v_[W]; _Pragma("unroll") for (int i = 0; i < W; ++i) { const int back = (i <= pos) ? i : pos; v_[i] = *(const v4u*)(up - (size_t)back * AW); } self = v_[0]; \
                    _Pragma("unroll") for (int i = 0; i < W; ++i) { const float wgt = (i <= pos) ? 1.f : 0.f; _Pragma("unroll") for (int j = 0; j < 4; ++j) { a[2 * j] += wgt * __uint_as_float(v_[i][j] << 16); a[2 * j + 1] += wgt * __uint_as_float(v_[i][j] & 0xffff0000u); } } } while (0)
                if (gi == 0) POOL_W(2); else if (gi == 1) POOL_W(4); else if (gi == 2) POOL_W(8); else POOL_W(16);
#undef POOL_W
                const int w = 2 << gi; const int cw = (pos + 1 < w) ? pos + 1 : w;
                const float inv = 1.0f / (float)cw; v4u o;
#pragma unroll
                for (int j = 0; j < 4; ++j) { const float s0 = __uint_as_float(self[j] << 16), s1 = __uint_as_float(self[j] & 0xffff0000u); o[j] = pk2(a[2 * j] * inv - s0, a[2 * j + 1] * inv - s1); }
                *(v4u*)(A3 + (size_t)t * D + AW + gi * 256 + chg * 8) = o; }
        }
        { WSPTR(bt2, WS_BT2); WSPTR(wout_t, WS_WOUT); WSPTR(wout_t2, WS_WOUT2);
          pg8::W2Order S{G, bx, (const char*)wout_t, (const char*)bt2};
          pg8::EpiStoreBf16 E{wout_t2, D, 0, 0, 1.f};
          int nt_w2 = 256 / 64; asm volatile("" : "+s"(nt_w2));
          pg8::gemm_phase<pg8::EpiStoreBf16, pg8::W2Order, true, false>(lds, nt_w2, D, 256, S, E);
          __syncthreads(); }
        const float* lq1 = LDARG(3); const float* lk1 = LDARG(4); const float* lq2 = LDARG(5); const float* lk2 = LDARG(6); const float* subln_g = LDARG(7);
        float lam;
        { const float p1 = wave_sum(lq1[lane] * lk1[lane]), p2 = wave_sum(lq2[lane] * lk2[lane]); lam = expf(p1) - expf(p2) + 0.2f; }
        LAS float* wsf = (LAS float*)(lds + WSF_OFF);
        {
            volatile LAS int* qslot = (volatile LAS int*)(lds + MISC_OFF + 32);
            LAS unsigned* scr = (LAS unsigned*)(lds + wave * 16384);
            const bool prefer_cvt = (vcu & 7) < 3;
#ifdef PROBE_TIME
            if (tid == 0) { volatile LAS unsigned* pa_ = (volatile LAS unsigned*)(lds + MISC_OFF + 64); pa_[0] = 0u; pa_[1] = 0u; pa_[2] = 0u; pa_[3] = 0u; }
            __syncthreads();
            const unsigned long long pq0_ = __builtin_amdgcn_s_memrealtime();
#endif
            bool att_left = true, cvt_left = true;
            constexpr int CVT_CH = 32, NCH = 24576 / CVT_CH, I_GU = 2 * 32 * 8 * 32;
            const int xq = (int)(xb_xcc_id() & 7u); int qoff = 0;
            for (;;) {
                int kind = -1, idx = 0, aq = 0;
#pragma unroll 1
                for (int pass = 0; pass < 2 && kind < 0; ++pass) {
                    const bool try_cvt = (pass == 0) ? prefer_cvt : !prefer_cvt;
                    if (try_cvt) {
                        if (cvt_left) {
                            if (tid == 0) qslot[0] = (int)__hip_atomic_fetch_add((unsigned*)(ctl + CW_QCVT), 1u, RLX_AGENT);
                            __syncthreads(); idx = qslot[0]; __syncthreads();
                            if (idx < NCH) kind = 1; else cvt_left = false;
                        }
                    } else {
                        while (att_left && kind < 0) {
                            aq = (xq + qoff) & 7;
                            if (tid == 0) qslot[0] = (int)__hip_atomic_fetch_add((unsigned*)(ctl + CW_QATT + 64 * aq), 1u, RLX_AGENT);
                            __syncthreads(); idx = qslot[0]; __syncthreads();
                            if (idx < 64) kind = 0; else { ++qoff; if (qoff == 8) att_left = false; }
                        }
                    }
                }
                if (kind < 0) break;
                if (kind == 1) {
                    const float* norm2_g = LDARG(11); const float* w_gate = LDARG(16); const float* w_up = LDARG(17); const float* w_down = LDARG(18);
                    unsigned char* ws2 = args.ws; asm volatile("" : "+s"(ws2)); bf16* wgu_t = (bf16*)(ws2 + WS_WGU); bf16* wd_t = (bf16*)(ws2 + WS_WD);
                    int lane2 = lane; asm volatile("" : "+v"(lane2));
#define CVT_ITEM(IT, rr) do { int r = (rr); if (r < I_GU) { const bool up = r >= I_GU / 2; if (up) r -= I_GU / 2; const int e = r / 256, q = r % 256, kb = q / 8, nb = q % 8, k0 = 64 * kb, n0 = 64 * nb; \
                            const float* W = (up ? w_up : w_gate) + (size_t)e * D * FF; const int drow = (n0 >> 7) * 256 + (up ? 128 : 0) + (n0 & 127); \
                            IT = TrItem{(const GAS float*)(W + (size_t)k0 * FF + n0), FF, (GAS bf16*)(wgu_t + ((size_t)e * 1024 + drow) * D + k0), D, (const GAS float*)(norm2_g + k0)}; } \
                        else { r -= I_GU; const int e = r / 256, q = r % 256, kb = q / 32, nb = q % 32, k0 = 64 * kb, n0 = 64 * nb; \
                            IT = TrItem{(const GAS float*)(w_down + (size_t)e * FF * D + (size_t)k0 * D + n0), D, (GAS bf16*)(wd_t + ((size_t)e * D + n0) * FF + k0), FF, (const GAS float*)nullptr}; } } while (0)
                    const int r0 = idx * CVT_CH + wave * (CVT_CH / 8);
                    TrItem ia, ib; f32x4 va[16], vb2[16]; f32x2 sa[8], sb[8];
                    CVT_ITEM(ia, r0); tr_load(ia, va, sa, lane2);
#pragma unroll 1
                    for (int i = 0; i < CVT_CH / 8; i += 2) {
                        CVT_ITEM(ib, r0 + i + 1); tr_load(ib, vb2, sb, lane2);
                        tr_finish(ia, va, sa, scr, lane2);
                        if (i + 2 < CVT_CH / 8) { CVT_ITEM(ia, r0 + i + 2); tr_load(ia, va, sa, lane2); }
                        tr_finish(ib, vb2, sb, scr, lane2);
                    }
#undef CVT_ITEM
                } else {
                    const int qb = 15 - (idx & 15), bh = aq + 8 * (idx >> 4);
#ifdef PROBE_TIME
                    const unsigned long long pu0_ = __builtin_amdgcn_s_memrealtime();
#endif
                    att::attn_unit(bh >> 3, bh & 7, qb, Qb, Kb, Vb, A3, subln_g, lam, lds, wsf);
#ifdef PROBE_TIME
                    if (tid == 0) { volatile LAS unsigned* pa_ = (volatile LAS unsigned*)(lds + MISC_OFF + 64); pa_[2] += (unsigned)(__builtin_amdgcn_s_memrealtime() - pu0_); pa_[3] += 1u; }
#endif
                }
            }
#ifdef PROBE_TIME
            __syncthreads();
            if (bx == 16) { volatile LAS unsigned* pa_ = (volatile LAS unsigned*)(lds + MISC_OFF + 64);
                const unsigned long long now_ = __builtin_amdgcn_s_memrealtime();
                unsigned long long q_ = (PROBE_TIME == 1) ? pa_[0] : (PROBE_TIME == 2) ? pa_[2] : (PROBE_TIME == 3) ? (unsigned)(now_ - pq0_) : (PROBE_TIME == 4) ? pa_[1] * 100ull : pa_[3] * 1000ull;
                const unsigned long long until_ = now_ + 3ull * q_;
                while (__builtin_amdgcn_s_memrealtime() < until_) __builtin_amdgcn_s_sleep(8); }
#endif
        }
        if (BOTH(2)) GRID_BAR();
    }

    if (IN(3)) {
        PHASE_WS(); WSPTR(wout_t2, WS_WOUT2); WSPTR(A3, WS_A3); WSPTR(rb, WS_RB);
        pg8::DenseOrder S; S.init(T, D, G, bx, A3, wout_t2, D, D);
        pg8::EpiStoreBf16 E{rb, D, 0, 0, 1.f};
        pg8::gemm_phase<pg8::EpiStoreBf16, pg8::DenseOrder, true, false>(lds, D / 64, D, D, S, E);
        if (BOTH(3)) GRID_BAR();
    }

    if (IN(4)) {
        PHASE_WS(); WSPTR(wfrag, WS_WFRAG); WSPTR(rb, WS_RB); WSPTR(hb, WS_HB); unsigned* tokl = (unsigned*)(ws + WS_TOK); f32x2* swl = (f32x2*)(ws + WS_SW);
        const float* x = LDARG(0); const float* norm2_g = LDARG(11); const float* b_coarse = LDARG(13); const float* b_fine = LDARG(15);
        LAS float* part = (LAS float*)lds;
        LAS float* ssqs = (LAS float*)(lds + 73728);
        LAS float* logit = (LAS float*)(lds + 73728 + 1024);
        const int r32 = lane & 31, hi = lane >> 5, rsub = lane >> 4, cg = lane & 15;
        LAS unsigned char* stg = lds + wave * 9216;
        const __amdgpu_buffer_rsrc_t rsx = __builtin_amdgcn_make_buffer_rsrc((void*)x, 0, T * D * 4, 0x00020000);
        const __amdgpu_buffer_rsrc_t rsr = __builtin_amdgcn_make_buffer_rsrc((void*)rb, 0, T * D * 2, 0x00020000);
        const __amdgpu_buffer_rsrc_t rsh = __builtin_amdgcn_make_buffer_rsrc((void*)hb, 0, T * D * 2, 0x00020000);
        for (int rblk = vcu; rblk < T / 32; rblk += G) {
            const int R0 = rblk * 32;
            const unsigned vo4 = (unsigned)(rsub * D + 4 * cg) * 4u, vo2 = (unsigned)(rsub * D + 4 * cg) * 2u; const unsigned so0 = (unsigned)(R0 * D + wave * 256);
            f32x16 acc0, acc1;
#pragma unroll
            for (int r = 0; r < 16; ++r) { acc0[r] = 0.f; acc1[r] = 0.f; }
            float sq[8];
#pragma unroll
            for (int j = 0; j < 8; ++j) sq[j] = 0.f;
            f32x4 xa[8]; v2u ra[8];
#define P4_LOAD(XV, RV, c) do { _Pragma("unroll") for (int j = 0; j < 8; ++j) { const unsigned so_ = so0 + (unsigned)(4 * j * D + 64 * (c)); \
                XV[j] = __builtin_bit_cast(f32x4, __builtin_amdgcn_raw_buffer_load_b128(rsx, vo4, so_ * 4u, 0)); RV[j] = __builtin_amdgcn_raw_buffer_load_b64(rsr, vo2, so_ * 2u, 0); } } while (0)
#define P4_CHUNK(XV, RV, c, NEXT) do { \
                bf16x8 wfr[4][4]; \
                _Pragma("unroll") for (int s_ = 0; s_ < 4; ++s_) { const bf16x8* wf_ = (const bf16x8*)wfrag + (size_t)(wave * 16 + 4 * (c) + s_) * 256 + lane; wfr[s_][0] = wf_[0]; wfr[s_][1] = wf_[64]; wfr[s_][2] = wf_[128]; wfr[s_][3] = wf_[192]; } \
                _Pragma("unroll") for (int j = 0; j < 8; ++j) { f32x4 h4 = XV[j]; \
                    h4.x += __uint_as_float(RV[j].x << 16); h4.y += __uint_as_float(RV[j].x & 0xffff0000u); h4.z += __uint_as_float(RV[j].y << 16); h4.w += __uint_as_float(RV[j].y & 0xffff0000u); \
                    sq[j] += (h4.x * h4.x + h4.y * h4.y) + (h4.z * h4.z + h4.w * h4.w); \
                    const unsigned h01 = pk2(h4.x, h4.y), h23 = pk2(h4.z, h4.w); \
                    __builtin_amdgcn_raw_buffer_store_b64((v2u){h01, h23}, rsh, vo2, (so0 + (unsigned)(4 * j * D + 64 * (c))) * 2u, 0); \
                    const unsigned l01 = pk2(h4.x - __uint_as_float(h01 << 16), h4.y - __uint_as_float(h01 & 0xffff0000u)), l23 = pk2(h4.z - __uint_as_float(h23 << 16), h4.w - __uint_as_float(h23 & 0xffff0000u)); \
                    *(LAS v2u*)(stg + (4 * j + rsub) * 144 + cg * 8) = (v2u){h01, h23}; *(LAS v2u*)(stg + 4608 + (4 * j + rsub) * 144 + cg * 8) = (v2u){l01, l23}; } \
                if (NEXT) { P4_LOAD(XV, RV, (c) + 1); } \
                LDS_WAIT(); asm volatile("" ::: "memory"); \
                _Pragma("unroll") for (int s_ = 0; s_ < 4; ++s_) { \
                    const bf16x8 ah = *(const LAS bf16x8*)(stg + r32 * 144 + s_ * 32 + hi * 16), al = *(const LAS bf16x8*)(stg + 4608 + r32 * 144 + s_ * 32 + hi * 16); \
                    acc0 = __builtin_amdgcn_mfma_f32_32x32x16_bf16(ah, wfr[s_][0], acc0, 0, 0, 0); acc0 = __builtin_amdgcn_mfma_f32_32x32x16_bf16(al, wfr[s_][0], acc0, 0, 0, 0); acc0 = __builtin_amdgcn_mfma_f32_32x32x16_bf16(ah, wfr[s_][1], acc0, 0, 0, 0); \
                    acc1 = __builtin_amdgcn_mfma_f32_32x32x16_bf16(ah, wfr[s_][2], acc1, 0, 0, 0); acc1 = __builtin_amdgcn_mfma_f32_32x32x16_bf16(al, wfr[s_][2], acc1, 0, 0, 0); acc1 = __builtin_amdgcn_mfma_f32_32x32x16_bf16(ah, wfr[s_][3], acc1, 0, 0, 0); } \
                LDS_WAIT(); asm volatile("" ::: "memory"); __builtin_amdgcn_sched_barrier(0); } while (0)
            P4_LOAD(xa, ra, 0);
#pragma unroll 1
            for (int c = 0; c < 4; ++c) P4_CHUNK(xa, ra, c, c < 3);
#undef P4_LOAD
#undef P4_CHUNK
#pragma unroll
            for (int j = 0; j < 8; ++j) {
#pragma unroll
                for (int off = 1; off < 16; off <<= 1) sq[j] += __shfl_xor(sq[j], off);
            }
            __syncthreads();
#pragma unroll
            for (int r = 0; r < 16; ++r) { part[((wave * 2 + 0) * 16 + r) * 64 + lane] = acc0[r]; part[((wave * 2 + 1) * 16 + r) * 64 + lane] = acc1[r]; }
            if (cg == 0) {
#pragma unroll
                for (int j = 0; j < 8; ++j) ssqs[wave * 32 + 4 * j + rsub] = sq[j]; }
            __syncthreads();
#pragma unroll
            for (int q = 0; q < 4; ++q) { const int idx = tid + 512 * q; float sm = 0.f;
#pragma unroll
                for (int w = 0; w < 8; ++w) sm += part[w * 2048 + idx];
                const int nt_ = idx >> 10, r = (idx >> 6) & 15, ln = idx & 63; const int row = att::crow(r, ln >> 5), n = nt_ * 32 + (ln & 31);
                logit[row * 64 + n] = sm; }
            __syncthreads();
            if (tid < 32) {
                const int row = tid, token = R0 + row; float ss = 0.f;
#pragma unroll
                for (int w = 0; w < 8; ++w) ss += ssqs[w * 32 + row];
                const float rs = rsqrtf(ss * (1.f / D) + RMS_EPS);
                const LAS float* lg = logit + row * 64;
                float c[4];
#pragma unroll
                for (int k = 0; k < 4; ++k) c[k] = lg[32 + k] * rs + b_coarse[k];
                float cb = c[0]; int g = 0;
#pragma unroll
                for (int k = 1; k < 4; ++k) if (c[k] > cb) { cb = c[k]; g = k; }
                float den = 0.f;
#pragma unroll
                for (int k = 0; k < 4; ++k) den += expf(c[k] - cb);
                const float pg = 1.0f / den;
                float f[8];
#pragma unroll
                for (int k = 0; k < 8; ++k) f[k] = lg[g * 8 + k] * rs + b_fine[g * 8 + k];
                float v0 = f[0]; int i0 = 0;
#pragma unroll
                for (int k = 1; k < 8; ++k) if (f[k] > v0) { v0 = f[k]; i0 = k; }
                float v1 = -INFINITY; int i1 = 0;
#pragma unroll
                for (int k = 0; k < 8; ++k) if (k != i0 && f[k] > v1) { v1 = f[k]; i1 = k; }
                const float ex = expf(v1 - v0); const float w0 = pg / (1.0f + ex), w1 = pg * ex / (1.0f + ex);
                const int e0 = g * 8 + i0, e1 = g * 8 + i1;
                const unsigned s0 = __hip_atomic_fetch_add((unsigned*)(ctl + CW_CNT + 64 * e0), 1u, RLX_AGENT);
                const unsigned s1 = __hip_atomic_fetch_add((unsigned*)(ctl + CW_CNT + 64 * e1), 1u, RLX_AGENT);
                tokl[(size_t)e0 * 8192 + s0] = (unsigned)token; swl[(size_t)e0 * 8192 + s0] = (f32x2){rs, w0};
                tokl[(size_t)e1 * 8192 + s1] = (unsigned)token | 0x10000u; swl[(size_t)e1 * 8192 + s1] = (f32x2){rs, w1};
            }
        }
        __syncthreads();
        if (BOTH(4)) GRID_BAR();
    }

    if (IN(5) || IN(6) || IN(7)) {
        PHASE_WS(); WSPTR(hb, WS_HB); WSPTR(wgu_t, WS_WGU); WSPTR(wd_t, WS_WD); WSPTR(hmid, WS_HMID); WSPTR(yb, WS_Y); unsigned* tokl = (unsigned*)(ws + WS_TOK); f32x2* swl = (f32x2*)(ws + WS_SW);
        LAS int* tab = (LAS int*)(lds + TAB_OFF);
        if (tid < 32) tab[40 + tid] = (int)__hip_atomic_load((unsigned*)(ctl + CW_CNT + 64 * tid), RLX_AGENT);
        __syncthreads();
        if (tid == 0) { int acc = 0; for (int e = 0; e < 32; ++e) { tab[e] = acc; acc += (tab[40 + e] + 255) >> 8; } tab[32] = acc; }
        __syncthreads();
        const int NTt = __builtin_amdgcn_readfirstlane(tab[32]); const int T0 = NTt < 64 ? NTt : 64;
        int nb = (NTt - T0) * 4; if (nb > G / 2) nb = G / 2;
        if (IN(5)) {
            pg8::MoeOrder<4, true> S{0, G, bx, 0, T0, tab, (const char*)hb, (const char*)wgu_t, tokl};
            pg8::EpiGateUp E{hmid, swl};
            pg8::gemm_phase<pg8::EpiGateUp, pg8::MoeOrder<4, true>, true, true>(lds, D / 64, D, D, S, E);
            if (BOTH(5)) GRID_BAR();
        }
        if (IN(6)) {
            { pg8::MoeOrder<4, true> S{0, nb, bx, T0, NTt, tab, (const char*)hb, (const char*)wgu_t, tokl};
              pg8::EpiGateUp E{hmid, swl};
              pg8::gemm_phase<pg8::EpiGateUp, pg8::MoeOrder<4, true>, true, true>(lds, D / 64, D, D, S, E); }
            { pg8::MoeOrder<8, false> S{nb, G - nb, bx, 0, T0, tab, (const char*)hmid, (const char*)wd_t, tokl};
              pg8::EpiDown E{yb, tokl};
              pg8::gemm_phase<pg8::EpiDown, pg8::MoeOrder<8, false>, true, false>(lds, FF / 64, FF, FF, S, E); }
            if (BOTH(6)) GRID_BAR();
        }
        if (IN(7)) {
            pg8::MoeOrder<8, false> S{0, G, bx, T0, NTt, tab, (const char*)hmid, (const char*)wd_t, tokl};
            pg8::EpiDown E{yb, tokl};
            pg8::gemm_phase<pg8::EpiDown, pg8::MoeOrder<8, false>, true, false>(lds, FF / 64, FF, FF, S, E);
            if (BOTH(7)) GRID_BAR();
        }
    }

    if (IN(8)) {
        PHASE_WS(); WSPTR(yb, WS_Y); WSPTR(hb, WS_HB);
        const float* final_g = LDARG(19);
        for (int m = gw; m < T; m += NGW) {
            f32x4* orow = (f32x4*)(out + (size_t)m * D) + 2 * lane; f32x4 v[8]; float s = 0.f;
            const v4u* y0 = (const v4u*)(yb + (size_t)m * D) + lane; const v4u* y1 = (const v4u*)(yb + ((size_t)T + m) * D) + lane; const v4u* r0 = (const v4u*)(hb + (size_t)m * D) + lane;
#pragma unroll
            for (int j = 0; j < 4; ++j) { const v4u a = y0[64 * j], b = y1[64 * j], c = r0[64 * j];
                v[2 * j].x = __uint_as_float(a.x << 16) + __uint_as_float(b.x << 16) + __uint_as_float(c.x << 16); v[2 * j].y = __uint_as_float(a.x & 0xffff0000u) + __uint_as_float(b.x & 0xffff0000u) + __uint_as_float(c.x & 0xffff0000u);
                v[2 * j].z = __uint_as_float(a.y << 16) + __uint_as_float(b.y << 16) + __uint_as_float(c.y << 16); v[2 * j].w = __uint_as_float(a.y & 0xffff0000u) + __uint_as_float(b.y & 0xffff0000u) + __uint_as_float(c.y & 0xffff0000u);
                v[2 * j + 1].x = __uint_as_float(a.z << 16) + __uint_as_float(b.z << 16) + __uint_as_float(c.z << 16); v[2 * j + 1].y = __uint_as_float(a.z & 0xffff0000u) + __uint_as_float(b.z & 0xffff0000u) + __uint_as_float(c.z & 0xffff0000u);
                v[2 * j + 1].z = __uint_as_float(a.w << 16) + __uint_as_float(b.w << 16) + __uint_as_float(c.w << 16); v[2 * j + 1].w = __uint_as_float(a.w & 0xffff0000u) + __uint_as_float(b.w & 0xffff0000u) + __uint_as_float(c.w & 0xffff0000u); }
#pragma unroll
            for (int j = 0; j < 8; ++j) s += (v[j].x * v[j].x + v[j].y * v[j].y) + (v[j].z * v[j].z + v[j].w * v[j].w);
            const float rstd = rsqrtf(wave_sum(s) * (1.f / D) + RMS_EPS);
#pragma unroll
            for (int j = 0; j < 4; ++j) { const f32x4 g0 = ((const f32x4*)final_g)[2 * lane + 128 * j], g1 = ((const f32x4*)final_g)[2 * lane + 128 * j + 1]; orow[128 * j] = v[2 * j] * rstd * g0; orow[128 * j + 1] = v[2 * j + 1] * rstd * g1; }
        }
    }
#undef IN
#undef BOTH
#undef GRID_BAR
}

extern "C" void kernel_launch(void* const* d_in, const int* in_sizes, int n_in, void* d_out, int out_size, void* d_ws, size_t ws_size, hipStream_t stream) {
    static int grid = 0;
    if (grid == 0) {
        if (n_in != 20 || out_size != T * D || ws_size < WS_END) { fprintf(stderr, "kernel_launch: unexpected shapes (n_in %d out %d ws %zu)\n", n_in, out_size, ws_size); grid = -1; return; }
        int dev = 0, cus = 0, per_cu = 0;
        if (hipGetDevice(&dev) != hipSuccess || hipDeviceGetAttribute(&cus, hipDeviceAttributeMultiprocessorCount, dev) != hipSuccess) { grid = -1; return; }
        if (hipFuncSetAttribute((const void*)hymba_fwd, hipFuncAttributeMaxDynamicSharedMemorySize, LDS_BYTES) != hipSuccess) { fprintf(stderr, "kernel_launch: hipFuncSetAttribute failed\n"); grid = -1; return; }
        if (hipOccupancyMaxActiveBlocksPerMultiprocessor(&per_cu, (const void*)hymba_fwd, 512, LDS_BYTES) != hipSuccess || per_cu < 1) fprintf(stderr, "kernel_launch: occupancy query reports %d\n", per_cu);
        (void)hipGetLastError();
        grid = cus;
    }
    if (grid < 0) return;
    (void)hipMemsetAsync((char*)d_ws + WS_CTL, 0, CTL_ZERO_BYTES, stream);
    Args a{};
    for (int i = 0; i < 20; ++i) a.in[i] = (const float*)d_in[i];
    a.out = (float*)d_out; a.ws = (unsigned char*)d_ws;
    if (MK_N_LAUNCHES == 1) { a.ph_lo = 0; a.ph_hi = NPH; a.li = 0; hipLaunchKernelGGL(hymba_fwd, dim3(grid), dim3(512), LDS_BYTES, stream, a); }
    else { for (int p = 0; p < NPH; ++p) { a.ph_lo = p; a.ph_hi = p + 1; a.li = p; hipLaunchKernelGGL(hymba_fwd, dim3(grid), dim3(512), LDS_BYTES, stream, a);
            if (p == PROBE_DUP) { if (p == 4) (void)hipMemsetAsync((char*)d_ws + WS_CTL, 0, CTL_ZERO_BYTES, stream); if (p == 2) (void)hipMemsetAsync((char*)d_ws + WS_CTL + CW_QATT * 4, 0, 8 * 256, stream); hipLaunchKernelGGL(hymba_fwd, dim3(grid), dim3(512), LDS_BYTES, stream, a); } } }
}
```

```cpp
#include <hip/hip_runtime.h>
#include <hip/hip_bf16.h>
#include <cstdio>
#include <cstdint>

#ifndef MK_N_LAUNCHES
#define MK_N_LAUNCHES 1
#endif
#ifndef PROBE_DUP
#define PROBE_DUP -1
#endif

#define GAS __attribute__((address_space(1)))
#define LAS __attribute__((address_space(3)))
typedef unsigned short bf16;
typedef unsigned v4u __attribute__((ext_vector_type(4)));
typedef unsigned v2u __attribute__((ext_vector_type(2)));
typedef float f32x4 __attribute__((ext_vector_type(4)));
typedef float f32x2 __attribute__((ext_vector_type(2)));
typedef float f32x16 __attribute__((ext_vector_type(16)));
typedef short bf16x8 __attribute__((ext_vector_type(8)));
typedef short s16x4 __attribute__((ext_vector_type(4)));
typedef GAS unsigned gu32;
#define RLX_AGENT __ATOMIC_RELAXED, __HIP_MEMORY_SCOPE_AGENT
#define LDS_WAIT() asm volatile("s_waitcnt lgkmcnt(0)" ::: "memory")
#define VM_WAIT() asm volatile("s_waitcnt vmcnt(0)" ::: "memory")

constexpr int T = 8192, SEQ = 2048, D = 2048, INW = 4096, AW = 1024, NH = 8, NE = 32, FF = 512;
constexpr float RMS_EPS = 1e-6f;
constexpr float LOG2E = 1.4426950408889634f;
constexpr float C2 = 0.125f * LOG2E;

constexpr size_t MiB = 1u << 20;
constexpr size_t WS_CTL = 0, CTL_ZERO_BYTES = 32768;
constexpr size_t WS_WFRAG = 1 * MiB;
constexpr size_t WS_BT2 = 1 * MiB + 512 * 1024;
constexpr size_t WS_WIN = 2 * MiB;
constexpr size_t WS_WOUT = 18 * MiB;
constexpr size_t WS_WOUT2 = 26 * MiB;
constexpr size_t WS_TOK = 34 * MiB;
constexpr size_t WS_SW = 35 * MiB;
constexpr size_t WS_WGU = 40 * MiB;
constexpr size_t WS_WD = 168 * MiB;
constexpr size_t WS_XN = 232 * MiB;
constexpr size_t WS_HMID = 232 * MiB;
constexpr size_t WS_Q = 264 * MiB, WS_K = 280 * MiB, WS_V = 296 * MiB, WS_U = 312 * MiB;
constexpr size_t WS_Y = 264 * MiB;
constexpr size_t WS_A3 = 328 * MiB;
constexpr size_t WS_HB = 360 * MiB;
constexpr size_t WS_RB = 392 * MiB;
constexpr size_t WS_END = 424 * MiB;
constexpr int CW_CNT = 1024;
constexpr int CW_QATT = 3072, CW_QCVT = 3584;
constexpr int CW_BAR = 4096;

constexpr int RING_BYTES = 131072;
constexpr int WSF_OFF = RING_BYTES;
constexpr int TAB_OFF = WSF_OFF + 2048;
constexpr int MISC_OFF = TAB_OFF + 512;
constexpr int LDS_BYTES = 147456;

namespace pg8 {
#define PG8_LAS __attribute__((address_space(3)))
typedef unsigned short bf16_t;
typedef unsigned u32x4 __attribute__((ext_vector_type(4)));
constexpr int BM = 256, BK = 64, HALF = 128, HTB = HALF * BK * 2, STAGE_BYTES = 8 * HTB, NXCD = 8, WGM = 8;

__host__ __device__ __forceinline__ int lds_byte(int r, int c) { const int st = (r >> 4) * 2 + (c >> 5), rr = r & 15, cc = c & 31, ob = rr * 64 + cc * 2; return st * 1024 + (ob ^ (((ob >> 9) & 1) << 5)); }
__host__ __device__ __forceinline__ void stage_rc(int b, int& R, int& C) { const int st = b / 1024, sb = b % 1024, swz = sb ^ (((sb >> 9) & 1) << 5); R = (st >> 1) * 16 + swz / 64; C = (st & 1) * 32 + (swz % 64) / 2; }
__host__ __device__ __forceinline__ int perm32(int rho) { const int n = rho >> 4, i = rho & 15; return 8 * (i >> 2) + 4 * n + (i & 3); }

struct Unit { const char* a; const char* b; int orow, ocol, e, s0, cnt; };

__device__ __forceinline__ unsigned cvt_pk_bf16(float lo, float hi) { unsigned r; asm volatile("v_cvt_pk_bf16_f32 %0, %1, %2" : "=v"(r) : "v"(lo), "v"(hi)); return r; }

struct DenseOrder {
    int nM, nN, nwg, G, c; const char* A; const char* Bt; size_t tsA, tsB;
    __device__ void init(int M, int N, int G_, int c_, const void* A_, const void* Bt_, int lda, int ldb) { nM = M / BM; nN = N / BM; nwg = nM * nN; G = G_; c = c_; A = (const char*)A_; Bt = (const char*)Bt_; tsA = (size_t)BM * lda * 2; tsB = (size_t)BM * ldb * 2; }
    __device__ bool next(int i, Unit& u) const {
        const long L = (long)i * G + c; if (L >= nwg) return false;
        int wgid = (int)L; { const int q = nwg / NXCD, r = nwg % NXCD, xcd = wgid % NXCD, off = wgid / NXCD; wgid = (xcd < r ? xcd * (q + 1) : r * (q + 1) + (xcd - r) * q) + off; }
        const int nig = WGM * nN, gid = wgid / nig, fm = gid * WGM, gsz = (nM - fm) < WGM ? (nM - fm) : WGM;
        const int pm = fm + ((wgid % nig) % gsz), pn = (wgid % nig) / gsz;
        u.a = A + (size_t)pm * tsA; u.b = Bt + (size_t)pn * tsB; u.orow = pm * BM; u.ocol = pn * BM; u.e = 0; u.s0 = 0; u.cnt = 0; return true;
    }
    __device__ __forceinline__ unsigned row_off(const Unit&, int) const { return 0u; }
};

template <class Epi, class Sched, bool ALIGN_EPI, bool GATHER>
__device__ __forceinline__ void gemm_phase(PG8_LAS unsigned char* lds, const int nt, const int lda, const int ldb, const Sched& S, const Epi& E) {
    const int tid = threadIdx.x, wid = __builtin_amdgcn_readfirstlane(tid >> 6), lane = tid & 63, wr = wid >> 2, wc = wid & 3, fr = lane & 15, fq = lane >> 4;
    unsigned voffA[2], voffB[2]; int rA[2]; unsigned cA2[2];
#pragma unroll
    for (int i = 0; i < 2; ++i) { int R, C; stage_rc(tid * 16 + i * 8192, R, C); const int Rb = Epi::PERM ? ((R & ~31) + perm32(R & 31)) : R;
        voffA[i] = (unsigned)(R * lda + C) * 2u; voffB[i] = (unsigned)(Rb * ldb + C) * 2u; rA[i] = R; cA2[i] = (unsigned)C * 2u; }
    const size_t kstep = (size_t)(BK * 2);
    const size_t hstepA = (size_t)HALF * lda * 2, hstepB = (size_t)HALF * ldb * 2;
    const unsigned ldsw = (unsigned)wid * 1024u;
    const int aoff = lds_byte(wr * 64 + fr, fq * 8), boff = lds_byte(wc * 32 + fr, fq * 8);
#define PG8_SA(b, h) (((b) * 2 + (h)) * HTB)
#define PG8_SB(b, h) ((4 + (b) * 2 + (h)) * HTB)
#define PG8_STAGE_O(bufoff, gbase, o0, o1) do { \
        __builtin_amdgcn_global_load_lds((const unsigned*)((const char*)(gbase) + (o0)), (PG8_LAS unsigned*)(lds + (bufoff) + ldsw), 16, 0, 0); \
        __builtin_amdgcn_global_load_lds((const unsigned*)((const char*)(gbase) + (o1)), (PG8_LAS unsigned*)(lds + (bufoff) + ldsw + 8192), 16, 0, 0); } while (0)
#define PG8_STB(b, h, bptr) PG8_STAGE_O(PG8_SB(b, h), (bptr) + (h) * hstepB, voffB[0], voffB[1])
#define PG8_STA(b, h, aptr, O) do { if constexpr (GATHER) { PG8_STAGE_O(PG8_SA(b, h), (aptr), O[h][0], O[h][1]); } else { PG8_STAGE_O(PG8_SA(b, h), (aptr) + (h) * hstepA, voffA[0], voffA[1]); } } while (0)
#define PG8_LDA(dst, b, h) do { _Pragma("unroll") for (int m = 0; m < 4; ++m) _Pragma("unroll") for (int k = 0; k < 2; ++k) dst[m][k] = *(const PG8_LAS bf16x8*)(lds + PG8_SA(b, h) + aoff + m * 2048 + k * 1024); } while (0)
#define PG8_LDB(dst, b, h) do { _Pragma("unroll") for (int n = 0; n < 2; ++n) _Pragma("unroll") for (int k = 0; k < 2; ++k) dst[n][k] = *(const PG8_LAS bf16x8*)(lds + PG8_SB(b, h) + boff + n * 2048 + k * 1024); } while (0)
#define PG8_MMA(ai, bj, At, Bt) do { __builtin_amdgcn_s_setprio(1); _Pragma("unroll") for (int m = 0; m < 4; ++m) _Pragma("unroll") for (int n = 0; n < 2; ++n) _Pragma("unroll") for (int k = 0; k < 2; ++k) \
        acc[ai][bj][m][n] = __builtin_amdgcn_mfma_f32_16x16x32_bf16(Bt[n][k], At[m][k], acc[ai][bj][m][n], 0, 0, 0); __builtin_amdgcn_s_setprio(0); } while (0)
#define PG8_WAIT_V(n) asm volatile("s_waitcnt vmcnt(" #n ")" ::: "memory")
#define PG8_WAIT_L(n) asm volatile("s_waitcnt lgkmcnt(" #n ")" ::: "memory")
#define PG8_BAR __builtin_amdgcn_s_barrier()
#define PG8_SCHED __builtin_amdgcn_sched_barrier(0)
#define PG8_FETCH(u, O) do { _Pragma("unroll") for (int h_ = 0; h_ < 2; ++h_) _Pragma("unroll") for (int i_ = 0; i_ < 2; ++i_) O[h_][i_] = S.row_off(u, h_ * HALF + rA[i_]) + cA2[i_]; } while (0)
    Unit cur, nxt; int ui = 0;
    if (!S.next(0, cur)) return;
    f32x4 acc[2][2][4][2];
#pragma unroll
    for (int a = 0; a < 2; ++a)
#pragma unroll
        for (int b = 0; b < 2; ++b)
#pragma unroll
            for (int m = 0; m < 4; ++m)
#pragma unroll
                for (int n = 0; n < 2; ++n) acc[a][b][m][n] = (f32x4){0.f, 0.f, 0.f, 0.f};
    bf16x8 At[4][2], B0[2][2], B1[2][2];
    unsigned oC[2][2] = {{0u, 0u}, {0u, 0u}}, oN[2][2] = {{0u, 0u}, {0u, 0u}}, o2[2][2] = {{0u, 0u}, {0u, 0u}};
    if constexpr (GATHER) { PG8_FETCH(cur, oC); }
    const char* cA = cur.a; const char* cB = cur.b;
    PG8_STB(0, 0, cB); PG8_STB(0, 1, cB); PG8_STA(0, 0, cA, oC); PG8_STA(0, 1, cA, oC);
    if (wr == 1) PG8_BAR;
    PG8_WAIT_V(2); PG8_BAR;
    PG8_STB(1, 0, cB + kstep); PG8_STA(1, 0, cA + kstep, oC); PG8_STB(1, 1, cB + kstep);
    PG8_WAIT_V(6); PG8_BAR;
    for (;;) {
        const bool has_next = S.next(ui + 1, nxt);
        const char* nA = has_next ? nxt.a : cA; const char* nB = has_next ? nxt.b : cB;
        if constexpr (GATHER) { if (has_next) { PG8_FETCH(nxt, oN); } else {
#pragma unroll
            for (int h_ = 0; h_ < 2; ++h_)
#pragma unroll
                for (int i_ = 0; i_ < 2; ++i_) oN[h_][i_] = oC[h_][i_]; } }
        for (int t = 0; t < nt; t += 2) {
            const bool last = (t == nt - 2);
            const char* a1 = cA + (size_t)(t + 1) * kstep;
            const char* a2 = last ? nA : cA + (size_t)(t + 2) * kstep; const char* b2 = last ? nB : cB + (size_t)(t + 2) * kstep;
            const char* a3 = a2 + kstep; const char* b3 = b2 + kstep;
            if constexpr (GATHER) {
#pragma unroll
                for (int h_ = 0; h_ < 2; ++h_)
#pragma unroll
                    for (int i_ = 0; i_ < 2; ++i_) o2[h_][i_] = last ? oN[h_][i_] : oC[h_][i_]; }
            PG8_LDB(B0, 0, 0); PG8_LDB(B1, 0, 1); PG8_SCHED; PG8_LDA(At, 0, 0); PG8_STA(1, 1, a1, oC);
            PG8_WAIT_V(8); PG8_WAIT_L(0); PG8_BAR; PG8_MMA(0, 0, At, B0); PG8_MMA(0, 1, At, B1); PG8_BAR; PG8_SCHED;
            PG8_LDA(At, 0, 1); PG8_STB(0, 0, b2); PG8_STB(0, 1, b2); PG8_STA(0, 0, a2, o2);
            PG8_WAIT_V(8); PG8_WAIT_L(0); PG8_BAR; PG8_MMA(1, 0, At, B0); PG8_MMA(1, 1, At, B1); PG8_BAR; PG8_SCHED;
            PG8_LDB(B0, 1, 0); PG8_LDB(B1, 1, 1); PG8_SCHED; PG8_LDA(At, 1, 0); PG8_STA(0, 1, a2, o2);
            PG8_WAIT_V(8); PG8_WAIT_L(0); PG8_BAR; PG8_MMA(0, 0, At, B0); PG8_MMA(0, 1, At, B1); PG8_BAR; PG8_SCHED;
            PG8_LDA(At, 1, 1); PG8_STB(1, 0, b3); PG8_STB(1, 1, b3); PG8_STA(1, 0, a3, o2);
            PG8_WAIT_V(8); PG8_WAIT_L(0); PG8_BAR; PG8_MMA(1, 0, At, B0); PG8_MMA(1, 1, At, B1); PG8_BAR; PG8_SCHED;
        }
        if constexpr (ALIGN_EPI) { if (wr == 0) PG8_BAR; }
        E(acc, cur, wr, wc, fr, fq);
        if (!has_next) break;
#pragma unroll
        for (int a = 0; a < 2; ++a)
#pragma unroll
            for (int b = 0; b < 2; ++b)
#pragma unroll
                for (int m = 0; m < 4; ++m)
#pragma unroll
                    for (int n = 0; n < 2; ++n) acc[a][b][m][n] = (f32x4){0.f, 0.f, 0.f, 0.f};
        cur = nxt; cA = nA; cB = nB; ++ui;
        if constexpr (GATHER) {
#pragma unroll
            for (int h_ = 0; h_ < 2; ++h_)
#pragma unroll
                for (int i_ = 0; i_ < 2; ++i_) oC[h_][i_] = oN[h_][i_]; }
        if constexpr (ALIGN_EPI) { if (wr == 1) PG8_BAR; }
    }
    PG8_WAIT_V(0);
    if constexpr (!ALIGN_EPI) { if (wr == 0) PG8_BAR; }
    PG8_BAR;
#undef PG8_SA
#undef PG8_SB
#undef PG8_STAGE_O
#undef PG8_STB
#undef PG8_STA
#undef PG8_LDA
#undef PG8_LDB
#undef PG8_MMA
#undef PG8_WAIT_V
#undef PG8_WAIT_L
#undef PG8_BAR
#undef PG8_SCHED
#undef PG8_FETCH
}

struct EpiStoreBf16 {
    static constexpr bool PERM = true;
    bf16_t* O; int ldc; int split_cols; size_t split_stride; float scale0;
    __device__ __forceinline__ void operator()(const f32x4 (&acc)[2][2][4][2], const Unit& u, int wr, int wc, int fr, int fq) const {
        const int row0 = u.orow + wr * 64 + fr; int colt = u.ocol; bf16_t* base = O;
        float sc = 1.f; if (split_cols) { const int t = colt / split_cols; base += (size_t)t * split_stride; colt -= t * split_cols; if (t == 0) sc = scale0; }
        const int col0 = colt + wc * 32 + 8 * fq;
#pragma unroll
        for (int ai = 0; ai < 2; ++ai)
#pragma unroll
            for (int m = 0; m < 4; ++m) { bf16_t* rowp = base + (size_t)(row0 + ai * HALF + m * 16) * ldc + col0;
#pragma unroll
                for (int bj = 0; bj < 2; ++bj) { const f32x4 v0 = acc[ai][bj][m][0] * sc, v1 = acc[ai][bj][m][1] * sc;
                    u32x4 w; w.x = cvt_pk_bf16(v0[0], v0[1]); w.y = cvt_pk_bf16(v0[2], v0[3]); w.z = cvt_pk_bf16(v1[0], v1[1]); w.w = cvt_pk_bf16(v1[2], v1[3]);
                    *(u32x4*)(rowp + bj * HALF) = w; } }
    }
};
struct EpiResid {
    static constexpr bool PERM = false;
    const float* x; float* out; bf16_t* hb;
    __device__ __forceinline__ void operator()(const f32x4 (&acc)[2][2][4][2], const Unit& u, int wr, int wc, int fr, int fq) const {
        const int row0 = u.orow + wr * 64 + fr, col0 = u.ocol + wc * 32 + 4 * fq;
#pragma unroll
        for (int ai = 0; ai < 2; ++ai)
#pragma unroll
            for (int m = 0; m < 4; ++m) { const size_t off = (size_t)(row0 + ai * HALF + m * 16) * D + col0;
#pragma unroll
                for (int bj = 0; bj < 2; ++bj)
#pragma unroll
                    for (int n = 0; n < 2; ++n) { const size_t o = off + bj * HALF + n * 16; const f32x4 xv = *(const f32x4*)(x + o); const f32x4 hv = xv + acc[ai][bj][m][n];
                        *(f32x4*)(out + o) = hv; v2u w; w.x = cvt_pk_bf16(hv[0], hv[1]); w.y = cvt_pk_bf16(hv[2], hv[3]); *(v2u*)(hb + o) = w; } }
    }
};
struct EpiGateUp {
    static constexpr bool PERM = true;
    bf16_t* hmid; const f32x2* sw;
    __device__ __forceinline__ void operator()(const f32x4 (&acc)[2][2][4][2], const Unit& u, int wr, int wc, int fr, int fq) const {
        const int col0 = u.ocol + wc * 32 + 8 * fq;
        const GAS f32x2* swg = (const GAS f32x2*)sw + (size_t)u.e * 8192 + u.s0 + wr * 64 + fr;
        f32x2 rws[2][4];
#pragma unroll
        for (int ai = 0; ai < 2; ++ai)
#pragma unroll
            for (int m = 0; m < 4; ++m) rws[ai][m] = swg[ai * HALF + m * 16];
#pragma unroll
        for (int ai = 0; ai < 2; ++ai)
#pragma unroll
            for (int m = 0; m < 4; ++m) { const int r = ai * HALF + wr * 64 + m * 16 + fr; const int slot = u.s0 + r; const bool valid = slot < u.cnt;
                const f32x2 rw = rws[ai][m];
                float hv[8];
#pragma unroll
                for (int n = 0; n < 2; ++n)
#pragma unroll
                    for (int j = 0; j < 4; ++j) { const float g = acc[ai][0][m][n][j] * rw.x, up = acc[ai][1][m][n][j] * rw.x;
                        const float e = __builtin_amdgcn_exp2f(-g * LOG2E); const float s = g * __builtin_amdgcn_rcpf(1.0f + e); hv[n * 4 + j] = valid ? s * up * rw.y : 0.f; }
                u32x4 w; w.x = cvt_pk_bf16(hv[0], hv[1]); w.y = cvt_pk_bf16(hv[2], hv[3]); w.z = cvt_pk_bf16(hv[4], hv[5]); w.w = cvt_pk_bf16(hv[6], hv[7]);
                *(GAS u32x4*)(hmid + (size_t)(u.orow + r) * FF + col0) = w; }
    }
};
struct EpiDown {
    static constexpr bool PERM = true;
    bf16_t* y; const unsigned* tok;
    __device__ __forceinline__ void operator()(const f32x4 (&acc)[2][2][4][2], const Unit& u, int wr, int wc, int fr, int fq) const {
        const int col0 = u.ocol + wc * 32 + 8 * fq;
        const GAS unsigned* tg = (const GAS unsigned*)tok + (size_t)u.e * 8192 + u.s0 + wr * 64 + fr;
        unsigned tis[2][4];
#pragma unroll
        for (int ai = 0; ai < 2; ++ai)
#pragma unroll
            for (int m = 0; m < 4; ++m) tis[ai][m] = tg[ai * HALF + m * 16];
#pragma unroll
        for (int ai = 0; ai < 2; ++ai)
#pragma unroll
            for (int m = 0; m < 4; ++m) { const int r = ai * HALF + wr * 64 + m * 16 + fr; const int slot = u.s0 + r;
                if (slot < u.cnt) { const unsigned ti = tis[ai][m]; const unsigned token = ti & 0xffffu, ks = ti >> 16;
                    bf16_t* rowp = y + ((size_t)ks * T + token) * D + col0;
#pragma unroll
                    for (int bj = 0; bj < 2; ++bj) { const f32x4 v0 = acc[ai][bj][m][0], v1 = acc[ai][bj][m][1];
                        u32x4 w; w.x = cvt_pk_bf16(v0[0], v0[1]); w.y = cvt_pk_bf16(v0[2], v0[3]); w.z = cvt_pk_bf16(v1[0], v1[1]); w.w = cvt_pk_bf16(v1[2], v1[3]);
                        *(GAS u32x4*)(rowp + bj * HALF) = w; } } }
    }
};
struct W2Order {
    int G, c; const char* A; const char* Bt;
    __device__ bool next(int i, Unit& u) const { const int L = i * G + c; if (L >= 32) return false; const int g = L & 3, dt = L >> 2;
        u.a = A + ((size_t)dt * 256 * D + 1024 + 256 * g) * 2; u.b = Bt + (size_t)g * 65536 * 2; u.orow = dt * 256; u.ocol = 1024 + 256 * g; u.e = 0; u.s0 = 0; u.cnt = 0; return true; }
    __device__ __forceinline__ unsigned row_off(const Unit&, int) const { return 0u; }
};
template <int NPN, bool UP> struct MoeOrder {
    int c0, ncu, c, t_lo, t_hi; const PG8_LAS int* tab; const char* A; const char* W; const unsigned* tok;
    __device__ bool next(int i, Unit& u) const {
        if (c < c0 || c >= c0 + ncu) return false;
        const int nt_all = __builtin_amdgcn_readfirstlane(tab[32]); const int hi_ = t_hi < nt_all ? t_hi : nt_all; const int total = (hi_ - t_lo) * NPN;
        const int L = i * ncu + (c - c0); if (L >= total) return false;
        const int Tt = t_lo + L / NPN, pn = L % NPN; int e = 0;
        for (int k = 1; k < 32; ++k) e = (tab[k] <= Tt) ? k : e;
        e = __builtin_amdgcn_readfirstlane(e);
        const int mt = Tt - __builtin_amdgcn_readfirstlane(tab[e]);
        u.e = e; u.s0 = mt * 256; u.cnt = __builtin_amdgcn_readfirstlane(tab[40 + e]); u.orow = Tt * 256;
        if (UP) { u.a = A; u.b = W + ((size_t)(e * 4 + pn) * 256) * D * 2; u.ocol = pn * 128; }
        else { u.a = A + (size_t)Tt * 256 * FF * 2; u.b = W + ((size_t)e * D + pn * 256) * FF * 2; u.ocol = pn * 256; }
        return true;
    }
    __device__ __forceinline__ unsigned row_off(const Unit& u, int R) const {
        const int slot = u.s0 + R; unsigned token = ((const GAS unsigned*)tok)[u.e * 8192 + slot] & 0xffffu; token = (slot < u.cnt) ? token : 0u; return token * (unsigned)(D * 2);
    }
};
}

namespace att {
constexpr int PITCH = 1024, QB = 128, KVB = 64;
constexpr int KBUF0 = 0, VBUF0 = 32768, XBUF0 = 65536;
__device__ __forceinline__ int crow(int r, int hi) { return (r & 3) + 8 * (r >> 2) + 4 * hi; }
__device__ __forceinline__ unsigned cvtpk(float lo, float hi) { unsigned r; asm volatile("v_cvt_pk_bf16_f32 %0, %1, %2" : "=v"(r) : "v"(lo), "v"(hi)); return r; }
typedef short v4i16_t __attribute__((ext_vector_type(4)));
__device__ __forceinline__ v2u vtr(const LAS char* p) { return __builtin_bit_cast(v2u, __builtin_amdgcn_ds_read_tr16_b64_v4i16((LAS v4i16_t*)p)); }
__device__ __forceinline__ float opq(float x) { asm("" : "+v"(x)); return x; }
__device__ __forceinline__ float hswap_max(float m) { auto rr = __builtin_amdgcn_permlane32_swap(__float_as_uint(m), __float_as_uint(m), false, false); return fmaxf(__uint_as_float(rr[0]), __uint_as_float(rr[1])); }
__device__ __forceinline__ float hswap_sum(float m) { auto rr = __builtin_amdgcn_permlane32_swap(__float_as_uint(m), __float_as_uint(m), false, false); return __uint_as_float(rr[0]) + __uint_as_float(rr[1]); }

__device__ __forceinline__ void attn_unit(int b, int h, int qb, const bf16* Q, const bf16* K, const bf16* V, bf16* A3, const float* subg, float lam, LAS unsigned char* lds, LAS float* wsf_all) {
    int lane_ = threadIdx.x & 63; asm volatile("" : "+v"(lane_));
    const int tid = threadIdx.x, lane = lane_, r32 = lane & 31, hi = lane >> 5; const int wid = __builtin_amdgcn_readfirstlane(tid >> 6);
    const int mp = wid >> 2, rg = wid & 3;
    const long rowbase = (long)b * SEQ; const int q0 = qb * QB, qmin = q0 + 32 * rg, qmax = qmin + 31;
    const float slope2 = exp2f(-(float)(h + 1)) * LOG2E;
    LAS float* wsf = wsf_all + wid * 64;
    const bf16* Kh = K + rowbase * PITCH + h * 128; const bf16* Vh = V + rowbase * PITCH + h * 128;
    const int NT = (q0 + QB) / KVB;
    const int drow = 4 * wid + (lane >> 4), dslot = lane & 15;
    const bf16* ksrc = Kh + (long)drow * PITCH + ((dslot ^ (drow & 15)) * 8);
    const bf16* vsrc = Vh + (long)drow * PITCH + (((dslot >> 2) ^ (drow & 3)) * 32) + (dslot & 3) * 8;
    const unsigned lds0 = (unsigned)(unsigned long)lds;
#define ATT_GLDS(gsrc, ldst) do { unsigned keep_; asm volatile("s_mov_b32 %0, m0\n\ts_mov_b32 m0, %2\n\ts_nop 0\n\tglobal_load_lds_dwordx4 %1, off\n\ts_mov_b32 m0, %0" : "=&s"(keep_) : "v"(gsrc), "s"(ldst) : "memory"); } while (0)
#define ATT_DMA_K(t) do { const long to_ = (long)(t) * KVB * PITCH; const unsigned bb_ = (unsigned)__builtin_amdgcn_readfirstlane((int)(lds0 + KBUF0 + (unsigned)((t) & 1) * 16384u)); \
        ATT_GLDS(ksrc + to_, bb_ + (unsigned)wid * 1024u); ATT_GLDS(ksrc + to_ + 32 * PITCH, bb_ + 8192u + (unsigned)wid * 1024u); } while (0)
#define ATT_DMA_V(t) do { const long to_ = (long)(t) * KVB * PITCH; const unsigned bb_ = (unsigned)__builtin_amdgcn_readfirstlane((int)(lds0 + VBUF0 + (unsigned)((t) & 1) * 16384u)); \
        ATT_GLDS(vsrc + to_, bb_ + (unsigned)wid * 1024u); ATT_GLDS(vsrc + to_ + 32 * PITCH, bb_ + 8192u + (unsigned)wid * 1024u); } while (0)
    ATT_DMA_K(0);
    bf16x8 qr[4];
    {
        const bf16* Qw = Q + (rowbase + qmin + r32) * PITCH + h * 128 + mp * 64 + hi * 8;
#pragma unroll
        for (int d0 = 0; d0 < 4; ++d0) qr[d0] = *(const bf16x8*)(Qw + d0 * 16);
        asm volatile("" :: "v"(qr[0]), "v"(qr[1]), "v"(qr[2]), "v"(qr[3]));
    }
    const float s32 = 32.f * slope2;
    const float lbase = slope2 * (float)(4 * hi - r32 - qmin);
#ifdef PROBE_TIME
    const unsigned long long pt0_ = __builtin_amdgcn_s_memrealtime();
#endif
    float mrow = -INFINITY, lsum = 0.f;
    f32x16 o[4];
#pragma unroll
    for (int d0 = 0; d0 < 4; ++d0)
#pragma unroll
        for (int r = 0; r < 16; ++r) o[d0][r] = 0.f;
    v4u pw[4] = {(v4u){0u, 0u, 0u, 0u}, (v4u){0u, 0u, 0u, 0u}, (v4u){0u, 0u, 0u, 0u}, (v4u){0u, 0u, 0u, 0u}};
    bool resc = false;
    const int vq = (lane & 15) >> 2;
    for (int s = 0; s <= NT; ++s) {
        VM_WAIT(); __syncthreads();
        if (s + 1 < NT) ATT_DMA_K(s + 1);
        if (s < NT) ATT_DMA_V(s);
        const bool do_s = s < NT && KVB * s <= qmax, do_pv = s >= 1 && KVB * (s - 1) <= qmax;
        f32x16 p0, p1;
        if (do_s) {
            const LAS unsigned char* kb = lds + KBUF0 + (s & 1) * 16384 + r32 * 256;
            bf16x8 kf[8];
#pragma unroll
            for (int d0 = 0; d0 < 4; ++d0) { const int so = ((mp * 8 + 2 * d0 + hi) ^ (r32 & 15)) * 16; kf[2 * d0] = *(const LAS bf16x8*)(kb + so); kf[2 * d0 + 1] = *(const LAS bf16x8*)(kb + so + 8192); }
#pragma unroll
            for (int r = 0; r < 16; ++r) { p0[r] = 0.f; p1[r] = 0.f; }
#pragma unroll
            for (int d0 = 0; d0 < 4; ++d0) {
                p0 = __builtin_amdgcn_mfma_f32_32x32x16_bf16(kf[2 * d0], qr[d0], p0, 0, 0, 0);
                p1 = __builtin_amdgcn_mfma_f32_32x32x16_bf16(kf[2 * d0 + 1], qr[d0], p1, 0, 0, 0);
            }
        }
        if (do_pv) {
            const int t = s - 1;
            if (resc) {
                float al[16];
#pragma unroll
                for (int r = 0; r < 16; ++r) al[r] = wsf[crow(r, hi)];
#pragma unroll
                for (int d0 = 0; d0 < 4; ++d0)
#pragma unroll
                    for (int r = 0; r < 16; ++r) o[d0][r] = opq(o[d0][r] * al[r]);
            }
            const LAS char* vb = (const LAS char*)(lds + VBUF0 + (t & 1) * 16384) + ((lane >> 4) & 1) * 32 + (lane & 3) * 8 + (4 * hi + vq) * 256;
#pragma unroll
            for (int d0 = 0; d0 < 4; ++d0) {
#pragma unroll
                for (int ks = 0; ks < 4; ++ks) { const v2u lo = vtr(vb + ((d0 ^ vq) * 64) + ks * 4096), hh = vtr(vb + ((d0 ^ vq) * 64) + ks * 4096 + 2048);
                    const v4u vf = (v4u){lo.x, lo.y, hh.x, hh.y};
                    o[d0] = __builtin_amdgcn_mfma_f32_32x32x16_bf16(__builtin_bit_cast(bf16x8, pw[ks]), __builtin_bit_cast(bf16x8, vf), o[d0], 0, 0, 0); }
            }
        }
        if (do_s) {
            const float lb = lbase + slope2 * (float)(KVB * s);
#pragma unroll
            for (int r = 0; r < 16; ++r) { const float cr = (float)((r & 3) + 8 * (r >> 2)); p0[r] = opq(fmaf(slope2, cr, p0[r])); p1[r] = opq(fmaf(slope2, cr, p1[r])); }
            if (KVB * s + 63 > qmin) {
                const int dq = qmin + r32 - KVB * s - 4 * hi;
#pragma unroll
                for (int r = 0; r < 16; ++r) { const int kk = (r & 3) + 8 * (r >> 2); if (kk > dq) p0[r] = -INFINITY; if (kk + 32 > dq) p1[r] = -INFINITY; }
            }
            float m0 = p0[0], m1 = p1[0];
#pragma unroll
            for (int r = 1; r < 16; ++r) { m0 = fmaxf(m0, p0[r]); m1 = fmaxf(m1, p1[r]); }
            float rmt = fmaxf(m0, m1 + s32) + lb; rmt = hswap_max(rmt);
            const float mnew = fmaxf(mrow, rmt);
            const float alpha = __builtin_amdgcn_exp2f(mrow - mnew);
            mrow = mnew;
            const float e0 = mnew - lb, e1 = e0 - s32;
            float sacc = 0.f;
#pragma unroll
            for (int r = 0; r < 16; ++r) { p0[r] = __builtin_amdgcn_exp2f(opq(p0[r] - e0)); p1[r] = __builtin_amdgcn_exp2f(opq(p1[r] - e1)); sacc = opq(sacc + p0[r]); sacc = opq(sacc + p1[r]); }
            lsum = lsum * alpha + sacc;
            pw[0] = (v4u){cvtpk(p0[0], p0[1]), cvtpk(p0[2], p0[3]), cvtpk(p0[4], p0[5]), cvtpk(p0[6], p0[7])};
            pw[1] = (v4u){cvtpk(p0[8], p0[9]), cvtpk(p0[10], p0[11]), cvtpk(p0[12], p0[13]), cvtpk(p0[14], p0[15])};
            pw[2] = (v4u){cvtpk(p1[0], p1[1]), cvtpk(p1[2], p1[3]), cvtpk(p1[4], p1[5]), cvtpk(p1[6], p1[7])};
            pw[3] = (v4u){cvtpk(p1[8], p1[9]), cvtpk(p1[10], p1[11]), cvtpk(p1[12], p1[13]), cvtpk(p1[14], p1[15])};
            resc = !__all(alpha == 1.0f);
            if (resc && hi == 0) wsf[r32] = alpha;
        }
    }
#undef ATT_DMA_K
#undef ATT_DMA_V
#undef ATT_GLDS
#ifdef PROBE_TIME
    if (threadIdx.x == 0) { volatile LAS unsigned* pa_ = (volatile LAS unsigned*)(lds + MISC_OFF + 64); pa_[0] += (unsigned)(__builtin_amdgcn_s_memrealtime() - pt0_); pa_[1] += (unsigned)(NT + 1); }
#endif
    lsum = hswap_sum(lsum);
    if (hi == 0) wsf[r32] = __builtin_amdgcn_rcpf(lsum);
    LDS_WAIT();
    {
        float rl[16];
#pragma unroll
        for (int r = 0; r < 16; ++r) rl[r] = wsf[crow(r, hi)];
#pragma unroll
        for (int d0 = 0; d0 < 4; ++d0)
#pragma unroll
            for (int r = 0; r < 16; ++r) o[d0][r] *= rl[r];
    }
    LAS float* X = (LAS float*)(lds + XBUF0) + rg * 4096;
    if (mp == 1) {
#pragma unroll
        for (int d0 = 0; d0 < 4; ++d0)
#pragma unroll
            for (int r = 0; r < 16; ++r) X[(d0 * 16 + r) * 64 + lane] = o[d0][r];
    }
    __syncthreads();
    if (mp == 0) {
        float ss[16];
#pragma unroll
        for (int r = 0; r < 16; ++r) ss[r] = 0.f;
#pragma unroll
        for (int d0 = 0; d0 < 4; ++d0)
#pragma unroll
            for (int r = 0; r < 16; ++r) { const float dv = o[d0][r] - lam * X[(d0 * 16 + r) * 64 + lane]; o[d0][r] = dv; ss[r] += dv * dv; }
#pragma unroll
        for (int r = 0; r < 16; ++r) {
#pragma unroll
            for (int off = 1; off < 32; off <<= 1) ss[r] += __shfl_xor(ss[r], off);
            ss[r] = rsqrtf(ss[r] * (1.0f / 128.0f) + RMS_EPS) * 0.8f;
        }
        LAS bf16* stg = (LAS bf16*)(lds + KBUF0 + rg * 8192);
#pragma unroll
        for (int d0 = 0; d0 < 4; ++d0) { const float gg = subg[d0 * 32 + r32];
#pragma unroll
            for (int r = 0; r < 16; ++r) { const float v = o[d0][r] * ss[r] * gg; const unsigned pk = cvtpk(v, v); stg[crow(r, hi) * 128 + d0 * 32 + r32] = (bf16)(pk & 0xffffu); } }
        LDS_WAIT(); asm volatile("" ::: "memory");
        bf16* Ow = A3 + (rowbase + qmin) * D + h * 128;
#pragma unroll
        for (int i = 0; i < 8; ++i) { const int row = i * 4 + (lane >> 4), ch = lane & 15; const v4u v = *(const LAS v4u*)(stg + row * 128 + ch * 8); *(GAS v4u*)(Ow + (long)row * D + ch * 8) = v; }
    }
    __syncthreads();
}
}

#define XB_TMO      128
#define XB_XCNT(j)  (256  + 64 * (j))
#define XB_XSUB(j)  (1280 + 64 * (j))
#define XB_XGEN(j)  (2304 + 64 * (j))
#define XB_TOP      3328
#define XB_TOPGEN   3392
#define XCD_BAR_WORDS 3456
#define XB_SPIN_CAP (1u << 18)

__device__ __forceinline__ unsigned xb_ld(unsigned* p)              { return __hip_atomic_load(p, __ATOMIC_RELAXED, __HIP_MEMORY_SCOPE_AGENT); }
__device__ __forceinline__ unsigned xb_add(unsigned* p, unsigned v) { return __hip_atomic_fetch_add(p, v, __ATOMIC_RELAXED, __HIP_MEMORY_SCOPE_AGENT); }
__device__ __forceinline__ unsigned xb_xcc_id() { return (unsigned)__builtin_amdgcn_s_getreg((3 << 11) | 20) & 0xFu; }
#define XB_SPIN(cond, bar) do { unsigned _sp = 0; while (cond) { __builtin_amdgcn_s_sleep(1); \
    if ((++_sp & 255u) == 0u) { if (xb_ld(&(bar)[XB_TMO])) break; if (_sp > XB_SPIN_CAP) { atomicAdd(&(bar)[XB_TMO], 1u); break; } } } } while (0)

struct XcdBarrier { unsigned* bar; unsigned x; volatile LAS unsigned* st; };

__device__ __forceinline__ XcdBarrier xcd_barrier_post(unsigned* bar, volatile LAS unsigned* st) {
    XcdBarrier b; b.bar = bar; b.x = xb_xcc_id(); b.st = st;
    if (threadIdx.x == 0) (void)xb_add(&bar[XB_XCNT(b.x)], 1u);
    return b;
}
__device__ __forceinline__ void xcd_barrier_complete(unsigned* bar, unsigned x, unsigned& nloc, unsigned& nx) {
    const unsigned G = gridDim.x * gridDim.y * gridDim.z;
    unsigned sum, cnt, mine, sp = 0u;
    for (;;) {
        sum = 0u; cnt = 0u; mine = 0u;
#pragma unroll
        for (unsigned j = 0; j < 16; ++j) { const unsigned c = xb_ld(&bar[XB_XCNT(j)]); sum += c; cnt += (c > 0u) ? 1u : 0u; mine = (j == x) ? c : mine; }
        if (sum == G) break;
        __builtin_amdgcn_s_sleep(1);
        if ((++sp & 255u) == 0u) { if (xb_ld(&bar[XB_TMO])) break; if (sp > XB_SPIN_CAP) { atomicAdd(&bar[XB_TMO], 1u); break; } }
    }
    nloc = mine > 0u ? mine : 1u; nx = cnt > 0u ? cnt : 1u;
}
__device__ __forceinline__ void xcd_barrier(const XcdBarrier& b) {
    asm volatile("s_waitcnt vmcnt(0)" ::: "memory");
    __syncthreads();
    if (threadIdx.x == 0) {
        unsigned* bar = b.bar;
        __builtin_amdgcn_s_waitcnt(0);
        unsigned nloc = b.st[0], nx = b.st[1];
        if (nloc == 0u) { xcd_barrier_complete(bar, b.x, nloc, nx); b.st[0] = nloc; b.st[1] = nx; }
        const unsigned old = xb_add(&bar[XB_XSUB(b.x)], 1u);
        const unsigned gen = old / nloc;
        if (old + 1u == (gen + 1u) * nloc) {
            __builtin_amdgcn_fence(__ATOMIC_RELEASE, "agent");
            asm volatile("s_waitcnt vmcnt(0)" ::: "memory");
            const unsigned og = xb_add(&bar[XB_TOP], 1u);
            const unsigned tg = og / nx;
            if (og + 1u == (tg + 1u) * nx) xb_add(&bar[XB_TOPGEN], 1u);
            else XB_SPIN(xb_ld(&bar[XB_TOPGEN]) == tg, bar);
            __builtin_amdgcn_fence(__ATOMIC_ACQUIRE, "agent");
            xb_add(&bar[XB_XGEN(b.x)], 1u);
            asm volatile("s_waitcnt vmcnt(0)" ::: "memory");
        } else {
            XB_SPIN(xb_ld(&bar[XB_XGEN(b.x)]) == gen, bar);
            __builtin_amdgcn_fence(__ATOMIC_ACQUIRE, "agent");
            asm volatile("s_waitcnt vmcnt(0)" ::: "memory");
        }
    }
    __syncthreads();
}

__device__ __forceinline__ unsigned f2bf(float f) { unsigned u = __builtin_bit_cast(unsigned, f); return (u + 0x7fffu + ((u >> 16) & 1u)) >> 16; }
__device__ __forceinline__ unsigned pk2(float lo, float hi) { unsigned r; asm volatile("v_cvt_pk_bf16_f32 %0, %1, %2" : "=v"(r) : "v"(lo), "v"(hi)); return r; }
__device__ __forceinline__ float bf2f(unsigned short v) { return __uint_as_float(((unsigned)v) << 16); }
__device__ __forceinline__ float wave_sum(float v) {
#pragma unroll
    for (int o = 1; o < 64; o <<= 1) v += __shfl_xor(v, o);
    return v;
}
struct TrItem { const GAS float* src; int N; GAS bf16* dst; int ldt; const GAS float* ks; };
__device__ __forceinline__ void tr_load(const TrItem& it, f32x4 (&v)[16], f32x2 (&sc)[8], int lane) {
    const int kq = lane >> 4, nq = lane & 15;
    const GAS float* sp = it.src + (size_t)(2 * kq) * it.N + 4 * nq;
#pragma unroll
    for (int i = 0; i < 8; ++i) { v[2 * i] = *(const GAS f32x4*)(sp + (size_t)(8 * i) * it.N); v[2 * i + 1] = *(const GAS f32x4*)(sp + (size_t)(8 * i + 1) * it.N); }
    if (it.ks) {
#pragma unroll
        for (int i = 0; i < 8; ++i) sc[i] = *(const GAS f32x2*)(it.ks + 8 * i + 2 * kq);
    } else {
#pragma unroll
        for (int i = 0; i < 8; ++i) sc[i] = (f32x2){1.f, 1.f};
    }
}
__device__ __forceinline__ void tr_finish(const TrItem& it, f32x4 (&v)[16], f32x2 (&sc)[8], LAS unsigned* scr, int lane) {
    const int kq = lane >> 4, nq = lane & 15;
#pragma unroll
    for (int i = 0; i < 8; ++i)
#pragma unroll
        for (int j = 0; j < 4; ++j) scr[(4 * nq + j) * 33 + 4 * i + kq] = pk2(v[2 * i][j] * sc[i].x, v[2 * i + 1][j] * sc[i].y);
    LDS_WAIT(); asm volatile("" ::: "memory");
    const int c = lane & 7;
#pragma unroll
    for (int jj = 0; jj < 8; ++jj) { const int n = (lane >> 3) + 8 * jj; const LAS unsigned* s = scr + n * 33 + 4 * c;
        v4u o; o.x = s[0]; o.y = s[1]; o.z = s[2]; o.w = s[3];
        *(GAS v4u*)(it.dst + (size_t)n * it.ldt + 8 * c) = o; }
    LDS_WAIT(); asm volatile("" ::: "memory");
}
__device__ __forceinline__ void p0_transpose_item(const float* src, int N, bf16* dst, int ldt, const float* ks, LAS unsigned* scr, int lane) {
    asm volatile("" : "+v"(lane));
    const TrItem it{(const GAS float*)src, N, (GAS bf16*)dst, ldt, (const GAS float*)ks}; f32x4 v[16]; f32x2 sc[8]; tr_load(it, v, sc, lane); tr_finish(it, v, sc, scr, lane);
}

template <int IDX> __device__ __forceinline__ const float* ldarg_ptr() {
    auto ka = __builtin_amdgcn_kernarg_segment_ptr();
    unsigned long long v; asm volatile("s_load_dwordx2 %0, %1, %2\n\ts_waitcnt lgkmcnt(0)" : "=s"(v) : "s"(ka), "i"(IDX * 8) : "memory"); return (const float*)v;
}
struct Args { const float* in[20]; float* out; unsigned char* ws; int ph_lo, ph_hi, li, pad; };
constexpr int NPH = 9;

__global__ void __launch_bounds__(512, 2) hymba_fwd(Args args) {
    extern __shared__ __attribute__((aligned(16))) unsigned char lds_raw[];
    LAS unsigned char* lds = (LAS unsigned char*)lds_raw;
    const int tid = threadIdx.x, lane = tid & 63, wave = __builtin_amdgcn_readfirstlane(tid >> 6);
    const int G = gridDim.x; const int bx = blockIdx.x; const int vcu = (G % 8 == 0) ? (bx % 8) * (G / 8) + bx / 8 : bx;
    gu32* ctl = (gu32*)(args.ws + WS_CTL);
#define LDARG(i) ldarg_ptr<i>()
#define WSPTR(name, off) bf16* name = (bf16*)(ws + (off))
#define PHASE_WS() unsigned char* ws = args.ws; asm volatile("" : "+s"(ws)); float* out = args.out; asm volatile("" : "+s"(out)); (void)out
    volatile LAS unsigned* MISC = (volatile LAS unsigned*)(lds + MISC_OFF);
    if (tid < 4) MISC[tid] = 0u;
    __syncthreads();
    const int lo = args.ph_lo, hi_ph = args.ph_hi;
    const bool use_bar = (hi_ph - lo) > 1;
    XcdBarrier bar; bar.bar = (unsigned*)(ctl + CW_BAR); bar.x = 0; bar.st = nullptr;
    if (use_bar) bar = xcd_barrier_post((unsigned*)(ctl + CW_BAR), MISC);
#ifndef PHASE_MASK
#define PHASE_MASK 0x1FF
#endif
#define IN(k) (((PHASE_MASK >> (k)) & 1) && lo <= (k) && (k) < hi_ph)
#define BOTH(k) (IN(k) && IN((k) + 1))
#define GRID_BAR() do { xcd_barrier(bar); } while (0)
    const int gw = vcu * 8 + wave, NGW = G * 8;

    if (IN(0)) {
        PHASE_WS(); WSPTR(wfrag, WS_WFRAG); WSPTR(bt2, WS_BT2); WSPTR(win_t, WS_WIN); WSPTR(wout_t, WS_WOUT); WSPTR(wout_t2, WS_WOUT2); WSPTR(XN, WS_XN);
        const float* x = LDARG(0); const float* norm1_g = LDARG(1); const float* w_in = LDARG(2); const float* pool_w = LDARG(8); const float* pool_scale = LDARG(9); const float* w_out = LDARG(10);
        const float* norm2_g = LDARG(11); const float* w_coarse = LDARG(12); const float* w_fine = LDARG(14);
        LAS unsigned* scr = (LAS unsigned*)(lds + wave * 16384);
        constexpr int I_IN = 32 * 64, I_OUT = 32 * 32, I_OUT2 = 16 * 32;
        constexpr int NITEMS = I_IN + I_OUT + I_OUT2;
        for (int it = gw; it < NITEMS; it += NGW) {
            int r = it;
            if (r < I_IN) { const int kb = r / 64, nb = r % 64, k0 = 64 * kb, n0 = 64 * nb; p0_transpose_item(w_in + (size_t)k0 * INW + n0, INW, win_t + (size_t)n0 * D + k0, D, nullptr, scr, lane); continue; } r -= I_IN;
            if (r < I_OUT) { const int kb = r / 32, nb = r % 32, k0 = 64 * kb, n0 = 64 * nb; p0_transpose_item(w_out + (size_t)k0 * D + n0, D, wout_t + (size_t)n0 * D + k0, D, nullptr, scr, lane); continue; } r -= I_OUT;
            { const int kb = r / 32, nb = r % 32, k0 = 64 * kb, n0 = 64 * nb; p0_transpose_item(w_out + (size_t)k0 * D + n0, D, wout_t2 + (size_t)n0 * D + k0, D, nullptr, scr, lane); }
        }
        for (int i = blockIdx.x * 512 + tid; i < 4 * 256 * 256 / 4; i += G * 512) { const int e4 = (i & 63) * 4, gc = i >> 6, g = gc >> 8;
            const f32x4 w = *(const f32x4*)(pool_w + (size_t)gc * 256 + e4); const f32x4 s = *(const f32x4*)(pool_scale + g * 256 + e4);
            v2u o; o.x = pk2(w[0] * s[0], w[1] * s[1]); o.y = pk2(w[2] * s[2], w[3] * s[3]); *(v2u*)(bt2 + (size_t)gc * 256 + e4) = o; }
        for (int i = blockIdx.x * 512 + tid; i < 128 * 2 * 64; i += G * 512) { const int ln = i & 63, nt_ = (i >> 6) & 1, gs = i >> 7; const int n = ln & 31;
            unsigned hw[4], lw[4];
#pragma unroll
            for (int jp = 0; jp < 4; ++jp) { float v[2];
#pragma unroll
                for (int q = 0; q < 2; ++q) { const int k = 16 * gs + 8 * (ln >> 5) + 2 * jp + q; float w = 0.f;
                    if (nt_ == 0) w = w_fine[((size_t)(n >> 3) * D + k) * 8 + (n & 7)]; else if (n < 4) w = w_coarse[(size_t)k * 4 + n];
                    v[q] = w * norm2_g[k]; }
                const unsigned h0 = f2bf(v[0]), h1 = f2bf(v[1]); hw[jp] = h0 | (h1 << 16);
                lw[jp] = f2bf(v[0] - __uint_as_float(h0 << 16)) | (f2bf(v[1] - __uint_as_float(h1 << 16)) << 16); }
            *(v4u*)(wfrag + ((size_t)((gs * 2 + nt_) * 2 + 0) * 64 + ln) * 8) = (v4u){hw[0], hw[1], hw[2], hw[3]};
            *(v4u*)(wfrag + ((size_t)((gs * 2 + nt_) * 2 + 1) * 64 + ln) * 8) = (v4u){lw[0], lw[1], lw[2], lw[3]}; }
        for (int m = gw; m < T; m += NGW) {
            const f32x4* xr = (const f32x4*)(x + (size_t)m * D) + 2 * lane; f32x4 v[8]; float s = 0.f;
#pragma unroll
            for (int j = 0; j < 4; ++j) { v[2 * j] = xr[128 * j]; v[2 * j + 1] = xr[128 * j + 1]; }
#pragma unroll
            for (int j = 0; j < 8; ++j) s += (v[j].x * v[j].x + v[j].y * v[j].y) + (v[j].z * v[j].z + v[j].w * v[j].w);
            const float rstd = rsqrtf(wave_sum(s) * (1.f / D) + RMS_EPS);
            v4u* o16 = (v4u*)(XN + (size_t)m * D) + lane;
#pragma unroll
            for (int j = 0; j < 4; ++j) { const f32x4 g0 = ((const f32x4*)norm1_g)[2 * lane + 128 * j], g1 = ((const f32x4*)norm1_g)[2 * lane + 128 * j + 1]; const f32x4 a = v[2 * j] * rstd * g0, c = v[2 * j + 1] * rstd * g1;
                o16[64 * j] = (v4u){pk2(a.x, a.y), pk2(a.z, a.w), pk2(c.x, c.y), pk2(c.z, c.w)}; }
        }
        if (BOTH(0)) GRID_BAR();
    }

    if (IN(1)) {
        PHASE_WS(); WSPTR(win_t, WS_WIN); WSPTR(XN, WS_XN); WSPTR(Qb, WS_Q);
        { pg8::DenseOrder S; S.init(T, INW, G, bx, XN, win_t, D, D);
          pg8::EpiStoreBf16 E{Qb, AW, AW, (size_t)T * AW, C2};
          pg8::gemm_phase<pg8::EpiStoreBf16, pg8::DenseOrder, true, false>(lds, D / 64, D, D, S, E); }
        if (BOTH(1)) GRID_BAR();
    }

    if (IN(2)) {
        PHASE_WS(); WSPTR(Qb, WS_Q); WSPTR(Kb, WS_K); WSPTR(Vb, WS_V); WSPTR(Ub, WS_U); WSPTR(A3, WS_A3);
        for (int tb = vcu; tb < T / 32; tb += G) {
            const int gi = wave & 3, chg = lane & 31;
#pragma unroll 1
            for (int k = 0; k < 8; ++k) {
                const int t = tb * 32 + (wave >> 2) * 16 + 2 * k + (lane >> 5), pos = t & (SEQ - 1);
                const bf16* up = Ub + (size_t)t * AW + gi * 256 + chg * 8;
                float a[8];
#pragma unroll
                for (int j = 0; j < 8; ++j) a[j] = 0.f;
                v4u self;
#define POOL_W(W) do { v4u v_[W]; _Pragma("unroll") for (int i = 0; i < W; ++i) { const int back = (i <= pos) ? i : pos; v_[i] = *(const v4u*)(up - (size_t)back * AW); } self = v_[0]; \
                    _Pragma("unroll") for (int i = 0; i < W; ++i) { const float wgt = (i <= pos) ? 1.f : 0.f; _Pragma("unroll") for (int j = 0; j < 4; ++j) { a[2 * j] += wgt * __uint_as_float(v_[i][j] << 16); a[2 * j + 1] += wgt * __uint_as_float(v_[i][j] & 0xffff0000u); } } } while (0)
                if (gi == 0) POOL_W(2); else if (gi == 1) POOL_W(4); else if (gi == 2) POOL_W(8); else POOL_W(16);
#undef POOL_W
                const int w = 2 << gi; const int cw = (pos + 1 < w) ? pos + 1 : w;
                const float inv = 1.0f / (float)cw; v4u o;
#pragma unroll
                for (int j = 0; j < 4; ++j) { const float s0 = __uint_as_float(self[j] << 16), s1 = __uint_as_float(self[j] & 0xffff0000u); o[j] = pk2(a[2 * j] * inv - s0, a[2 * j + 1] * inv - s1); }
                *(v4u*)(A3 + (size_t)t * D + AW + gi * 256 + chg * 8) = o; }
        }
        { WSPTR(bt2, WS_BT2); WSPTR(wout_t, WS_WOUT); WSPTR(wout_t2, WS_WOUT2);
          pg8::W2Order S{G, bx, (const char*)wout_t, (const char*)bt2};
          pg8::EpiStoreBf16 E{wout_t2, D, 0, 0, 1.f};
          int nt_w2 = 256 / 64; asm volatile("" : "+s"(nt_w2));
          pg8::gemm_phase<pg8::EpiStoreBf16, pg8::W2Order, true, false>(lds, nt_w2, D, 256, S, E);
          __syncthreads(); }
        const float* lq1 = LDARG(3); const float* lk1 = LDARG(4); const float* lq2 = LDARG(5); const float* lk2 = LDARG(6); const float* subln_g = LDARG(7);
        float lam;
        { const float p1 = wave_sum(lq1[lane] * lk1[lane]), p2 = wave_sum(lq2[lane] * lk2[lane]); lam = expf(p1) - expf(p2) + 0.2f; }
        LAS float* wsf = (LAS float*)(lds + WSF_OFF);
        {
            volatile LAS int* qslot = (volatile LAS int*)(lds + MISC_OFF + 32);
            LAS unsigned* scr = (LAS unsigned*)(lds + wave * 16384);
            const bool prefer_cvt = (vcu & 15) < 7;
#ifdef PROBE_TIME
            if (tid == 0) { volatile LAS unsigned* pa_ = (volatile LAS unsigned*)(lds + MISC_OFF + 64); pa_[0] = 0u; pa_[1] = 0u; pa_[2] = 0u; pa_[3] = 0u; }
            __syncthreads();
            const unsigned long long pq0_ = __builtin_amdgcn_s_memrealtime();
#endif
            bool att_left = true, cvt_left = true;
            constexpr int CVT_CH = 32, NCH = 24576 / CVT_CH, I_GU = 2 * 32 * 8 * 32;
            const int xq = (int)(xb_xcc_id() & 7u); int qoff = 0;
            for (;;) {
                int kind = -1, idx = 0, aq = 0;
#pragma unroll 1
                for (int pass = 0; pass < 2 && kind < 0; ++pass) {
                    const bool try_cvt = (pass == 0) ? prefer_cvt : !prefer_cvt;
                    if (try_cvt) {
                        if (cvt_left) {
                            if (tid == 0) qslot[0] = (int)__hip_atomic_fetch_add((unsigned*)(ctl + CW_QCVT), 1u, RLX_AGENT);
                            __syncthreads(); idx = qslot[0]; __syncthreads();
                            if (idx < NCH) kind = 1; else cvt_left = false;
                        }
                    } else {
                        while (att_left && kind < 0) {
                            aq = (xq + qoff) & 7;
                            if (tid == 0) qslot[0] = (int)__hip_atomic_fetch_add((unsigned*)(ctl + CW_QATT + 64 * aq), 1u, RLX_AGENT);
                            __syncthreads(); idx = qslot[0]; __syncthreads();
                            if (idx < 64) kind = 0; else { ++qoff; if (qoff == 8) att_left = false; }
                        }
                    }
                }
                if (kind < 0) break;
                if (kind == 1) {
                    const float* norm2_g = LDARG(11); const float* w_gate = LDARG(16); const float* w_up = LDARG(17); const float* w_down = LDARG(18);
                    unsigned char* ws2 = args.ws; asm volatile("" : "+s"(ws2)); bf16* wgu_t = (bf16*)(ws2 + WS_WGU); bf16* wd_t = (bf16*)(ws2 + WS_WD);
                    int lane2 = lane; asm volatile("" : "+v"(lane2));
#define CVT_ITEM(IT, rr) do { int r = (rr); if (r < I_GU) { const bool up = r >= I_GU / 2; if (up) r -= I_GU / 2; const int e = r / 256, q = r % 256, kb = q / 8, nb = q % 8, k0 = 64 * kb, n0 = 64 * nb; \
                            const float* W = (up ? w_up : w_gate) + (size_t)e * D * FF; const int drow = (n0 >> 7) * 256 + (up ? 128 : 0) + (n0 & 127); \
                            IT = TrItem{(const GAS float*)(W + (size_t)k0 * FF + n0), FF, (GAS bf16*)(wgu_t + ((size_t)e * 1024 + drow) * D + k0), D, (const GAS float*)(norm2_g + k0)}; } \
                        else { r -= I_GU; const int e = r / 256, q = r % 256, kb = q / 32, nb = q % 32, k0 = 64 * kb, n0 = 64 * nb; \
                            IT = TrItem{(const GAS float*)(w_down + (size_t)e * FF * D + (size_t)k0 * D + n0), D, (GAS bf16*)(wd_t + ((size_t)e * D + n0) * FF + k0), FF, (const GAS float*)nullptr}; } } while (0)
                    const int r0 = idx * CVT_CH + wave * (CVT_CH / 8);
                    TrItem ia, ib; f32x4 va[16], vb2[16]; f32x2 sa[8], sb[8];
                    CVT_ITEM(ia, r0); tr_load(ia, va, sa, lane2);
#pragma unroll 1
                    for (int i = 0; i < CVT_CH / 8; i += 2) {
                        CVT_ITEM(ib, r0 + i + 1); tr_load(ib, vb2, sb, lane2);
                        tr_finish(ia, va, sa, scr, lane2);
                        if (i + 2 < CVT_CH / 8) { CVT_ITEM(ia, r0 + i + 2); tr_load(ia, va, sa, lane2); }
                        tr_finish(ib, vb2, sb, scr, lane2);
                    }
#undef CVT_ITEM
                } else {
                    const int qb = 15 - (idx & 15), bh = aq + 8 * (idx >> 4);
#ifdef PROBE_TIME
                    const unsigned long long pu0_ = __builtin_amdgcn_s_memrealtime();
#endif
                    att::attn_unit(bh >> 3, bh & 7, qb, Qb, Kb, Vb, A3, subln_g, lam, lds, wsf);
#ifdef PROBE_TIME
                    if (tid == 0) { volatile LAS unsigned* pa_ = (volatile LAS unsigned*)(lds + MISC_OFF + 64); pa_[2] += (unsigned)(__builtin_amdgcn_s_memrealtime() - pu0_); pa_[3] += 1u; }
#endif
                }
            }
#ifdef PROBE_TIME
            __syncthreads();
            if (bx == 16) { volatile LAS unsigned* pa_ = (volatile LAS unsigned*)(lds + MISC_OFF + 64);
                const unsigned long long now_ = __builtin_amdgcn_s_memrealtime();
                unsigned long long q_ = (PROBE_TIME == 1) ? pa_[0] : (PROBE_TIME == 2) ? pa_[2] : (PROBE_TIME == 3) ? (unsigned)(now_ - pq0_) : (PROBE_TIME == 4) ? pa_[1] * 100ull : pa_[3] * 1000ull;
                const unsigned long long until_ = now_ + 3ull * q_;
                while (__builtin_amdgcn_s_memrealtime() < until_) __builtin_amdgcn_s_sleep(8); }
#endif
        }
        if (BOTH(2)) GRID_BAR();
    }

    if (IN(3)) {
        PHASE_WS(); WSPTR(wout_t2, WS_WOUT2); WSPTR(A3, WS_A3); WSPTR(rb, WS_RB);
        pg8::DenseOrder S; S.init(T, D, G, bx, A3, wout_t2, D, D);
        pg8::EpiStoreBf16 E{rb, D, 0, 0, 1.f};
        pg8::gemm_phase<pg8::EpiStoreBf16, pg8::DenseOrder, true, false>(lds, D / 64, D, D, S, E);
        if (BOTH(3)) GRID_BAR();
    }

    if (IN(4)) {
        PHASE_WS(); WSPTR(wfrag, WS_WFRAG); WSPTR(rb, WS_RB); WSPTR(hb, WS_HB); unsigned* tokl = (unsigned*)(ws + WS_TOK); f32x2* swl = (f32x2*)(ws + WS_SW);
        const float* x = LDARG(0); const float* norm2_g = LDARG(11); const float* b_coarse = LDARG(13); const float* b_fine = LDARG(15);
        LAS float* part = (LAS float*)lds;
        LAS float* ssqs = (LAS float*)(lds + 73728);
        LAS float* logit = (LAS float*)(lds + 73728 + 1024);
        const int r32 = lane & 31, hi = lane >> 5, rsub = lane >> 4, cg = lane & 15;
        LAS unsigned char* stg = lds + wave * 9216;
        const __amdgpu_buffer_rsrc_t rsx = __builtin_amdgcn_make_buffer_rsrc((void*)x, 0, T * D * 4, 0x00020000);
        const __amdgpu_buffer_rsrc_t rsr = __builtin_amdgcn_make_buffer_rsrc((void*)rb, 0, T * D * 2, 0x00020000);
        const __amdgpu_buffer_rsrc_t rsh = __builtin_amdgcn_make_buffer_rsrc((void*)hb, 0, T * D * 2, 0x00020000);
        for (int rblk = vcu; rblk < T / 32; rblk += G) {
            const int R0 = rblk * 32;
            const unsigned vo4 = (unsigned)(rsub * D + 4 * cg) * 4u, vo2 = (unsigned)(rsub * D + 4 * cg) * 2u; const unsigned so0 = (unsigned)(R0 * D + wave * 256);
            f32x16 acc0, acc1;
#pragma unroll
            for (int r = 0; r < 16; ++r) { acc0[r] = 0.f; acc1[r] = 0.f; }
            float sq[8];
#pragma unroll
            for (int j = 0; j < 8; ++j) sq[j] = 0.f;
            f32x4 xa[8]; v2u ra[8];
#define P4_LOAD(XV, RV, c) do { _Pragma("unroll") for (int j = 0; j < 8; ++j) { const unsigned so_ = so0 + (unsigned)(4 * j * D + 64 * (c)); \
                XV[j] = __builtin_bit_cast(f32x4, __builtin_amdgcn_raw_buffer_load_b128(rsx, vo4, so_ * 4u, 0)); RV[j] = __builtin_amdgcn_raw_buffer_load_b64(rsr, vo2, so_ * 2u, 0); } } while (0)
#define P4_CHUNK(XV, RV, c, NEXT) do { \
                bf16x8 wfr[4][4]; \
                _Pragma("unroll") for (int s_ = 0; s_ < 4; ++s_) { const bf16x8* wf_ = (const bf16x8*)wfrag + (size_t)(wave * 16 + 4 * (c) + s_) * 256 + lane; wfr[s_][0] = wf_[0]; wfr[s_][1] = wf_[64]; wfr[s_][2] = wf_[128]; wfr[s_][3] = wf_[192]; } \
                _Pragma("unroll") for (int j = 0; j < 8; ++j) { f32x4 h4 = XV[j]; \
                    h4.x += __uint_as_float(RV[j].x << 16); h4.y += __uint_as_float(RV[j].x & 0xffff0000u); h4.z += __uint_as_float(RV[j].y << 16); h4.w += __uint_as_float(RV[j].y & 0xffff0000u); \
                    sq[j] += (h4.x * h4.x + h4.y * h4.y) + (h4.z * h4.z + h4.w * h4.w); \
                    const unsigned h01 = pk2(h4.x, h4.y), h23 = pk2(h4.z, h4.w); \
                    __builtin_amdgcn_raw_buffer_store_b64((v2u){h01, h23}, rsh, vo2, (so0 + (unsigned)(4 * j * D + 64 * (c))) * 2u, 0); \
                    const unsigned l01 = pk2(h4.x - __uint_as_float(h01 << 16), h4.y - __uint_as_float(h01 & 0xffff0000u)), l23 = pk2(h4.z - __uint_as_float(h23 << 16), h4.w - __uint_as_float(h23 & 0xffff0000u)); \
                    *(LAS v2u*)(stg + (4 * j + rsub) * 144 + cg * 8) = (v2u){h01, h23}; *(LAS v2u*)(stg + 4608 + (4 * j + rsub) * 144 + cg * 8) = (v2u){l01, l23}; } \
                if (NEXT) { P4_LOAD(XV, RV, (c) + 1); } \
                LDS_WAIT(); asm volatile("" ::: "memory"); \
                _Pragma("unroll") for (int s_ = 0; s_ < 4; ++s_) { \
                    const bf16x8 ah = *(const LAS bf16x8*)(stg + r32 * 144 + s_ * 32 + hi * 16), al = *(const LAS bf16x8*)(stg + 4608 + r32 * 144 + s_ * 32 + hi * 16); \
                    acc0 = __builtin_amdgcn_mfma_f32_32x32x16_bf16(ah, wfr[s_][0], acc0, 0, 0, 0); acc0 = __builtin_amdgcn_mfma_f32_32x32x16_bf16(al, wfr[s_][0], acc0, 0, 0, 0); acc0 = __builtin_amdgcn_mfma_f32_32x32x16_bf16(ah, wfr[s_][1], acc0, 0, 0, 0); \
                    acc1 = __builtin_amdgcn_mfma_f32_32x32x16_bf16(ah, wfr[s_][2], acc1, 0, 0, 0); acc1 = __builtin_amdgcn_mfma_f32_32x32x16_bf16(al, wfr[s_][2], acc1, 0, 0, 0); acc1 = __builtin_amdgcn_mfma_f32_32x32x16_bf16(ah, wfr[s_][3], acc1, 0, 0, 0); } \
                LDS_WAIT(); asm volatile("" ::: "memory"); __builtin_amdgcn_sched_barrier(0); } while (0)
            P4_LOAD(xa, ra, 0);
#pragma unroll 1
            for (int c = 0; c < 4; ++c) P4_CHUNK(xa, ra, c, c < 3);
#undef P4_LOAD
#undef P4_CHUNK
#pragma unroll
            for (int j = 0; j < 8; ++j) {
#pragma unroll
                for (int off = 1; off < 16; off <<= 1) sq[j] += __shfl_xor(sq[j], off);
            }
            __syncthreads();
#pragma unroll
            for (int r = 0; r < 16; ++r) { part[((wave * 2 + 0) * 16 + r) * 64 + lane] = acc0[r]; part[((wave * 2 + 1) * 16 + r) * 64 + lane] = acc1[r]; }
            if (cg == 0) {
#pragma unroll
                for (int j = 0; j < 8; ++j) ssqs[wave * 32 + 4 * j + rsub] = sq[j]; }
            __syncthreads();
#pragma unroll
            for (int q = 0; q < 4; ++q) { const int idx = tid + 512 * q; float sm = 0.f;
#pragma unroll
                for (int w = 0; w < 8; ++w) sm += part[w * 2048 + idx];
                const int nt_ = idx >> 10, r = (idx >> 6) & 15, ln = idx & 63; const int row = att::crow(r, ln >> 5), n = nt_ * 32 + (ln & 31);
                logit[row * 64 + n] = sm; }
            __syncthreads();
            if (tid < 32) {
                const int row = tid, token = R0 + row; float ss = 0.f;
#pragma unroll
                for (int w = 0; w < 8; ++w) ss += ssqs[w * 32 + row];
                const float rs = rsqrtf(ss * (1.f / D) + RMS_EPS);
                const LAS float* lg = logit + row * 64;
                float c[4];
#pragma unroll
                for (int k = 0; k < 4; ++k) c[k] = lg[32 + k] * rs + b_coarse[k];
                float cb = c[0]; int g = 0;
#pragma unroll
                for (int k = 1; k < 4; ++k) if (c[k] > cb) { cb = c[k]; g = k; }
                float den = 0.f;
#pragma unroll
                for (int k = 0; k < 4; ++k) den += expf(c[k] - cb);
                const float pg = 1.0f / den;
                float f[8];
#pragma unroll
                for (int k = 0; k < 8; ++k) f[k] = lg[g * 8 + k] * rs + b_fine[g * 8 + k];
                float v0 = f[0]; int i0 = 0;
#pragma unroll
                for (int k = 1; k < 8; ++k) if (f[k] > v0) { v0 = f[k]; i0 = k; }
                float v1 = -INFINITY; int i1 = 0;
#pragma unroll
                for (int k = 0; k < 8; ++k) if (k != i0 && f[k] > v1) { v1 = f[k]; i1 = k; }
                const float ex = expf(v1 - v0); const float w0 = pg / (1.0f + ex), w1 = pg * ex / (1.0f + ex);
                const int e0 = g * 8 + i0, e1 = g * 8 + i1;
                const unsigned s0 = __hip_atomic_fetch_add((unsigned*)(ctl + CW_CNT + 64 * e0), 1u, RLX_AGENT);
                const unsigned s1 = __hip_atomic_fetch_add((unsigned*)(ctl + CW_CNT + 64 * e1), 1u, RLX_AGENT);
                tokl[(size_t)e0 * 8192 + s0] = (unsigned)token; swl[(size_t)e0 * 8192 + s0] = (f32x2){rs, w0};
                tokl[(size_t)e1 * 8192 + s1] = (unsigned)token | 0x10000u; swl[(size_t)e1 * 8192 + s1] = (f32x2){rs, w1};
            }
        }
        __syncthreads();
        if (BOTH(4)) GRID_BAR();
    }

    if (IN(5) || IN(6) || IN(7)) {
        PHASE_WS(); WSPTR(hb, WS_HB); WSPTR(wgu_t, WS_WGU); WSPTR(wd_t, WS_WD); WSPTR(hmid, WS_HMID); WSPTR(yb, WS_Y); unsigned* tokl = (unsigned*)(ws + WS_TOK); f32x2* swl = (f32x2*)(ws + WS_SW);
        LAS int* tab = (LAS int*)(lds + TAB_OFF);
        if (tid < 32) tab[40 + tid] = (int)__hip_atomic_load((unsigned*)(ctl + CW_CNT + 64 * tid), RLX_AGENT);
        __syncthreads();
        if (tid == 0) { int acc = 0; for (int e = 0; e < 32; ++e) { tab[e] = acc; acc += (tab[40 + e] + 255) >> 8; } tab[32] = acc; }
        __syncthreads();
        const int NTt = __builtin_amdgcn_readfirstlane(tab[32]); const int T0 = NTt < 64 ? NTt : 64;
        int nb = (NTt - T0) * 4; if (nb > G / 2) nb = G / 2;
        if (IN(5)) {
            pg8::MoeOrder<4, true> S{0, G, bx, 0, T0, tab, (const char*)hb, (const char*)wgu_t, tokl};
            pg8::EpiGateUp E{hmid, swl};
            pg8::gemm_phase<pg8::EpiGateUp, pg8::MoeOrder<4, true>, true, true>(lds, D / 64, D, D, S, E);
            if (BOTH(5)) GRID_BAR();
        }
        if (IN(6)) {
            { pg8::MoeOrder<4, true> S{0, nb, bx, T0, NTt, tab, (const char*)hb, (const char*)wgu_t, tokl};
              pg8::EpiGateUp E{hmid, swl};
              pg8::gemm_phase<pg8::EpiGateUp, pg8::MoeOrder<4, true>, true, true>(lds, D / 64, D, D, S, E); }
            { pg8::MoeOrder<8, false> S{nb, G - nb, bx, 0, T0, tab, (const char*)hmid, (const char*)wd_t, tokl};
              pg8::EpiDown E{yb, tokl};
              pg8::gemm_phase<pg8::EpiDown, pg8::MoeOrder<8, false>, true, false>(lds, FF / 64, FF, FF, S, E); }
            if (BOTH(6)) GRID_BAR();
        }
        if (IN(7)) {
            pg8::MoeOrder<8, false> S{0, G, bx, T0, NTt, tab, (const char*)hmid, (const char*)wd_t, tokl};
            pg8::EpiDown E{yb, tokl};
            pg8::gemm_phase<pg8::EpiDown, pg8::MoeOrder<8, false>, true, false>(lds, FF / 64, FF, FF, S, E);
            if (BOTH(7)) GRID_BAR();
        }
    }

    if (IN(8)) {
        PHASE_WS(); WSPTR(yb, WS_Y); WSPTR(hb, WS_HB);
        const float* final_g = LDARG(19);
        for (int m = gw; m < T; m += NGW) {
            f32x4* orow = (f32x4*)(out + (size_t)m * D) + 2 * lane; f32x4 v[8]; float s = 0.f;
            const v4u* y0 = (const v4u*)(yb + (size_t)m * D) + lane; const v4u* y1 = (const v4u*)(yb + ((size_t)T + m) * D) + lane; const v4u* r0 = (const v4u*)(hb + (size_t)m * D) + lane;
#pragma unroll
            for (int j = 0; j < 4; ++j) { const v4u a = y0[64 * j], b = y1[64 * j], c = r0[64 * j];
                v[2 * j].x = __uint_as_float(a.x << 16) + __uint_as_float(b.x << 16) + __uint_as_float(c.x << 16); v[2 * j].y = __uint_as_float(a.x & 0xffff0000u) + __uint_as_float(b.x & 0xffff0000u) + __uint_as_float(c.x & 0xffff0000u);
                v[2 * j].z = __uint_as_float(a.y << 16) + __uint_as_float(b.y << 16) + __uint_as_float(c.y << 16); v[2 * j].w = __uint_as_float(a.y & 0xffff0000u) + __uint_as_float(b.y & 0xffff0000u) + __uint_as_float(c.y & 0xffff0000u);
                v[2 * j + 1].x = __uint_as_float(a.z << 16) + __uint_as_float(b.z << 16) + __uint_as_float(c.z << 16); v[2 * j + 1].y = __uint_as_float(a.z & 0xffff0000u) + __uint_as_float(b.z & 0xffff0000u) + __uint_as_float(c.z & 0xffff0000u);
                v[2 * j + 1].z = __uint_as_float(a.w << 16) + __uint_as_float(b.w << 16) + __uint_as_float(c.w << 16); v[2 * j + 1].w = __uint_as_float(a.w & 0xffff0000u) + __uint_as_float(b.w & 0xffff0000u) + __uint_as_float(c.w & 0xffff0000u); }
#pragma unroll
            for (int j = 0; j < 8; ++j) s += (v[j].x * v[j].x + v[j].y * v[j].y) + (v[j].z * v[j].z + v[j].w * v[j].w);
            const float rstd = rsqrtf(wave_sum(s) * (1.f / D) + RMS_EPS);
#pragma unroll
            for (int j = 0; j < 4; ++j) { const f32x4 g0 = ((const f32x4*)final_g)[2 * lane + 128 * j], g1 = ((const f32x4*)final_g)[2 * lane + 128 * j + 1]; orow[128 * j] = v[2 * j] * rstd * g0; orow[128 * j + 1] = v[2 * j + 1] * rstd * g1; }
        }
    }
#undef IN
#undef BOTH
#undef GRID_BAR
}

extern "C" void kernel_launch(void* const* d_in, const int* in_sizes, int n_in, void* d_out, int out_size, void* d_ws, size_t ws_size, hipStream_t stream) {
    static int grid = 0;
    if (grid == 0) {
        if (n_in != 20 || out_size != T * D || ws_size < WS_END) { fprintf(stderr, "kernel_launch: unexpected shapes (n_in %d out %d ws %zu)\n", n_in, out_size, ws_size); grid = -1; return; }
        int dev = 0, cus = 0, per_cu = 0;
        if (hipGetDevice(&dev) != hipSuccess || hipDeviceGetAttribute(&cus, hipDeviceAttributeMultiprocessorCount, dev) != hipSuccess) { grid = -1; return; }
        if (hipFuncSetAttribute((const void*)hymba_fwd, hipFuncAttributeMaxDynamicSharedMemorySize, LDS_BYTES) != hipSuccess) { fprintf(stderr, "kernel_launch: hipFuncSetAttribute failed\n"); grid = -1; return; }
        if (hipOccupancyMaxActiveBlocksPerMultiprocessor(&per_cu, (const void*)hymba_fwd, 512, LDS_BYTES) != hipSuccess || per_cu < 1) fprintf(stderr, "kernel_launch: occupancy query reports %d\n", per_cu);
        (void)hipGetLastError();
        grid = cus;
    }
    if (grid < 0) return;
    (void)hipMemsetAsync((char*)d_ws + WS_CTL, 0, CTL_ZERO_BYTES, stream);
    Args a{};
    for (int i = 0; i < 20; ++i) a.in[i] = (const float*)d_in[i];
    a.out = (float*)d_out; a.ws = (unsigned char*)d_ws;
    if (MK_N_LAUNCHES == 1) { a.ph_lo = 0; a.ph_hi = NPH; a.li = 0; hipLaunchKernelGGL(hymba_fwd, dim3(grid), dim3(512), LDS_BYTES, stream, a); }
    else { for (int p = 0; p < NPH; ++p) { a.ph_lo = p; a.ph_hi = p + 1; a.li = p; hipLaunchKernelGGL(hymba_fwd, dim3(grid), dim3(512), LDS_BYTES, stream, a);
            if (p == PROBE_DUP) { if (p == 4) (void)hipMemsetAsync((char*)d_ws + WS_CTL, 0, CTL_ZERO_BYTES, stream); if (p == 2) (void)hipMemsetAsync((char*)d_ws + WS_CTL + CW_QATT * 4, 0, 8 * 256, stream); hipLaunchKernelGGL(hymba_fwd, dim3(grid), dim3(512), LDS_BYTES, stream, a); } } }
}
```

```cpp
#include <hip/hip_runtime.h>
#include <hip/hip_bf16.h>
#include <cstdio>
#include <cstdint>

#ifndef MK_N_LAUNCHES
#define MK_N_LAUNCHES 1
#endif
#ifndef PROBE_DUP
#define PROBE_DUP -1
#endif

#define GAS __attribute__((address_space(1)))
#define LAS __attribute__((address_space(3)))
typedef unsigned short bf16;
typedef unsigned v4u __attribute__((ext_vector_type(4)));
typedef unsigned v2u __attribute__((ext_vector_type(2)));
typedef float f32x4 __attribute__((ext_vector_type(4)));
typedef float f32x2 __attribute__((ext_vector_type(2)));
typedef float f32x16 __attribute__((ext_vector_type(16)));
typedef short bf16x8 __attribute__((ext_vector_type(8)));
typedef short s16x4 __attribute__((ext_vector_type(4)));
typedef GAS unsigned gu32;
#define RLX_AGENT __ATOMIC_RELAXED, __HIP_MEMORY_SCOPE_AGENT
#define LDS_WAIT() asm volatile("s_waitcnt lgkmcnt(0)" ::: "memory")
#define VM_WAIT() asm volatile("s_waitcnt vmcnt(0)" ::: "memory")

constexpr int T = 8192, SEQ = 2048, D = 2048, INW = 4096, AW = 1024, NH = 8, NE = 32, FF = 512;
constexpr float RMS_EPS = 1e-6f;
constexpr float LOG2E = 1.4426950408889634f;
constexpr float C2 = 0.125f * LOG2E;

constexpr size_t MiB = 1u << 20;
constexpr size_t WS_CTL = 0, CTL_ZERO_BYTES = 32768;
constexpr size_t WS_WFRAG = 1 * MiB;
constexpr size_t WS_BT2 = 1 * MiB + 512 * 1024;
constexpr size_t WS_WIN = 2 * MiB;
constexpr size_t WS_WOUT = 18 * MiB;
constexpr size_t WS_WOUT2 = 26 * MiB;
constexpr size_t WS_TOK = 34 * MiB;
constexpr size_t WS_SW = 35 * MiB;
constexpr size_t WS_WGU = 40 * MiB;
constexpr size_t WS_WD = 168 * MiB;
constexpr size_t WS_XN = 232 * MiB;
constexpr size_t WS_HMID = 232 * MiB;
constexpr size_t WS_Q = 264 * MiB, WS_K = 280 * MiB, WS_V = 296 * MiB, WS_U = 312 * MiB;
constexpr size_t WS_Y = 264 * MiB;
constexpr size_t WS_A3 = 328 * MiB;
constexpr size_t WS_HB = 360 * MiB;
constexpr size_t WS_RB = 392 * MiB;
constexpr size_t WS_END = 424 * MiB;
constexpr int CW_CNT = 1024;
constexpr int CW_QATT = 3072, CW_QCVT = 3584;
constexpr int CW_BAR = 4096;

constexpr int RING_BYTES = 131072;
constexpr int WSF_OFF = RING_BYTES;
constexpr int TAB_OFF = WSF_OFF + 2048;
constexpr int MISC_OFF = TAB_OFF + 512;
constexpr int LDS_BYTES = 147456;

namespace pg8 {
#define PG8_LAS __attribute__((address_space(3)))
typedef unsigned short bf16_t;
typedef unsigned u32x4 __attribute__((ext_vector_type(4)));
constexpr int BM = 256, BK = 64, HALF = 128, HTB = HALF * BK * 2, STAGE_BYTES = 8 * HTB, NXCD = 8, WGM = 8;

__host__ __device__ __forceinline__ int lds_byte(int r, int c) { const int st = (r >> 4) * 2 + (c >> 5), rr = r & 15, cc = c & 31, ob = rr * 64 + cc * 2; return st * 1024 + (ob ^ (((ob >> 9) & 1) << 5)); }
__host__ __device__ __forceinline__ void stage_rc(int b, int& R, int& C) { const int st = b / 1024, sb = b % 1024, swz = sb ^ (((sb >> 9) & 1) << 5); R = (st >> 1) * 16 + swz / 64; C = (st & 1) * 32 + (swz % 64) / 2; }
__host__ __device__ __forceinline__ int perm32(int rho) { const int n = rho >> 4, i = rho & 15; return 8 * (i >> 2) + 4 * n + (i & 3); }

struct Unit { const char* a; const char* b; int orow, ocol, e, s0, cnt; };

__device__ __forceinline__ unsigned cvt_pk_bf16(float lo, float hi) { unsigned r; asm volatile("v_cvt_pk_bf16_f32 %0, %1, %2" : "=v"(r) : "v"(lo), "v"(hi)); return r; }

struct DenseOrder {
    int nM, nN, nwg, G, c; const char* A; const char* Bt; size_t tsA, tsB;
    __device__ void init(int M, int N, int G_, int c_, const void* A_, const void* Bt_, int lda, int ldb) { nM = M / BM; nN = N / BM; nwg = nM * nN; G = G_; c = c_; A = (const char*)A_; Bt = (const char*)Bt_; tsA = (size_t)BM * lda * 2; tsB = (size_t)BM * ldb * 2; }
    __device__ bool next(int i, Unit& u) const {
        const long L = (long)i * G + c; if (L >= nwg) return false;
        int wgid = (int)L; { const int q = nwg / NXCD, r = nwg % NXCD, xcd = wgid % NXCD, off = wgid / NXCD; wgid = (xcd < r ? xcd * (q + 1) : r * (q + 1) + (xcd - r) * q) + off; }
        const int nig = WGM * nN, gid = wgid / nig, fm = gid * WGM, gsz = (nM - fm) < WGM ? (nM - fm) : WGM;
        const int pm = fm + ((wgid % nig) % gsz), pn = (wgid % nig) / gsz;
        u.a = A + (size_t)pm * tsA; u.b = Bt + (size_t)pn * tsB; u.orow = pm * BM; u.ocol = pn * BM; u.e = 0; u.s0 = 0; u.cnt = 0; return true;
    }
    __device__ __forceinline__ unsigned row_off(const Unit&, int) const { return 0u; }
};

template <class Epi, class Sched, bool ALIGN_EPI, bool GATHER>
__device__ __forceinline__ void gemm_phase(PG8_LAS unsigned char* lds, const int nt, const int lda, const int ldb, const Sched& S, const Epi& E) {
    const int tid = threadIdx.x, wid = __builtin_amdgcn_readfirstlane(tid >> 6), lane = tid & 63, wr = wid >> 2, wc = wid & 3, fr = lane & 15, fq = lane >> 4;
    unsigned voffA[2], voffB[2]; int rA[2]; unsigned cA2[2];
#pragma unroll
    for (int i = 0; i < 2; ++i) { int R, C; stage_rc(tid * 16 + i * 8192, R, C); const int Rb = Epi::PERM ? ((R & ~31) + perm32(R & 31)) : R;
        voffA[i] = (unsigned)(R * lda + C) * 2u; voffB[i] = (unsigned)(Rb * ldb + C) * 2u; rA[i] = R; cA2[i] = (unsigned)C * 2u; }
    const size_t kstep = (size_t)(BK * 2);
    const size_t hstepA = (size_t)HALF * lda * 2, hstepB = (size_t)HALF * ldb * 2;
    const unsigned ldsw = (unsigned)wid * 1024u;
    const int aoff = lds_byte(wr * 64 + fr, fq * 8), boff = lds_byte(wc * 32 + fr, fq * 8);
#define PG8_SA(b, h) (((b) * 2 + (h)) * HTB)
#define PG8_SB(b, h) ((4 + (b) * 2 + (h)) * HTB)
#define PG8_STAGE_O(bufoff, gbase, o0, o1) do { \
        __builtin_amdgcn_global_load_lds((const unsigned*)((const char*)(gbase) + (o0)), (PG8_LAS unsigned*)(lds + (bufoff) + ldsw), 16, 0, 0); \
        __builtin_amdgcn_global_load_lds((const unsigned*)((const char*)(gbase) + (o1)), (PG8_LAS unsigned*)(lds + (bufoff) + ldsw + 8192), 16, 0, 0); } while (0)
#define PG8_STB(b, h, bptr) PG8_STAGE_O(PG8_SB(b, h), (bptr) + (h) * hstepB, voffB[0], voffB[1])
#define PG8_STA(b, h, aptr, O) do { if constexpr (GATHER) { PG8_STAGE_O(PG8_SA(b, h), (aptr), O[h][0], O[h][1]); } else { PG8_STAGE_O(PG8_SA(b, h), (aptr) + (h) * hstepA, voffA[0], voffA[1]); } } while (0)
#define PG8_LDA(dst, b, h) do { _Pragma("unroll") for (int m = 0; m < 4; ++m) _Pragma("unroll") for (int k = 0; k < 2; ++k) dst[m][k] = *(const PG8_LAS bf16x8*)(lds + PG8_SA(b, h) + aoff + m * 2048 + k * 1024); } while (0)
#define PG8_LDB(dst, b, h) do { _Pragma("unroll") for (int n = 0; n < 2; ++n) _Pragma("unroll") for (int k = 0; k < 2; ++k) dst[n][k] = *(const PG8_LAS bf16x8*)(lds + PG8_SB(b, h) + boff + n * 2048 + k * 1024); } while (0)
#define PG8_MMA(ai, bj, At, Bt) do { __builtin_amdgcn_s_setprio(1); _Pragma("unroll") for (int m = 0; m < 4; ++m) _Pragma("unroll") for (int n = 0; n < 2; ++n) _Pragma("unroll") for (int k = 0; k < 2; ++k) \
        acc[ai][bj][m][n] = __builtin_amdgcn_mfma_f32_16x16x32_bf16(Bt[n][k], At[m][k], acc[ai][bj][m][n], 0, 0, 0); __builtin_amdgcn_s_setprio(0); } while (0)
#define PG8_WAIT_V(n) asm volatile("s_waitcnt vmcnt(" #n ")" ::: "memory")
#define PG8_WAIT_L(n) asm volatile("s_waitcnt lgkmcnt(" #n ")" ::: "memory")
#define PG8_BAR __builtin_amdgcn_s_barrier()
#define PG8_SCHED __builtin_amdgcn_sched_barrier(0)
#define PG8_FETCH(u, O) do { _Pragma("unroll") for (int h_ = 0; h_ < 2; ++h_) _Pragma("unroll") for (int i_ = 0; i_ < 2; ++i_) O[h_][i_] = S.row_off(u, h_ * HALF + rA[i_]) + cA2[i_]; } while (0)
    Unit cur, nxt; int ui = 0;
    if (!S.next(0, cur)) return;
    f32x4 acc[2][2][4][2];
#pragma unroll
    for (int a = 0; a < 2; ++a)
#pragma unroll
        for (int b = 0; b < 2; ++b)
#pragma unroll
            for (int m = 0; m < 4; ++m)
#pragma unroll
                for (int n = 0; n < 2; ++n) acc[a][b][m][n] = (f32x4){0.f, 0.f, 0.f, 0.f};
    bf16x8 At[4][2], B0[2][2], B1[2][2];
    unsigned oC[2][2] = {{0u, 0u}, {0u, 0u}}, oN[2][2] = {{0u, 0u}, {0u, 0u}}, o2[2][2] = {{0u, 0u}, {0u, 0u}};
    if constexpr (GATHER) { PG8_FETCH(cur, oC); }
    const char* cA = cur.a; const char* cB = cur.b;
    PG8_STB(0, 0, cB); PG8_STB(0, 1, cB); PG8_STA(0, 0, cA, oC); PG8_STA(0, 1, cA, oC);
    if (wr == 1) PG8_BAR;
    PG8_WAIT_V(2); PG8_BAR;
    PG8_STB(1, 0, cB + kstep); PG8_STA(1, 0, cA + kstep, oC); PG8_STB(1, 1, cB + kstep);
    PG8_WAIT_V(6); PG8_BAR;
    for (;;) {
        const bool has_next = S.next(ui + 1, nxt);
        const char* nA = has_next ? nxt.a : cA; const char* nB = has_next ? nxt.b : cB;
        if constexpr (GATHER) { if (has_next) { PG8_FETCH(nxt, oN); } else {
#pragma unroll
            for (int h_ = 0; h_ < 2; ++h_)
#pragma unroll
                for (int i_ = 0; i_ < 2; ++i_) oN[h_][i_] = oC[h_][i_]; } }
        for (int t = 0; t < nt; t += 2) {
            const bool last = (t == nt - 2);
            const char* a1 = cA + (size_t)(t + 1) * kstep;
            const char* a2 = last ? nA : cA + (size_t)(t + 2) * kstep; const char* b2 = last ? nB : cB + (size_t)(t + 2) * kstep;
            const char* a3 = a2 + kstep; const char* b3 = b2 + kstep;
            if constexpr (GATHER) {
#pragma unroll
                for (int h_ = 0; h_ < 2; ++h_)
#pragma unroll
                    for (int i_ = 0; i_ < 2; ++i_) o2[h_][i_] = last ? oN[h_][i_] : oC[h_][i_]; }
            PG8_LDB(B0, 0, 0); PG8_LDB(B1, 0, 1); PG8_SCHED; PG8_LDA(At, 0, 0); PG8_STA(1, 1, a1, oC);
            PG8_WAIT_V(8); PG8_WAIT_L(0); PG8_BAR; PG8_MMA(0, 0, At, B0); PG8_MMA(0, 1, At, B1); PG8_BAR; PG8_SCHED;
            PG8_LDA(At, 0, 1); PG8_STB(0, 0, b2); PG8_STB(0, 1, b2); PG8_STA(0, 0, a2, o2);
            PG8_WAIT_V(8); PG8_WAIT_L(0); PG8_BAR; PG8_MMA(1, 0, At, B0); PG8_MMA(1, 1, At, B1); PG8_BAR; PG8_SCHED;
            PG8_LDB(B0, 1, 0); PG8_LDB(B1, 1, 1); PG8_SCHED; PG8_LDA(At, 1, 0); PG8_STA(0, 1, a2, o2);
            PG8_WAIT_V(8); PG8_WAIT_L(0); PG8_BAR; PG8_MMA(0, 0, At, B0); PG8_MMA(0, 1, At, B1); PG8_BAR; PG8_SCHED;
            PG8_LDA(At, 1, 1); PG8_STB(1, 0, b3); PG8_STB(1, 1, b3); PG8_STA(1, 0, a3, o2);
            PG8_WAIT_V(8); PG8_WAIT_L(0); PG8_BAR; PG8_MMA(1, 0, At, B0); PG8_MMA(1, 1, At, B1); PG8_BAR; PG8_SCHED;
        }
        if constexpr (ALIGN_EPI) { if (wr == 0) PG8_BAR; }
        E(acc, cur, wr, wc, fr, fq);
        if (!has_next) break;
#pragma unroll
        for (int a = 0; a < 2; ++a)
#pragma unroll
            for (int b = 0; b < 2; ++b)
#pragma unroll
                for (int m = 0; m < 4; ++m)
#pragma unroll
                    for (int n = 0; n < 2; ++n) acc[a][b][m][n] = (f32x4){0.f, 0.f, 0.f, 0.f};
        cur = nxt; cA = nA; cB = nB; ++ui;
        if constexpr (GATHER) {
#pragma unroll
            for (int h_ = 0; h_ < 2; ++h_)
#pragma unroll
                for (int i_ = 0; i_ < 2; ++i_) oC[h_][i_] = oN[h_][i_]; }
        if constexpr (ALIGN_EPI) { if (wr == 1) PG8_BAR; }
    }
    PG8_WAIT_V(0);
    if constexpr (!ALIGN_EPI) { if (wr == 0) PG8_BAR; }
    PG8_BAR;
#undef PG8_SA
#undef PG8_SB
#undef PG8_STAGE_O
#undef PG8_STB
#undef PG8_STA
#undef PG8_LDA
#undef PG8_LDB
#undef PG8_MMA
#undef PG8_WAIT_V
#undef PG8_WAIT_L
#undef PG8_BAR
#undef PG8_SCHED
#undef PG8_FETCH
}

struct EpiStoreBf16 {
    static constexpr bool PERM = true;
    bf16_t* O; int ldc; int split_cols; size_t split_stride; float scale0;
    __device__ __forceinline__ void operator()(const f32x4 (&acc)[2][2][4][2], const Unit& u, int wr, int wc, int fr, int fq) const {
        const int row0 = u.orow + wr * 64 + fr; int colt = u.ocol; bf16_t* base = O;
        float sc = 1.f; if (split_cols) { const int t = colt / split_cols; base += (size_t)t * split_stride; colt -= t * split_cols; if (t == 0) sc = scale0; }
        const int col0 = colt + wc * 32 + 8 * fq;
#pragma unroll
        for (int ai = 0; ai < 2; ++ai)
#pragma unroll
            for (int m = 0; m < 4; ++m) { bf16_t* rowp = base + (size_t)(row0 + ai * HALF + m * 16) * ldc + col0;
#pragma unroll
                for (int bj = 0; bj < 2; ++bj) { const f32x4 v0 = acc[ai][bj][m][0] * sc, v1 = acc[ai][bj][m][1] * sc;
                    u32x4 w; w.x = cvt_pk_bf16(v0[0], v0[1]); w.y = cvt_pk_bf16(v0[2], v0[3]); w.z = cvt_pk_bf16(v1[0], v1[1]); w.w = cvt_pk_bf16(v1[2], v1[3]);
                    *(u32x4*)(rowp + bj * HALF) = w; } }
    }
};
struct EpiResid {
    static constexpr bool PERM = false;
    const float* x; float* out; bf16_t* hb;
    __device__ __forceinline__ void operator()(const f32x4 (&acc)[2][2][4][2], const Unit& u, int wr, int wc, int fr, int fq) const {
        const int row0 = u.orow + wr * 64 + fr, col0 = u.ocol + wc * 32 + 4 * fq;
#pragma unroll
        for (int ai = 0; ai < 2; ++ai)
#pragma unroll
            for (int m = 0; m < 4; ++m) { const size_t off = (size_t)(row0 + ai * HALF + m * 16) * D + col0;
#pragma unroll
                for (int bj = 0; bj < 2; ++bj)
#pragma unroll
                    for (int n = 0; n < 2; ++n) { const size_t o = off + bj * HALF + n * 16; const f32x4 xv = *(const f32x4*)(x + o); const f32x4 hv = xv + acc[ai][bj][m][n];
                        *(f32x4*)(out + o) = hv; v2u w; w.x = cvt_pk_bf16(hv[0], hv[1]); w.y = cvt_pk_bf16(hv[2], hv[3]); *(v2u*)(hb + o) = w; } }
    }
};
struct EpiGateUp {
    static constexpr bool PERM = true;
    bf16_t* hmid; const f32x2* sw;
    __device__ __forceinline__ void operator()(const f32x4 (&acc)[2][2][4][2], const Unit& u, int wr, int wc, int fr, int fq) const {
        const int col0 = u.ocol + wc * 32 + 8 * fq;
        const GAS f32x2* swg = (const GAS f32x2*)sw + (size_t)u.e * 8192 + u.s0 + wr * 64 + fr;
        f32x2 rws[2][4];
#pragma unroll
        for (int ai = 0; ai < 2; ++ai)
#pragma unroll
            for (int m = 0; m < 4; ++m) rws[ai][m] = swg[ai * HALF + m * 16];
#pragma unroll
        for (int ai = 0; ai < 2; ++ai)
#pragma unroll
            for (int m = 0; m < 4; ++m) { const int r = ai * HALF + wr * 64 + m * 16 + fr; const int slot = u.s0 + r; const bool valid = slot < u.cnt;
                const f32x2 rw = rws[ai][m];
                float hv[8];
#pragma unroll
                for (int n = 0; n < 2; ++n)
#pragma unroll
                    for (int j = 0; j < 4; ++j) { const float g = acc[ai][0][m][n][j] * rw.x, up = acc[ai][1][m][n][j] * rw.x;
                        const float e = __builtin_amdgcn_exp2f(-g * LOG2E); const float s = g * __builtin_amdgcn_rcpf(1.0f + e); hv[n * 4 + j] = valid ? s * up * rw.y : 0.f; }
                u32x4 w; w.x = cvt_pk_bf16(hv[0], hv[1]); w.y = cvt_pk_bf16(hv[2], hv[3]); w.z = cvt_pk_bf16(hv[4], hv[5]); w.w = cvt_pk_bf16(hv[6], hv[7]);
                *(GAS u32x4*)(hmid + (size_t)(u.orow + r) * FF + col0) = w; }
    }
};
struct EpiDown {
    static constexpr bool PERM = true;
    bf16_t* y; const unsigned* tok;
    __device__ __forceinline__ void operator()(const f32x4 (&acc)[2][2][4][2], const Unit& u, int wr, int wc, int fr, int fq) const {
        const int col0 = u.ocol + wc * 32 + 8 * fq;
        const GAS unsigned* tg = (const GAS unsigned*)tok + (size_t)u.e * 8192 + u.s0 + wr * 64 + fr;
        unsigned tis[2][4];
#pragma unroll
        for (int ai = 0; ai < 2; ++ai)
#pragma unroll
            for (int m = 0; m < 4; ++m) tis[ai][m] = tg[ai * HALF + m * 16];
#pragma unroll
        for (int ai = 0; ai < 2; ++ai)
#pragma unroll
            for (int m = 0; m < 4; ++m) { const int r = ai * HALF + wr * 64 + m * 16 + fr; const int slot = u.s0 + r;
                if (slot < u.cnt) { const unsigned ti = tis[ai][m]; const unsigned token = ti & 0xffffu, ks = ti >> 16;
                    bf16_t* rowp = y + ((size_t)ks * T + token) * D + col0;
#pragma unroll
                    for (int bj = 0; bj < 2; ++bj) { const f32x4 v0 = acc[ai][bj][m][0], v1 = acc[ai][bj][m][1];
                        u32x4 w; w.x = cvt_pk_bf16(v0[0], v0[1]); w.y = cvt_pk_bf16(v0[2], v0[3]); w.z = cvt_pk_bf16(v1[0], v1[1]); w.w = cvt_pk_bf16(v1[2], v1[3]);
                        *(GAS u32x4*)(rowp + bj * HALF) = w; } } }
    }
};
struct W2Order {
    int G, c; const char* A; const char* Bt;
    __device__ bool next(int i, Unit& u) const { const int L = i * G + c; if (L >= 32) return false; const int g = L & 3, dt = L >> 2;
        u.a = A + ((size_t)dt * 256 * D + 1024 + 256 * g) * 2; u.b = Bt + (size_t)g * 65536 * 2; u.orow = dt * 256; u.ocol = 1024 + 256 * g; u.e = 0; u.s0 = 0; u.cnt = 0; return true; }
    __device__ __forceinline__ unsigned row_off(const Unit&, int) const { return 0u; }
};
template <int NPN, bool UP> struct MoeOrder {
    int c0, ncu, c, t_lo, t_hi; const PG8_LAS int* tab; const char* A; const char* W; const unsigned* tok;
    __device__ bool next(int i, Unit& u) const {
        if (c < c0 || c >= c0 + ncu) return false;
        const int nt_all = __builtin_amdgcn_readfirstlane(tab[32]); const int hi_ = t_hi < nt_all ? t_hi : nt_all; const int total = (hi_ - t_lo) * NPN;
        const int L = i * ncu + (c - c0); if (L >= total) return false;
        const int Tt = t_lo + L / NPN, pn = L % NPN; int e = 0;
        for (int k = 1; k < 32; ++k) e = (tab[k] <= Tt) ? k : e;
        e = __builtin_amdgcn_readfirstlane(e);
        const int mt = Tt - __builtin_amdgcn_readfirstlane(tab[e]);
        u.e = e; u.s0 = mt * 256; u.cnt = __builtin_amdgcn_readfirstlane(tab[40 + e]); u.orow = Tt * 256;
        if (UP) { u.a = A; u.b = W + ((size_t)(e * 4 + pn) * 256) * D * 2; u.ocol = pn * 128; }
        else { u.a = A + (size_t)Tt * 256 * FF * 2; u.b = W + ((size_t)e * D + pn * 256) * FF * 2; u.ocol = pn * 256; }
        return true;
    }
    __device__ __forceinline__ unsigned row_off(const Unit& u, int R) const {
        const int slot = u.s0 + R; unsigned token = ((const GAS unsigned*)tok)[u.e * 8192 + slot] & 0xffffu; token = (slot < u.cnt) ? token : 0u; return token * (unsigned)(D * 2);
    }
};
}

namespace att {
constexpr int PITCH = 1024, QB = 128, KVB = 64;
constexpr int KBUF0 = 0, VBUF0 = 32768, XBUF0 = 65536;
__device__ __forceinline__ int crow(int r, int hi) { return (r & 3) + 8 * (r >> 2) + 4 * hi; }
__device__ __forceinline__ unsigned cvtpk(float lo, float hi) { unsigned r; asm volatile("v_cvt_pk_bf16_f32 %0, %1, %2" : "=v"(r) : "v"(lo), "v"(hi)); return r; }
typedef short v4i16_t __attribute__((ext_vector_type(4)));
__device__ __forceinline__ v2u vtr(const LAS char* p) { return __builtin_bit_cast(v2u, __builtin_amdgcn_ds_read_tr16_b64_v4i16((LAS v4i16_t*)p)); }
__device__ __forceinline__ float opq(float x) { asm("" : "+v"(x)); return x; }
__device__ __forceinline__ float hswap_max(float m) { auto rr = __builtin_amdgcn_permlane32_swap(__float_as_uint(m), __float_as_uint(m), false, false); return fmaxf(__uint_as_float(rr[0]), __uint_as_float(rr[1])); }
__device__ __forceinline__ float hswap_sum(float m) { auto rr = __builtin_amdgcn_permlane32_swap(__float_as_uint(m), __float_as_uint(m), false, false); return __uint_as_float(rr[0]) + __uint_as_float(rr[1]); }

__device__ __forceinline__ void attn_unit(int b, int h, int qb, const bf16* Q, const bf16* K, const bf16* V, bf16* A3, const float* subg, float lam, LAS unsigned char* lds, LAS float* wsf_all) {
    int lane_ = threadIdx.x & 63; asm volatile("" : "+v"(lane_));
    const int tid = threadIdx.x, lane = lane_, r32 = lane & 31, hi = lane >> 5; const int wid = __builtin_amdgcn_readfirstlane(tid >> 6);
    const int mp = wid >> 2, rg = wid & 3;
    const long rowbase = (long)b * SEQ; const int q0 = qb * QB, qmin = q0 + 32 * rg, qmax = qmin + 31;
    const float slope2 = exp2f(-(float)(h + 1)) * LOG2E;
    LAS float* wsf = wsf_all + wid * 64;
    const bf16* Kh = K + rowbase * PITCH + h * 128; const bf16* Vh = V + rowbase * PITCH + h * 128;
    const int NT = (q0 + QB) / KVB;
    const int drow = 4 * wid + (lane >> 4), dslot = lane & 15;
    const bf16* ksrc = Kh + (long)drow * PITCH + ((dslot ^ (drow & 15)) * 8);
    const bf16* vsrc = Vh + (long)drow * PITCH + (((dslot >> 2) ^ (drow & 3)) * 32) + (dslot & 3) * 8;
    const unsigned lds0 = (unsigned)(unsigned long)lds;
#define ATT_GLDS(gsrc, ldst) do { unsigned keep_; asm volatile("s_mov_b32 %0, m0\n\ts_mov_b32 m0, %2\n\ts_nop 0\n\tglobal_load_lds_dwordx4 %1, off\n\ts_mov_b32 m0, %0" : "=&s"(keep_) : "v"(gsrc), "s"(ldst) : "memory"); } while (0)
#define ATT_DMA_K(t) do { const long to_ = (long)(t) * KVB * PITCH; const unsigned bb_ = (unsigned)__builtin_amdgcn_readfirstlane((int)(lds0 + KBUF0 + (unsigned)((t) & 1) * 16384u)); \
        ATT_GLDS(ksrc + to_, bb_ + (unsigned)wid * 1024u); ATT_GLDS(ksrc + to_ + 32 * PITCH, bb_ + 8192u + (unsigned)wid * 1024u); } while (0)
#define ATT_DMA_V(t) do { const long to_ = (long)(t) * KVB * PITCH; const unsigned bb_ = (unsigned)__builtin_amdgcn_readfirstlane((int)(lds0 + VBUF0 + (unsigned)((t) & 1) * 16384u)); \
        ATT_GLDS(vsrc + to_, bb_ + (unsigned)wid * 1024u); ATT_GLDS(vsrc + to_ + 32 * PITCH, bb_ + 8192u + (unsigned)wid * 1024u); } while (0)
    ATT_DMA_K(0);
    bf16x8 qr[4];
    {
        const bf16* Qw = Q + (rowbase + qmin + r32) * PITCH + h * 128 + mp * 64 + hi * 8;
#pragma unroll
        for (int d0 = 0; d0 < 4; ++d0) qr[d0] = *(const bf16x8*)(Qw + d0 * 16);
        asm volatile("" :: "v"(qr[0]), "v"(qr[1]), "v"(qr[2]), "v"(qr[3]));
    }
    const float s32 = 32.f * slope2;
    const float lbase = slope2 * (float)(4 * hi - r32 - qmin);
#ifdef PROBE_TIME
    const unsigned long long pt0_ = __builtin_amdgcn_s_memrealtime();
#endif
    float mrow = -INFINITY, lsum = 0.f;
    f32x16 o[4];
#pragma unroll
    for (int d0 = 0; d0 < 4; ++d0)
#pragma unroll
        for (int r = 0; r < 16; ++r) o[d0][r] = 0.f;
    v4u pw[4] = {(v4u){0u, 0u, 0u, 0u}, (v4u){0u, 0u, 0u, 0u}, (v4u){0u, 0u, 0u, 0u}, (v4u){0u, 0u, 0u, 0u}};
    bool resc = false;
    const int vq = (lane & 15) >> 2;
    for (int s = 0; s <= NT; ++s) {
        VM_WAIT(); __syncthreads();
        if (s + 1 < NT) ATT_DMA_K(s + 1);
        if (s < NT) ATT_DMA_V(s);
        const bool do_s = s < NT && KVB * s <= qmax, do_pv = s >= 1 && KVB * (s - 1) <= qmax;
        f32x16 p0, p1;
        if (do_s) {
            const LAS unsigned char* kb = lds + KBUF0 + (s & 1) * 16384 + r32 * 256;
            bf16x8 kf[8];
#pragma unroll
            for (int d0 = 0; d0 < 4; ++d0) { const int so = ((mp * 8 + 2 * d0 + hi) ^ (r32 & 15)) * 16; kf[2 * d0] = *(const LAS bf16x8*)(kb + so); kf[2 * d0 + 1] = *(const LAS bf16x8*)(kb + so + 8192); }
#pragma unroll
            for (int r = 0; r < 16; ++r) { p0[r] = 0.f; p1[r] = 0.f; }
#pragma unroll
            for (int d0 = 0; d0 < 4; ++d0) {
                p0 = __builtin_amdgcn_mfma_f32_32x32x16_bf16(kf[2 * d0], qr[d0], p0, 0, 0, 0);
                p1 = __builtin_amdgcn_mfma_f32_32x32x16_bf16(kf[2 * d0 + 1], qr[d0], p1, 0, 0, 0);
            }
        }
        if (do_pv) {
            const int t = s - 1;
            if (resc) {
                float al[16];
#pragma unroll
                for (int r = 0; r < 16; ++r) al[r] = wsf[crow(r, hi)];
#pragma unroll
                for (int d0 = 0; d0 < 4; ++d0)
#pragma unroll
                    for (int r = 0; r < 16; ++r) o[d0][r] = opq(o[d0][r] * al[r]);
            }
            const LAS char* vb = (const LAS char*)(lds + VBUF0 + (t & 1) * 16384) + ((lane >> 4) & 1) * 32 + (lane & 3) * 8 + (4 * hi + vq) * 256;
#pragma unroll
            for (int d0 = 0; d0 < 4; ++d0) {
#pragma unroll
                for (int ks = 0; ks < 4; ++ks) { const v2u lo = vtr(vb + ((d0 ^ vq) * 64) + ks * 4096), hh = vtr(vb + ((d0 ^ vq) * 64) + ks * 4096 + 2048);
                    const v4u vf = (v4u){lo.x, lo.y, hh.x, hh.y};
                    o[d0] = __builtin_amdgcn_mfma_f32_32x32x16_bf16(__builtin_bit_cast(bf16x8, pw[ks]), __builtin_bit_cast(bf16x8, vf), o[d0], 0, 0, 0); }
            }
        }
        if (do_s) {
            const float lb = lbase + slope2 * (float)(KVB * s);
#pragma unroll
            for (int r = 0; r < 16; ++r) { const float cr = (float)((r & 3) + 8 * (r >> 2)); p0[r] = opq(fmaf(slope2, cr, p0[r])); p1[r] = opq(fmaf(slope2, cr, p1[r])); }
            if (KVB * s + 63 > qmin) {
                const int dq = qmin + r32 - KVB * s - 4 * hi;
#pragma unroll
                for (int r = 0; r < 16; ++r) { const int kk = (r & 3) + 8 * (r >> 2); if (kk > dq) p0[r] = -INFINITY; if (kk + 32 > dq) p1[r] = -INFINITY; }
            }
            float m0 = p0[0], m1 = p1[0];
#pragma unroll
            for (int r = 1; r < 16; ++r) { m0 = fmaxf(m0, p0[r]); m1 = fmaxf(m1, p1[r]); }
            float rmt = fmaxf(m0, m1 + s32) + lb; rmt = hswap_max(rmt);
            const float mnew = fmaxf(mrow, rmt);
            const float alpha = __builtin_amdgcn_exp2f(mrow - mnew);
            mrow = mnew;
            const float e0 = mnew - lb, e1 = e0 - s32;
            float sacc = 0.f;
#pragma unroll
            for (int r = 0; r < 16; ++r) { p0[r] = __builtin_amdgcn_exp2f(opq(p0[r] - e0)); p1[r] = __builtin_amdgcn_exp2f(opq(p1[r] - e1)); sacc = opq(sacc + p0[r]); sacc = opq(sacc + p1[r]); }
            lsum = lsum * alpha + sacc;
            pw[0] = (v4u){cvtpk(p0[0], p0[1]), cvtpk(p0[2], p0[3]), cvtpk(p0[4], p0[5]), cvtpk(p0[6], p0[7])};
            pw[1] = (v4u){cvtpk(p0[8], p0[9]), cvtpk(p0[10], p0[11]), cvtpk(p0[12], p0[13]), cvtpk(p0[14], p0[15])};
            pw[2] = (v4u){cvtpk(p1[0], p1[1]), cvtpk(p1[2], p1[3]), cvtpk(p1[4], p1[5]), cvtpk(p1[6], p1[7])};
            pw[3] = (v4u){cvtpk(p1[8], p1[9]), cvtpk(p1[10], p1[11]), cvtpk(p1[12], p1[13]), cvtpk(p1[14], p1[15])};
            resc = !__all(alpha == 1.0f);
            if (resc && hi == 0) wsf[r32] = alpha;
        }
    }
#undef ATT_DMA_K
#undef ATT_DMA_V
#undef ATT_GLDS
#ifdef PROBE_TIME
    if (threadIdx.x == 0) { volatile LAS unsigned* pa_ = (volatile LAS unsigned*)(lds + MISC_OFF + 64); pa_[0] += (unsigned)(__builtin_amdgcn_s_memrealtime() - pt0_); pa_[1] += (unsigned)(NT + 1); }
#endif
    lsum = hswap_sum(lsum);
    if (hi == 0) wsf[r32] = __builtin_amdgcn_rcpf(lsum);
    LDS_WAIT();
    {
        float rl[16];
#pragma unroll
        for (int r = 0; r < 16; ++r) rl[r] = wsf[crow(r, hi)];
#pragma unroll
        for (int d0 = 0; d0 < 4; ++d0)
#pragma unroll
            for (int r = 0; r < 16; ++r) o[d0][r] *= rl[r];
    }
    LAS float* X = (LAS float*)(lds + XBUF0) + rg * 4096;
    if (mp == 1) {
#pragma unroll
        for (int d0 = 0; d0 < 4; ++d0)
#pragma unroll
            for (int r = 0; r < 16; ++r) X[(d0 * 16 + r) * 64 + lane] = o[d0][r];
    }
    __syncthreads();
    if (mp == 0) {
        float ss[16];
#pragma unroll
        for (int r = 0; r < 16; ++r) ss[r] = 0.f;
#pragma unroll
        for (int d0 = 0; d0 < 4; ++d0)
#pragma unroll
            for (int r = 0; r < 16; ++r) { const float dv = o[d0][r] - lam * X[(d0 * 16 + r) * 64 + lane]; o[d0][r] = dv; ss[r] += dv * dv; }
#pragma unroll
        for (int r = 0; r < 16; ++r) {
#pragma unroll
            for (int off = 1; off < 32; off <<= 1) ss[r] += __shfl_xor(ss[r], off);
            ss[r] = rsqrtf(ss[r] * (1.0f / 128.0f) + RMS_EPS) * 0.8f;
        }
        LAS bf16* stg = (LAS bf16*)(lds + KBUF0 + rg * 8192);
#pragma unroll
        for (int d0 = 0; d0 < 4; ++d0) { const float gg = subg[d0 * 32 + r32];
#pragma unroll
            for (int r = 0; r < 16; ++r) { const float v = o[d0][r] * ss[r] * gg; const unsigned pk = cvtpk(v, v); stg[crow(r, hi) * 128 + d0 * 32 + r32] = (bf16)(pk & 0xffffu); } }
        LDS_WAIT(); asm volatile("" ::: "memory");
        bf16* Ow = A3 + (rowbase + qmin) * D + h * 128;
#pragma unroll
        for (int i = 0; i < 8; ++i) { const int row = i * 4 + (lane >> 4), ch = lane & 15; const v4u v = *(const LAS v4u*)(stg + row * 128 + ch * 8); *(GAS v4u*)(Ow + (long)row * D + ch * 8) = v; }
    }
    __syncthreads();
}
}

#define XB_TMO      128
#define XB_XCNT(j)  (256  + 64 * (j))
#define XB_XSUB(j)  (1280 + 64 * (j))
#define XB_XGEN(j)  (2304 + 64 * (j))
#define XB_TOP      3328
#define XB_TOPGEN   3392
#define XCD_BAR_WORDS 3456
#define XB_SPIN_CAP (1u << 18)

__device__ __forceinline__ unsigned xb_ld(unsigned* p)              { return __hip_atomic_load(p, __ATOMIC_RELAXED, __HIP_MEMORY_SCOPE_AGENT); }
__device__ __forceinline__ unsigned xb_add(unsigned* p, unsigned v) { return __hip_atomic_fetch_add(p, v, __ATOMIC_RELAXED, __HIP_MEMORY_SCOPE_AGENT); }
__device__ __forceinline__ unsigned xb_xcc_id() { return (unsigned)__builtin_amdgcn_s_getreg((3 << 11) | 20) & 0xFu; }
#define XB_SPIN(cond, bar) do { unsigned _sp = 0; while (cond) { __builtin_amdgcn_s_sleep(1); \
    if ((++_sp & 255u) == 0u) { if (xb_ld(&(bar)[XB_TMO])) break; if (_sp > XB_SPIN_CAP) { atomicAdd(&(bar)[XB_TMO], 1u); break; } } } } while (0)

struct XcdBarrier { unsigned* bar; unsigned x; volatile LAS unsigned* st; };

__device__ __forceinline__ XcdBarrier xcd_barrier_post(unsigned* bar, volatile LAS unsigned* st) {
    XcdBarrier b; b.bar = bar; b.x = xb_xcc_id(); b.st = st;
    if (threadIdx.x == 0) (void)xb_add(&bar[XB_XCNT(b.x)], 1u);
    return b;
}
__device__ __forceinline__ void xcd_barrier_complete(unsigned* bar, unsigned x, unsigned& nloc, unsigned& nx) {
    const unsigned G = gridDim.x * gridDim.y * gridDim.z;
    unsigned sum, cnt, mine, sp = 0u;
    for (;;) {
        sum = 0u; cnt = 0u; mine = 0u;
#pragma unroll
        for (unsigned j = 0; j < 16; ++j) { const unsigned c = xb_ld(&bar[XB_XCNT(j)]); sum += c; cnt += (c > 0u) ? 1u : 0u; mine = (j == x) ? c : mine; }
        if (sum == G) break;
        __builtin_amdgcn_s_sleep(1);
        if ((++sp & 255u) == 0u) { if (xb_ld(&bar[XB_TMO])) break; if (sp > XB_SPIN_CAP) { atomicAdd(&bar[XB_TMO], 1u); break; } }
    }
    nloc = mine > 0u ? mine : 1u; nx = cnt > 0u ? cnt : 1u;
}
__device__ __forceinline__ void xcd_barrier(const XcdBarrier& b) {
    asm volatile("s_waitcnt vmcnt(0)" ::: "memory");
    __syncthreads();
    if (threadIdx.x == 0) {
        unsigned* bar = b.bar;
        __builtin_amdgcn_s_waitcnt(0);
        unsigned nloc = b.st[0], nx = b.st[1];
        if (nloc == 0u) { xcd_barrier_complete(bar, b.x, nloc, nx); b.st[0] = nloc; b.st[1] = nx; }
        const unsigned old = xb_add(&bar[XB_XSUB(b.x)], 1u);
        const unsigned gen = old / nloc;
        if (old + 1u == (gen + 1u) * nloc) {
            __builtin_amdgcn_fence(__ATOMIC_RELEASE, "agent");
            asm volatile("s_waitcnt vmcnt(0)" ::: "memory");
            const unsigned og = xb_add(&bar[XB_TOP], 1u);
            const unsigned tg = og / nx;
            if (og + 1u == (tg + 1u) * nx) xb_add(&bar[XB_TOPGEN], 1u);
            else XB_SPIN(xb_ld(&bar[XB_TOPGEN]) == tg, bar);
            __builtin_amdgcn_fence(__ATOMIC_ACQUIRE, "agent");
            xb_add(&bar[XB_XGEN(b.x)], 1u);
            asm volatile("s_waitcnt vmcnt(0)" ::: "memory");
        } else {
            XB_SPIN(xb_ld(&bar[XB_XGEN(b.x)]) == gen, bar);
            __builtin_amdgcn_fence(__ATOMIC_ACQUIRE, "agent");
            asm volatile("s_waitcnt vmcnt(0)" ::: "memory");
        }
    }
    __syncthreads();
}

__device__ __forceinline__ unsigned f2bf(float f) { unsigned u = __builtin_bit_cast(unsigned, f); return (u + 0x7fffu + ((u >> 16) & 1u)) >> 16; }
__device__ __forceinline__ unsigned pk2(float lo, float hi) { unsigned r; asm volatile("v_cvt_pk_bf16_f32 %0, %1, %2" : "=v"(r) : "v"(lo), "v"(hi)); return r; }
__device__ __forceinline__ float bf2f(unsigned short v) { return __uint_as_float(((unsigned)v) << 16); }
__device__ __forceinline__ float wave_sum(float v) {
#pragma unroll
    for (int o = 1; o < 64; o <<= 1) v += __shfl_xor(v, o);
    return v;
}
struct TrItem { const GAS float* src; int N; GAS bf16* dst; int ldt; const GAS float* ks; };
__device__ __forceinline__ void tr_load(const TrItem& it, f32x4 (&v)[16], f32x2 (&sc)[8], int lane) {
    const int kq = lane >> 4, nq = lane & 15;
    const GAS float* sp = it.src + (size_t)(2 * kq) * it.N + 4 * nq;
#pragma unroll
    for (int i = 0; i < 8; ++i) { v[2 * i] = *(const GAS f32x4*)(sp + (size_t)(8 * i) * it.N); v[2 * i + 1] = *(const GAS f32x4*)(sp + (size_t)(8 * i + 1) * it.N); }
    if (it.ks) {
#pragma unroll
        for (int i = 0; i < 8; ++i) sc[i] = *(const GAS f32x2*)(it.ks + 8 * i + 2 * kq);
    } else {
#pragma unroll
        for (int i = 0; i < 8; ++i) sc[i] = (f32x2){1.f, 1.f};
    }
}
__device__ __forceinline__ void tr_finish(const TrItem& it, f32x4 (&v)[16], f32x2 (&sc)[8], LAS unsigned* scr, int lane) {
    const int kq = lane >> 4, nq = lane & 15;
#pragma unroll
    for (int i = 0; i < 8; ++i)
#pragma unroll
        for (int j = 0; j < 4; ++j) scr[(4 * nq + j) * 33 + 4 * i + kq] = pk2(v[2 * i][j] * sc[i].x, v[2 * i + 1][j] * sc[i].y);
    LDS_WAIT(); asm volatile("" ::: "memory");
    const int c = lane & 7;
#pragma unroll
    for (int jj = 0; jj < 8; ++jj) { const int n = (lane >> 3) + 8 * jj; const LAS unsigned* s = scr + n * 33 + 4 * c;
        v4u o; o.x = s[0]; o.y = s[1]; o.z = s[2]; o.w = s[3];
        *(GAS v4u*)(it.dst + (size_t)n * it.ldt + 8 * c) = o; }
    LDS_WAIT(); asm volatile("" ::: "memory");
}
__device__ __forceinline__ void p0_transpose_item(const float* src, int N, bf16* dst, int ldt, const float* ks, LAS unsigned* scr, int lane) {
    asm volatile("" : "+v"(lane));
    const TrItem it{(const GAS float*)src, N, (GAS bf16*)dst, ldt, (const GAS float*)ks}; f32x4 v[16]; f32x2 sc[8]; tr_load(it, v, sc, lane); tr_finish(it, v, sc, scr, lane);
}

template <int IDX> __device__ __forceinline__ const float* ldarg_ptr() {
    auto ka = __builtin_amdgcn_kernarg_segment_ptr();
    unsigned long long v; asm volatile("s_load_dwordx2 %0, %1, %2\n\ts_waitcnt lgkmcnt(0)" : "=s"(v) : "s"(ka), "i"(IDX * 8) : "memory"); return (const float*)v;
}
struct Args { const float* in[20]; float* out; unsigned char* ws; int ph_lo, ph_hi, li, pad; };
constexpr int NPH = 9;

__global__ void __launch_bounds__(512, 2) hymba_fwd(Args args) {
    extern __shared__ __attribute__((aligned(16))) unsigned char lds_raw[];
    LAS unsigned char* lds = (LAS unsigned char*)lds_raw;
    const int tid = threadIdx.x, lane = tid & 63, wave = __builtin_amdgcn_readfirstlane(tid >> 6);
    const int G = gridDim.x; const int bx = blockIdx.x; const int vcu = (G % 8 == 0) ? (bx % 8) * (G / 8) + bx / 8 : bx;
    gu32* ctl = (gu32*)(args.ws + WS_CTL);
#define LDARG(i) ldarg_ptr<i>()
#define WSPTR(name, off) bf16* name = (bf16*)(ws + (off))
#define PHASE_WS() unsigned char* ws = args.ws; asm volatile("" : "+s"(ws)); float* out = args.out; asm volatile("" : "+s"(out)); (void)out
    volatile LAS unsigned* MISC = (volatile LAS unsigned*)(lds + MISC_OFF);
    if (tid < 4) MISC[tid] = 0u;
    __syncthreads();
    const int lo = args.ph_lo, hi_ph = args.ph_hi;
    const bool use_bar = (hi_ph - lo) > 1;
    XcdBarrier bar; bar.bar = (unsigned*)(ctl + CW_BAR); bar.x = 0; bar.st = nullptr;
    if (use_bar) bar = xcd_barrier_post((unsigned*)(ctl + CW_BAR), MISC);
#ifndef PHASE_MASK
#define PHASE_MASK 0x1FF
#endif
#define IN(k) (((PHASE_MASK >> (k)) & 1) && lo <= (k) && (k) < hi_ph)
#define BOTH(k) (IN(k) && IN((k) + 1))
#define GRID_BAR() do { xcd_barrier(bar); } while (0)
    const int gw = vcu * 8 + wave, NGW = G * 8;

    if (IN(0)) {
        PHASE_WS(); WSPTR(wfrag, WS_WFRAG); WSPTR(bt2, WS_BT2); WSPTR(win_t, WS_WIN); WSPTR(wout_t, WS_WOUT); WSPTR(wout_t2, WS_WOUT2); WSPTR(XN, WS_XN);
        const float* x = LDARG(0); const float* norm1_g = LDARG(1); const float* w_in = LDARG(2); const float* pool_w = LDARG(8); const float* pool_scale = LDARG(9); const float* w_out = LDARG(10);
        const float* norm2_g = LDARG(11); const float* w_coarse = LDARG(12); const float* w_fine = LDARG(14);
        LAS unsigned* scr = (LAS unsigned*)(lds + wave * 16384);
        constexpr int I_IN = 32 * 64, I_OUT = 32 * 32, I_OUT2 = 16 * 32;
        constexpr int NITEMS = I_IN + I_OUT + I_OUT2;
        for (int it = gw; it < NITEMS; it += NGW) {
            int r = it;
            if (r < I_IN) { const int kb = r / 64, nb = r % 64, k0 = 64 * kb, n0 = 64 * nb; p0_transpose_item(w_in + (size_t)k0 * INW + n0, INW, win_t + (size_t)n0 * D + k0, D, nullptr, scr, lane); continue; } r -= I_IN;
            if (r < I_OUT) { const int kb = r / 32, nb = r % 32, k0 = 64 * kb, n0 = 64 * nb; p0_transpose_item(w_out + (size_t)k0 * D + n0, D, wout_t + (size_t)n0 * D + k0, D, nullptr, scr, lane); continue; } r -= I_OUT;
            { const int kb = r / 32, nb = r % 32, k0 = 64 * kb, n0 = 64 * nb; p0_transpose_item(w_out + (size_t)k0 * D + n0, D, wout_t2 + (size_t)n0 * D + k0, D, nullptr, scr, lane); }
        }
        for (int i = blockIdx.x * 512 + tid; i < 4 * 256 * 256 / 4; i += G * 512) { const int e4 = (i & 63) * 4, gc = i >> 6, g = gc >> 8;
            const f32x4 w = *(const f32x4*)(pool_w + (size_t)gc * 256 + e4); const f32x4 s = *(const f32x4*)(pool_scale + g * 256 + e4);
            v2u o; o.x = pk2(w[0] * s[0], w[1] * s[1]); o.y = pk2(w[2] * s[2], w[3] * s[3]); *(v2u*)(bt2 + (size_t)gc * 256 + e4) = o; }
        for (int i = blockIdx.x * 512 + tid; i < 128 * 2 * 64; i += G * 512) { const int ln = i & 63, nt_ = (i >> 6) & 1, gs = i >> 7; const int n = ln & 31;
            unsigned hw[4], lw[4];
#pragma unroll
            for (int jp = 0; jp < 4; ++jp) { float v[2];
#pragma unroll
                for (int q = 0; q < 2; ++q) { const int k = 16 * gs + 8 * (ln >> 5) + 2 * jp + q; float w = 0.f;
                    if (nt_ == 0) w = w_fine[((size_t)(n >> 3) * D + k) * 8 + (n & 7)]; else if (n < 4) w = w_coarse[(size_t)k * 4 + n];
                    v[q] = w * norm2_g[k]; }
                const unsigned h0 = f2bf(v[0]), h1 = f2bf(v[1]); hw[jp] = h0 | (h1 << 16);
                lw[jp] = f2bf(v[0] - __uint_as_float(h0 << 16)) | (f2bf(v[1] - __uint_as_float(h1 << 16)) << 16); }
            *(v4u*)(wfrag + ((size_t)((gs * 2 + nt_) * 2 + 0) * 64 + ln) * 8) = (v4u){hw[0], hw[1], hw[2], hw[3]};
            *(v4u*)(wfrag + ((size_t)((gs * 2 + nt_) * 2 + 1) * 64 + ln) * 8) = (v4u){lw[0], lw[1], lw[2], lw[3]}; }
        for (int m = gw; m < T; m += NGW) {
            const f32x4* xr = (const f32x4*)(x + (size_t)m * D) + 2 * lane; f32x4 v[8]; float s = 0.f;
#pragma unroll
            for (int j = 0; j < 4; ++j) { v[2 * j] = xr[128 * j]; v[2 * j + 1] = xr[128 * j + 1]; }
#pragma unroll
            for (int j = 0; j < 8; ++j) s += (v[j].x * v[j].x + v[j].y * v[j].y) + (v[j].z * v[j].z + v[j].w * v[j].w);
            const float rstd = rsqrtf(wave_sum(s) * (1.f / D) + RMS_EPS);
            v4u* o16 = (v4u*)(XN + (size_t)m * D) + lane;
#pragma unroll
            for (int j = 0; j < 4; ++j) { const f32x4 g0 = ((const f32x4*)norm1_g)[2 * lane + 128 * j], g1 = ((const f32x4*)norm1_g)[2 * lane + 128 * j + 1]; const f32x4 a = v[2 * j] * rstd * g0, c = v[2 * j + 1] * rstd * g1;
                o16[64 * j] = (v4u){pk2(a.x, a.y), pk2(a.z, a.w), pk2(c.x, c.y), pk2(c.z, c.w)}; }
        }
        if (BOTH(0)) GRID_BAR();
    }

    if (IN(1)) {
        PHASE_WS(); WSPTR(win_t, WS_WIN); WSPTR(XN, WS_XN); WSPTR(Qb, WS_Q);
        { pg8::DenseOrder S; S.init(T, INW, G, bx, XN, win_t, D, D);
          pg8::EpiStoreBf16 E{Qb, AW, AW, (size_t)T * AW, C2};
          pg8::gemm_phase<pg8::EpiStoreBf16, pg8::DenseOrder, true, false>(lds, D / 64, D, D, S, E); }
        if (BOTH(1)) GRID_BAR();
    }

    if (IN(2)) {
        PHASE_WS(); WSPTR(Qb, WS_Q); WSPTR(Kb, WS_K); WSPTR(Vb, WS_V); WSPTR(Ub, WS_U); WSPTR(A3, WS_A3);
        for (int tb = vcu; tb < T / 32; tb += G) {
            const int gi = wave & 3, chg = lane & 31;
#pragma unroll 1
            for (int k = 0; k < 8; ++k) {
                const int t = tb * 32 + (wave >> 2) * 16 + 2 * k + (lane >> 5), pos = t & (SEQ - 1);
                const bf16* up = Ub + (size_t)t * AW + gi * 256 + chg * 8;
                float a[8];
#pragma unroll
                for (int j = 0; j < 8; ++j) a[j] = 0.f;
                v4u self;
#define POOL_W(W) do { v4u v_[W]; _Pragma("unroll") for (int i = 0; i < W; ++i) { const int back = (i <= pos) ? i : pos; v_[i] = *(const v4u*)(up - (size_t)back * AW); } self = v_[0]; \
                    _Pragma("unroll") for (int i = 0; i < W; ++i) { const float wgt = (i <= pos) ? 1.f : 0.f; _Pragma("unroll") for (int j = 0; j < 4; ++j) { a[2 * j] += wgt * __uint_as_float(v_[i][j] << 16); a[2 * j + 1] += wgt * __uint_as_float(v_[i][j] & 0xffff0000u); } } } while (0)
                if (gi == 0) POOL_W(2); else if (gi == 1) POOL_W(4); else if (gi == 2) POOL_W(8); else POOL_W(16);
#undef POOL_W
                const int w = 2 << gi; const int cw = (pos + 1 < w) ? pos + 1 : w;
                const float inv = 1.0f / (float)cw; v4u o;
#pragma unroll
                for (int j = 0; j < 4; ++j) { const float s0 = __uint_as_float(self[j] << 16), s1 = __uint_as_float(self[j] & 0xffff0000u); o[j] = pk2(a[2 * j] * inv - s0, a[2 * j + 1] * inv - s1); }
                *(v4u*)(A3 + (size_t)t * D + AW + gi * 256 + chg * 8) = o; }
        }
        { WSPTR(bt2, WS_BT2); WSPTR(wout_t, WS_WOUT); WSPTR(wout_t2, WS_WOUT2);
          pg8::W2Order S{G, bx, (const char*)wout_t, (const char*)bt2};
          pg8::EpiStoreBf16 E{wout_t2, D, 0, 0, 1.f};
          int nt_w2 = 256 / 64; asm volatile("" : "+s"(nt_w2));
          pg8::gemm_phase<pg8::EpiStoreBf16, pg8::W2Order, true, false>(lds, nt_w2, D, 256, S, E);
          __syncthreads(); }
        const float* lq1 = LDARG(3); const float* lk1 = LDARG(4); const float* lq2 = LDARG(5); const float* lk2 = LDARG(6); const float* subln_g = LDARG(7);
        float lam;
        { const float p1 = wave_sum(lq1[lane] * lk1[lane]), p2 = wave_sum(lq2[lane] * lk2[lane]); lam = expf(p1) - expf(p2) + 0.2f; }
        LAS float* wsf = (LAS float*)(lds + WSF_OFF);
        {
            volatile LAS int* qslot = (volatile LAS int*)(lds + MISC_OFF + 32);
            LAS unsigned* scr = (LAS unsigned*)(lds + wave * 16384);
            const bool prefer_cvt = (vcu & 15) < 7;
#ifdef PROBE_TIME
            if (tid == 0) { volatile LAS unsigned* pa_ = (volatile LAS unsigned*)(lds + MISC_OFF + 64); pa_[0] = 0u; pa_[1] = 0u; pa_[2] = 0u; pa_[3] = 0u; }
            __syncthreads();
            const unsigned long long pq0_ = __builtin_amdgcn_s_memrealtime();
#endif
            bool att_left = true, cvt_left = true;
            constexpr int CVT_CH = 32, NCH = 24576 / CVT_CH, I_GU = 2 * 32 * 8 * 32;
            const int xq = (int)(xb_xcc_id() & 7u); int qoff = 0;
            for (;;) {
                int kind = -1, idx = 0, aq = 0;
#pragma unroll 1
                for (int pass = 0; pass < 2 && kind < 0; ++pass) {
                    const bool try_cvt = (pass == 0) ? prefer_cvt : !prefer_cvt;
                    if (try_cvt) {
                        if (cvt_left) {
                            if (tid == 0) qslot[0] = (int)__hip_atomic_fetch_add((unsigned*)(ctl + CW_QCVT), 1u, RLX_AGENT);
                            __syncthreads(); idx = qslot[0]; __syncthreads();
                            if (idx < NCH) kind = 1; else cvt_left = false;
                        }
                    } else {
                        while (att_left && kind < 0) {
                            aq = (xq + qoff) & 7;
                            if (tid == 0) qslot[0] = (int)__hip_atomic_fetch_add((unsigned*)(ctl + CW_QATT + 64 * aq), 1u, RLX_AGENT);
                            __syncthreads(); idx = qslot[0]; __syncthreads();
                            if (idx < 64) kind = 0; else { ++qoff; if (qoff == 8) att_left = false; }
                        }
                    }
                }
                if (kind < 0) break;
                if (kind == 1) {
                    const float* norm2_g = LDARG(11); const float* w_gate = LDARG(16); const float* w_up = LDARG(17); const float* w_down = LDARG(18);
                    unsigned char* ws2 = args.ws; asm volatile("" : "+s"(ws2)); bf16* wgu_t = (bf16*)(ws2 + WS_WGU); bf16* wd_t = (bf16*)(ws2 + WS_WD);
                    int lane2 = lane; asm volatile("" : "+v"(lane2));
#define CVT_ITEM(IT, rr) do { int r = (rr); if (r < I_GU) { const bool up = r >= I_GU / 2; if (up) r -= I_GU / 2; const int e = r / 256, q = r % 256, kb = q / 8, nb = q % 8, k0 = 64 * kb, n0 = 64 * nb; \
                            const float* W = (up ? w_up : w_gate) + (size_t)e * D * FF; const int drow = (n0 >> 7) * 256 + (up ? 128 : 0) + (n0 & 127); \
                            IT = TrItem{(const GAS float*)(W + (size_t)k0 * FF + n0), FF, (GAS bf16*)(wgu_t + ((size_t)e * 1024 + drow) * D + k0), D, (const GAS float*)(norm2_g + k0)}; } \
                        else { r -= I_GU; const int e = r / 256, q = r % 256, kb = q / 32, nb = q % 32, k0 = 64 * kb, n0 = 64 * nb; \
                            IT = TrItem{(const GAS float*)(w_down + (size_t)e * FF * D + (size_t)k0 * D + n0), D, (GAS bf16*)(wd_t + ((size_t)e * D + n0) * FF + k0), FF, (const GAS float*)nullptr}; } } while (0)
                    const int r0 = idx * CVT_CH + wave * (CVT_CH / 8);
                    TrItem ia, ib; f32x4 va[16], vb2[16]; f32x2 sa[8], sb[8];
                    CVT_ITEM(ia, r0); tr_load(ia, va, sa, lane2);
#pragma unroll 1
                    for (int i = 0; i < CVT_CH / 8; i += 2) {
                        CVT_ITEM(ib, r0 + i + 1); tr_load(ib, vb2, sb, lane2);
                        tr_finish(ia, va, sa, scr, lane2);
                        if (i + 2 < CVT_CH / 8) { CVT_ITEM(ia, r0 + i + 2); tr_load(ia, va, sa, lane2); }
                        tr_finish(ib, vb2, sb, scr, lane2);
                    }
#undef CVT_ITEM
                } else {
                    const int qb = 15 - (idx & 15), bh = aq + 8 * (idx >> 4);
#ifdef PROBE_TIME
                    const unsigned long long pu0_ = __builtin_amdgcn_s_memrealtime();
#endif
                    att::attn_unit(bh >> 3, bh & 7, qb, Qb, Kb, Vb, A3, subln_g, lam, lds, wsf);
#ifdef PROBE_TIME
                    if (tid == 0) { volatile LAS unsigned* pa_ = (volatile LAS unsigned*)(lds + MISC_OFF + 64); pa_[2] += (unsigned)(__builtin_amdgcn_s_memrealtime() - pu0_); pa_[3] += 1u; }
#endif
                }
            }
#ifdef PROBE_TIME
            __syncthreads();
            if (bx == 16) { volatile LAS unsigned* pa_ = (volatile LAS unsigned*)(lds + MISC_OFF + 64);
                const unsigned long long now_ = __builtin_amdgcn_s_memrealtime();
                unsigned long long q_ = (PROBE_TIME == 1) ? pa_[0] : (PROBE_TIME == 2) ? pa_[2] : (PROBE_TIME == 3) ? (unsigned)(now_ - pq0_) : (PROBE_TIME == 4) ? pa_[1] * 100ull : pa_[3] * 1000ull;
                const unsigned long long until_ = now_ + 3ull * q_;
                while (__builtin_amdgcn_s_memrealtime() < until_) __builtin_amdgcn_s_sleep(8); }
#endif
        }
        if (BOTH(2)) GRID_BAR();
    }

    if (IN(3)) {
        PHASE_WS(); WSPTR(wout_t2, WS_WOUT2); WSPTR(A3, WS_A3); WSPTR(rb, WS_RB);
        pg8::DenseOrder S; S.init(T, D, G, bx, A3, wout_t2, D, D);
        pg8::EpiStoreBf16 E{rb, D, 0, 0, 1.f};
        pg8::gemm_phase<pg8::EpiStoreBf16, pg8::DenseOrder, true, false>(lds, D / 64, D, D, S, E);
        if (BOTH(3)) GRID_BAR();
    }

    if (IN(4)) {
        PHASE_WS(); WSPTR(wfrag, WS_WFRAG); WSPTR(rb, WS_RB); WSPTR(hb, WS_HB); unsigned* tokl = (unsigned*)(ws + WS_TOK); f32x2* swl = (f32x2*)(ws + WS_SW);
        const float* x = LDARG(0); const float* norm2_g = LDARG(11); const float* b_coarse = LDARG(13); const float* b_fine = LDARG(15);
        LAS float* part = (LAS float*)lds;
        LAS float* ssqs = (LAS float*)(lds + 73728);
        LAS float* logit = (LAS float*)(lds + 73728 + 1024);
        const int r32 = lane & 31, hi = lane >> 5, rsub = lane >> 4, cg = lane & 15;
        LAS unsigned char* stg = lds + wave * 9216;
        const __amdgpu_buffer_rsrc_t rsx = __builtin_amdgcn_make_buffer_rsrc((void*)x, 0, T * D * 4, 0x00020000);
        const __amdgpu_buffer_rsrc_t rsr = __builtin_amdgcn_make_buffer_rsrc((void*)rb, 0, T * D * 2, 0x00020000);
        const __amdgpu_buffer_rsrc_t rsh = __builtin_amdgcn_make_buffer_rsrc((void*)hb, 0, T * D * 2, 0x00020000);
        for (int rblk = vcu; rblk < T / 32; rblk += G) {
            const int R0 = rblk * 32;
            const unsigned vo4 = (unsigned)(rsub * D + 4 * cg) * 4u, vo2 = (unsigned)(rsub * D + 4 * cg) * 2u; const unsigned so0 = (unsigned)(R0 * D + wave * 256);
            f32x16 acc0, acc1;
#pragma unroll
            for (int r = 0; r < 16; ++r) { acc0[r] = 0.f; acc1[r] = 0.f; }
            float sq[8];
#pragma unroll
            for (int j = 0; j < 8; ++j) sq[j] = 0.f;
            f32x4 xa[8]; v2u ra[8];
#define P4_LOAD(XV, RV, c) do { _Pragma("unroll") for (int j = 0; j < 8; ++j) { const unsigned so_ = so0 + (unsigned)(4 * j * D + 64 * (c)); \
                XV[j] = __builtin_bit_cast(f32x4, __builtin_amdgcn_raw_buffer_load_b128(rsx, vo4, so_ * 4u, 0)); RV[j] = __builtin_amdgcn_raw_buffer_load_b64(rsr, vo2, so_ * 2u, 0); } } while (0)
#define P4_CHUNK(XV, RV, c, NEXT) do { \
                bf16x8 wfr[4][4]; \
                _Pragma("unroll") for (int s_ = 0; s_ < 4; ++s_) { const bf16x8* wf_ = (const bf16x8*)wfrag + (size_t)(wave * 16 + 4 * (c) + s_) * 256 + lane; wfr[s_][0] = wf_[0]; wfr[s_][1] = wf_[64]; wfr[s_][2] = wf_[128]; wfr[s_][3] = wf_[192]; } \
                _Pragma("unroll") for (int j = 0; j < 8; ++j) { f32x4 h4 = XV[j]; \
                    h4.x += __uint_as_float(RV[j].x << 16); h4.y += __uint_as_float(RV[j].x & 0xffff0000u); h4.z += __uint_as_float(RV[j].y << 16); h4.w += __uint_as_float(RV[j].y & 0xffff0000u); \
                    sq[j] += (h4.x * h4.x + h4.y * h4.y) + (h4.z * h4.z + h4.w * h4.w); \
                    const unsigned h01 = pk2(h4.x, h4.y), h23 = pk2(h4.z, h4.w); \
                    __builtin_amdgcn_raw_buffer_store_b64((v2u){h01, h23}, rsh, vo2, (so0 + (unsigned)(4 * j * D + 64 * (c))) * 2u, 0); \
                    const unsigned l01 = pk2(h4.x - __uint_as_float(h01 << 16), h4.y - __uint_as_float(h01 & 0xffff0000u)), l23 = pk2(h4.z - __uint_as_float(h23 << 16), h4.w - __uint_as_float(h23 & 0xffff0000u)); \
                    *(LAS v2u*)(stg + (4 * j + rsub) * 144 + cg * 8) = (v2u){h01, h23}; *(LAS v2u*)(stg + 4608 + (4 * j + rsub) * 144 + cg * 8) = (v2u){l01, l23}; } \
                if (NEXT) { P4_LOAD(XV, RV, (c) + 1); } \
                LDS_WAIT(); asm volatile("" ::: "memory"); \
                _Pragma("unroll") for (int s_ = 0; s_ < 4; ++s_) { \
                    const bf16x8 ah = *(const LAS bf16x8*)(stg + r32 * 144 + s_ * 32 + hi * 16), al = *(const LAS bf16x8*)(stg + 4608 + r32 * 144 + s_ * 32 + hi * 16); \
                    acc0 = __builtin_amdgcn_mfma_f32_32x32x16_bf16(ah, wfr[s_][0], acc0, 0, 0, 0); acc0 = __builtin_amdgcn_mfma_f32_32x32x16_bf16(al, wfr[s_][0], acc0, 0, 0, 0); acc0 = __builtin_amdgcn_mfma_f32_32x32x16_bf16(ah, wfr[s_][1], acc0, 0, 0, 0); \
                    acc1 = __builtin_amdgcn_mfma_f32_32x32x16_bf16(ah, wfr[s_][2], acc1, 0, 0, 0); acc1 = __builtin_amdgcn_mfma_f32_32x32x16_bf16(al, wfr[s_][2], acc1, 0, 0, 0); acc1 = __builtin_amdgcn_mfma_f32_32x32x16_bf16(ah, wfr[s_][3], acc1, 0, 0, 0); } \
                LDS_WAIT(); asm volatile("" ::: "memory"); __builtin_amdgcn_sched_barrier(0); } while (0)
            P4_LOAD(xa, ra, 0);
#pragma unroll 1
            for (int c = 0; c < 4; ++c) P4_CHUNK(xa, ra, c, c < 3);
#undef P4_LOAD
#undef P4_CHUNK
#pragma unroll
            for (int j = 0; j < 8; ++j) {
#pragma unroll
                for (int off = 1; off < 16; off <<= 1) sq[j] += __shfl_xor(sq[j], off);
            }
            __syncthreads();
#pragma unroll
            for (int r = 0; r < 16; ++r) { part[((wave * 2 + 0) * 16 + r) * 64 + lane] = acc0[r]; part[((wave * 2 + 1) * 16 + r) * 64 + lane] = acc1[r]; }
            if (cg == 0) {
#pragma unroll
                for (int j = 0; j < 8; ++j) ssqs[wave * 32 + 4 * j + rsub] = sq[j]; }
            __syncthreads();
#pragma unroll
            for (int q = 0; q < 4; ++q) { const int idx = tid + 512 * q; float sm = 0.f;
#pragma unroll
                for (int w = 0; w < 8; ++w) sm += part[w * 2048 + idx];
                const int nt_ = idx >> 10, r = (idx >> 6) & 15, ln = idx & 63; const int row = att::crow(r, ln >> 5), n = nt_ * 32 + (ln & 31);
                logit[row * 64 + n] = sm; }
            __syncthreads();
            if (tid < 32) {
                const int row = tid, token = R0 + row; float ss = 0.f;
#pragma unroll
                for (int w = 0; w < 8; ++w) ss += ssqs[w * 32 + row];
                const float rs = rsqrtf(ss * (1.f / D) + RMS_EPS);
                const LAS float* lg = logit + row * 64;
                float c[4];
#pragma unroll
                for (int k = 0; k < 4; ++k) c[k] = lg[32 + k] * rs + b_coarse[k];
                float cb = c[0]; int g = 0;
#pragma unroll
                for (int k = 1; k < 4; ++k) if (c[k] > cb) { cb = c[k]; g = k; }
                float den = 0.f;
#pragma unroll
                for (int k = 0; k < 4; ++k) den += expf(c[k] - cb);
                const float pg = 1.0f / den;
                float f[8];
#pragma unroll
                for (int k = 0; k < 8; ++k) f[k] = lg[g * 8 + k] * rs + b_fine[g * 8 + k];
                float v0 = f[0]; int i0 = 0;
#pragma unroll
                for (int k = 1; k < 8; ++k) if (f[k] > v0) { v0 = f[k]; i0 = k; }
                float v1 = -INFINITY; int i1 = 0;
#pragma unroll
                for (int k = 0; k < 8; ++k) if (k != i0 && f[k] > v1) { v1 = f[k]; i1 = k; }
                const float ex = expf(v1 - v0); const float w0 = pg / (1.0f + ex), w1 = pg * ex / (1.0f + ex);
                const int e0 = g * 8 + i0, e1 = g * 8 + i1;
                const unsigned s0 = __hip_atomic_fetch_add((unsigned*)(ctl + CW_CNT + 64 * e0), 1u, RLX_AGENT);
                const unsigned s1 = __hip_atomic_fetch_add((unsigned*)(ctl + CW_CNT + 64 * e1), 1u, RLX_AGENT);
                tokl[(size_t)e0 * 8192 + s0] = (unsigned)token; swl[(size_t)e0 * 8192 + s0] = (f32x2){rs, w0};
                tokl[(size_t)e1 * 8192 + s1] = (unsigned)token | 0x10000u; swl[(size_t)e1 * 8192 + s1] = (f32x2){rs, w1};
            }
        }
        __syncthreads();
        if (BOTH(4)) GRID_BAR();
    }

    if (IN(5) || IN(6) || IN(7)) {
        PHASE_WS(); WSPTR(hb, WS_HB); WSPTR(wgu_t, WS_WGU); WSPTR(wd_t, WS_WD); WSPTR(hmid, WS_HMID); WSPTR(yb, WS_Y); unsigned* tokl = (unsigned*)(ws + WS_TOK); f32x2* swl = (f32x2*)(ws + WS_SW);
        LAS int* tab = (LAS int*)(lds + TAB_OFF);
        if (tid < 32) tab[40 + tid] = (int)__hip_atomic_load((unsigned*)(ctl + CW_CNT + 64 * tid), RLX_AGENT);
        __syncthreads();
        if (tid == 0) { int acc = 0; for (int e = 0; e < 32; ++e) { tab[e] = acc; acc += (tab[40 + e] + 255) >> 8; } tab[32] = acc; }
        __syncthreads();
        const int NTt = __builtin_amdgcn_readfirstlane(tab[32]); const int T0 = NTt < 64 ? NTt : 64;
        int nb = (NTt - T0) * 4; if (nb > G / 2) nb = G / 2;
        if (IN(5)) {
            pg8::MoeOrder<4, true> S{0, G, vcu, 0, T0, tab, (const char*)hb, (const char*)wgu_t, tokl};
            pg8::EpiGateUp E{hmid, swl};
            pg8::gemm_phase<pg8::EpiGateUp, pg8::MoeOrder<4, true>, true, true>(lds, D / 64, D, D, S, E);
            if (BOTH(5)) GRID_BAR();
        }
        if (IN(6)) {
            { pg8::MoeOrder<4, true> S{0, nb, vcu, T0, NTt, tab, (const char*)hb, (const char*)wgu_t, tokl};
              pg8::EpiGateUp E{hmid, swl};
              pg8::gemm_phase<pg8::EpiGateUp, pg8::MoeOrder<4, true>, true, true>(lds, D / 64, D, D, S, E); }
            { pg8::MoeOrder<8, false> S{nb, G - nb, vcu, 0, T0, tab, (const char*)hmid, (const char*)wd_t, tokl};
              pg8::EpiDown E{yb, tokl};
              pg8::gemm_phase<pg8::EpiDown, pg8::MoeOrder<8, false>, true, false>(lds, FF / 64, FF, FF, S, E); }
            if (BOTH(6)) GRID_BAR();
        }
        if (IN(7)) {
            pg8::MoeOrder<8, false> S{0, G, vcu, T0, NTt, tab, (const char*)hmid, (const char*)wd_t, tokl};
            pg8::EpiDown E{yb, tokl};
            pg8::gemm_phase<pg8::EpiDown, pg8::MoeOrder<8, false>, true, false>(lds, FF / 64, FF, FF, S, E);
            if (BOTH(7)) GRID_BAR();
        }
    }

    if (IN(8)) {
        PHASE_WS(); WSPTR(yb, WS_Y); WSPTR(hb, WS_HB);
        const float* final_g = LDARG(19);
        for (int m = gw; m < T; m += NGW) {
            f32x4* orow = (f32x4*)(out + (size_t)m * D) + 2 * lane; f32x4 v[8]; float s = 0.f;
            const v4u* y0 = (const v4u*)(yb + (size_t)m * D) + lane; const v4u* y1 = (const v4u*)(yb + ((size_t)T + m) * D) + lane; const v4u* r0 = (const v4u*)(hb + (size_t)m * D) + lane;
#pragma unroll
            for (int j = 0; j < 4; ++j) { const v4u a = y0[64 * j], b = y1[64 * j], c = r0[64 * j];
                v[2 * j].x = __uint_as_float(a.x << 16) + __uint_as_float(b.x << 16) + __uint_as_float(c.x << 16); v[2 * j].y = __uint_as_float(a.x & 0xffff0000u) + __uint_as_float(b.x & 0xffff0000u) + __uint_as_float(c.x & 0xffff0000u);
                v[2 * j].z = __uint_as_float(a.y << 16) + __uint_as_float(b.y << 16) + __uint_as_float(c.y << 16); v[2 * j].w = __uint_as_float(a.y & 0xffff0000u) + __uint_as_float(b.y & 0xffff0000u) + __uint_as_float(c.y & 0xffff0000u);
                v[2 * j + 1].x = __uint_as_float(a.z << 16) + __uint_as_float(b.z << 16) + __uint_as_float(c.z << 16); v[2 * j + 1].y = __uint_as_float(a.z & 0xffff0000u) + __uint_as_float(b.z & 0xffff0000u) + __uint_as_float(c.z & 0xffff0000u);
                v[2 * j + 1].z = __uint_as_float(a.w << 16) + __uint_as_float(b.w << 16) + __uint_as_float(c.w << 16); v[2 * j + 1].w = __uint_as_float(a.w & 0xffff0000u) + __uint_as_float(b.w & 0xffff0000u) + __uint_as_float(c.w & 0xffff0000u); }
#pragma unroll
            for (int j = 0; j < 8; ++j) s += (v[j].x * v[j].x + v[j].y * v[j].y) + (v[j].z * v[j].z + v[j].w * v[j].w);
            const float rstd = rsqrtf(wave_sum(s) * (1.f / D) + RMS_EPS);
#pragma unroll
            for (int j = 0; j < 4; ++j) { const f32x4 g0 = ((const f32x4*)final_g)[2 * lane + 128 * j], g1 = ((const f32x4*)final_g)[2 * lane + 128 * j + 1]; orow[128 * j] = v[2 * j] * rstd * g0; orow[128 * j + 1] = v[2 * j + 1] * rstd * g1; }
        }
    }
#undef IN
#undef BOTH
#undef GRID_BAR
}

extern "C" void kernel_launch(void* const* d_in, const int* in_sizes, int n_in, void* d_out, int out_size, void* d_ws, size_t ws_size, hipStream_t stream) {
    static int grid = 0;
    if (grid == 0) {
        if (n_in != 20 || out_size != T * D || ws_size < WS_END) { fprintf(stderr, "kernel_launch: unexpected shapes (n_in %d out %d ws %zu)\n", n_in, out_size, ws_size); grid = -1; return; }
        int dev = 0, cus = 0, per_cu = 0;
        if (hipGetDevice(&dev) != hipSuccess || hipDeviceGetAttribute(&cus, hipDeviceAttributeMultiprocessorCount, dev) != hipSuccess) { grid = -1; return; }
        if (hipFuncSetAttribute((const void*)hymba_fwd, hipFuncAttributeMaxDynamicSharedMemorySize, LDS_BYTES) != hipSuccess) { fprintf(stderr, "kernel_launch: hipFuncSetAttribute failed\n"); grid = -1; return; }
        if (hipOccupancyMaxActiveBlocksPerMultiprocessor(&per_cu, (const void*)hymba_fwd, 512, LDS_BYTES) != hipSuccess || per_cu < 1) fprintf(stderr, "kernel_launch: occupancy query reports %d\n", per_cu);
        (void)hipGetLastError();
        grid = cus;
    }
    if (grid < 0) return;
    (void)hipMemsetAsync((char*)d_ws + WS_CTL, 0, CTL_ZERO_BYTES, stream);
    Args a{};
    for (int i = 0; i < 20; ++i) a.in[i] = (const float*)d_in[i];
    a.out = (float*)d_out; a.ws = (unsigned char*)d_ws;
    if (MK_N_LAUNCHES == 1) { a.ph_lo = 0; a.ph_hi = NPH; a.li = 0; hipLaunchKernelGGL(hymba_fwd, dim3(grid), dim3(512), LDS_BYTES, stream, a); }
    else { for (int p = 0; p < NPH; ++p) { a.ph_lo = p; a.ph_hi = p + 1; a.li = p; hipLaunchKernelGGL(hymba_fwd, dim3(grid), dim3(512), LDS_BYTES, stream, a);
            if (p == PROBE_DUP) { if (p == 4) (void)hipMemsetAsync((char*)d_ws + WS_CTL, 0, CTL_ZERO_BYTES, stream); if (p == 2) (void)hipMemsetAsync((char*)d_ws + WS_CTL + CW_QATT * 4, 0, 8 * 256, stream); hipLaunchKernelGGL(hymba_fwd, dim3(grid), dim3(512), LDS_BYTES, stream, a); } } }
}
```

```cpp
#include <hip/hip_runtime.h>
#include <hip/hip_bf16.h>
#include <cstdio>
#include <cstdint>

#ifndef MK_N_LAUNCHES
#define MK_N_LAUNCHES 1
#endif
#ifndef PROBE_DUP
#define PROBE_DUP -1
#endif

#define GAS __attribute__((address_space(1)))
#define LAS __attribute__((address_space(3)))
typedef unsigned short bf16;
typedef unsigned v4u __attribute__((ext_vector_type(4)));
typedef unsigned v2u __attribute__((ext_vector_type(2)));
typedef float f32x4 __attribute__((ext_vector_type(4)));
typedef float f32x2 __attribute__((ext_vector_type(2)));
typedef float f32x16 __attribute__((ext_vector_type(16)));
typedef short bf16x8 __attribute__((ext_vector_type(8)));
typedef short s16x4 __attribute__((ext_vector_type(4)));
typedef GAS unsigned gu32;
#define RLX_AGENT __ATOMIC_RELAXED, __HIP_MEMORY_SCOPE_AGENT
#define LDS_WAIT() asm volatile("s_waitcnt lgkmcnt(0)" ::: "memory")
#define VM_WAIT() asm volatile("s_waitcnt vmcnt(0)" ::: "memory")

constexpr int T = 8192, SEQ = 2048, D = 2048, INW = 4096, AW = 1024, NH = 8, NE = 32, FF = 512;
constexpr float RMS_EPS = 1e-6f;
constexpr float LOG2E = 1.4426950408889634f;
constexpr float C2 = 0.125f * LOG2E;

constexpr size_t MiB = 1u << 20;
constexpr size_t WS_CTL = 0, CTL_ZERO_BYTES = 32768;
constexpr size_t WS_WFRAG = 1 * MiB;
constexpr size_t WS_BT2 = 1 * MiB + 512 * 1024;
constexpr size_t WS_WIN = 2 * MiB;
constexpr size_t WS_WOUT = 18 * MiB;
constexpr size_t WS_WOUT2 = 26 * MiB;
constexpr size_t WS_TOK = 34 * MiB;
constexpr size_t WS_SW = 35 * MiB;
constexpr size_t WS_WGU = 40 * MiB;
constexpr size_t WS_WD = 168 * MiB;
constexpr size_t WS_XN = 232 * MiB;
constexpr size_t WS_HMID = 232 * MiB;
constexpr size_t WS_Q = 264 * MiB, WS_K = 280 * MiB, WS_V = 296 * MiB, WS_U = 312 * MiB;
constexpr size_t WS_Y = 264 * MiB;
constexpr size_t WS_A3 = 328 * MiB;
constexpr size_t WS_HB = 360 * MiB;
constexpr size_t WS_RB = 392 * MiB;
constexpr size_t WS_END = 424 * MiB;
constexpr int CW_CNT = 1024;
constexpr int CW_QATT = 3072, CW_QCVT = 3584;
constexpr int CW_BAR = 4096;

constexpr int RING_BYTES = 131072;
constexpr int WSF_OFF = RING_BYTES;
constexpr int TAB_OFF = WSF_OFF + 2048;
constexpr int MISC_OFF = TAB_OFF + 512;
constexpr int LDS_BYTES = 147456;

namespace pg8 {
#define PG8_LAS __attribute__((address_space(3)))
typedef unsigned short bf16_t;
typedef unsigned u32x4 __attribute__((ext_vector_type(4)));
constexpr int BM = 256, BK = 64, HALF = 128, HTB = HALF * BK * 2, STAGE_BYTES = 8 * HTB, NXCD = 8, WGM = 8;

__host__ __device__ __forceinline__ int lds_byte(int r, int c) { const int st = (r >> 4) * 2 + (c >> 5), rr = r & 15, cc = c & 31, ob = rr * 64 + cc * 2; return st * 1024 + (ob ^ (((ob >> 9) & 1) << 5)); }
__host__ __device__ __forceinline__ void stage_rc(int b, int& R, int& C) { const int st = b / 1024, sb = b % 1024, swz = sb ^ (((sb >> 9) & 1) << 5); R = (st >> 1) * 16 + swz / 64; C = (st & 1) * 32 + (swz % 64) / 2; }
__host__ __device__ __forceinline__ int perm32(int rho) { const int n = rho >> 4, i = rho & 15; return 8 * (i >> 2) + 4 * n + (i & 3); }

struct Unit { const char* a; const char* b; int orow, ocol, e, s0, cnt; };

__device__ __forceinline__ unsigned cvt_pk_bf16(float lo, float hi) { unsigned r; asm volatile("v_cvt_pk_bf16_f32 %0, %1, %2" : "=v"(r) : "v"(lo), "v"(hi)); return r; }

struct DenseOrder {
    int nM, nN, nwg, G, c; const char* A; const char* Bt; size_t tsA, tsB;
    __device__ void init(int M, int N, int G_, int c_, const void* A_, const void* Bt_, int lda, int ldb) { nM = M / BM; nN = N / BM; nwg = nM * nN; G = G_; c = c_; A = (const char*)A_; Bt = (const char*)Bt_; tsA = (size_t)BM * lda * 2; tsB = (size_t)BM * ldb * 2; }
    __device__ bool next(int i, Unit& u) const {
        const long L = (long)i * G + c; if (L >= nwg) return false;
        int wgid = (int)L; { const int q = nwg / NXCD, r = nwg % NXCD, xcd = wgid % NXCD, off = wgid / NXCD; wgid = (xcd < r ? xcd * (q + 1) : r * (q + 1) + (xcd - r) * q) + off; }
        const int nig = WGM * nN, gid = wgid / nig, fm = gid * WGM, gsz = (nM - fm) < WGM ? (nM - fm) : WGM;
        const int pm = fm + ((wgid % nig) % gsz), pn = (wgid % nig) / gsz;
        u.a = A + (size_t)pm * tsA; u.b = Bt + (size_t)pn * tsB; u.orow = pm * BM; u.ocol = pn * BM; u.e = 0; u.s0 = 0; u.cnt = 0; return true;
    }
    __device__ __forceinline__ unsigned row_off(const Unit&, int) const { return 0u; }
};

template <class Epi, class Sched, bool ALIGN_EPI, bool GATHER>
__device__ __forceinline__ void gemm_phase(PG8_LAS unsigned char* lds, const int nt, const int lda, const int ldb, const Sched& S, const Epi& E) {
    const int tid = threadIdx.x, wid = __builtin_amdgcn_readfirstlane(tid >> 6), lane = tid & 63, wr = wid >> 2, wc = wid & 3, fr = lane & 15, fq = lane >> 4;
    unsigned voffA[2], voffB[2]; int rA[2]; unsigned cA2[2];
#pragma unroll
    for (int i = 0; i < 2; ++i) { int R, C; stage_rc(tid * 16 + i * 8192, R, C); const int Rb = Epi::PERM ? ((R & ~31) + perm32(R & 31)) : R;
        voffA[i] = (unsigned)(R * lda + C) * 2u; voffB[i] = (unsigned)(Rb * ldb + C) * 2u; rA[i] = R; cA2[i] = (unsigned)C * 2u; }
    const size_t kstep = (size_t)(BK * 2);
    const size_t hstepA = (size_t)HALF * lda * 2, hstepB = (size_t)HALF * ldb * 2;
    const unsigned ldsw = (unsigned)wid * 1024u;
    const int aoff = lds_byte(wr * 64 + fr, fq * 8), boff = lds_byte(wc * 32 + fr, fq * 8);
#define PG8_SA(b, h) (((b) * 2 + (h)) * HTB)
#define PG8_SB(b, h) ((4 + (b) * 2 + (h)) * HTB)
#define PG8_STAGE_O(bufoff, gbase, o0, o1) do { \
        __builtin_amdgcn_global_load_lds((const unsigned*)((const char*)(gbase) + (o0)), (PG8_LAS unsigned*)(lds + (bufoff) + ldsw), 16, 0, 0); \
        __builtin_amdgcn_global_load_lds((const unsigned*)((const char*)(gbase) + (o1)), (PG8_LAS unsigned*)(lds + (bufoff) + ldsw + 8192), 16, 0, 0); } while (0)
#define PG8_STB(b, h, bptr) PG8_STAGE_O(PG8_SB(b, h), (bptr) + (h) * hstepB, voffB[0], voffB[1])
#define PG8_STA(b, h, aptr, O) do { if constexpr (GATHER) { PG8_STAGE_O(PG8_SA(b, h), (aptr), O[h][0], O[h][1]); } else { PG8_STAGE_O(PG8_SA(b, h), (aptr) + (h) * hstepA, voffA[0], voffA[1]); } } while (0)
#define PG8_LDA(dst, b, h) do { _Pragma("unroll") for (int m = 0; m < 4; ++m) _Pragma("unroll") for (int k = 0; k < 2; ++k) dst[m][k] = *(const PG8_LAS bf16x8*)(lds + PG8_SA(b, h) + aoff + m * 2048 + k * 1024); } while (0)
#define PG8_LDB(dst, b, h) do { _Pragma("unroll") for (int n = 0; n < 2; ++n) _Pragma("unroll") for (int k = 0; k < 2; ++k) dst[n][k] = *(const PG8_LAS bf16x8*)(lds + PG8_SB(b, h) + boff + n * 2048 + k * 1024); } while (0)
#define PG8_MMA(ai, bj, At, Bt) do { __builtin_amdgcn_s_setprio(1); _Pragma("unroll") for (int m = 0; m < 4; ++m) _Pragma("unroll") for (int n = 0; n < 2; ++n) _Pragma("unroll") for (int k = 0; k < 2; ++k) \
        acc[ai][bj][m][n] = __builtin_amdgcn_mfma_f32_16x16x32_bf16(Bt[n][k], At[m][k], acc[ai][bj][m][n], 0, 0, 0); __builtin_amdgcn_s_setprio(0); } while (0)
#define PG8_WAIT_V(n) asm volatile("s_waitcnt vmcnt(" #n ")" ::: "memory")
#define PG8_WAIT_L(n) asm volatile("s_waitcnt lgkmcnt(" #n ")" ::: "memory")
#define PG8_BAR __builtin_amdgcn_s_barrier()
#define PG8_SCHED __builtin_amdgcn_sched_barrier(0)
#define PG8_FETCH(u, O) do { _Pragma("unroll") for (int h_ = 0; h_ < 2; ++h_) _Pragma("unroll") for (int i_ = 0; i_ < 2; ++i_) O[h_][i_] = S.row_off(u, h_ * HALF + rA[i_]) + cA2[i_]; } while (0)
    Unit cur, nxt; int ui = 0;
    if (!S.next(0, cur)) return;
    f32x4 acc[2][2][4][2];
#pragma unroll
    for (int a = 0; a < 2; ++a)
#pragma unroll
        for (int b = 0; b < 2; ++b)
#pragma unroll
            for (int m = 0; m < 4; ++m)
#pragma unroll
                for (int n = 0; n < 2; ++n) acc[a][b][m][n] = (f32x4){0.f, 0.f, 0.f, 0.f};
    bf16x8 At[4][2], B0[2][2], B1[2][2];
    unsigned oC[2][2] = {{0u, 0u}, {0u, 0u}}, oN[2][2] = {{0u, 0u}, {0u, 0u}}, o2[2][2] = {{0u, 0u}, {0u, 0u}};
    if constexpr (GATHER) { PG8_FETCH(cur, oC); }
    const char* cA = cur.a; const char* cB = cur.b;
    PG8_STB(0, 0, cB); PG8_STB(0, 1, cB); PG8_STA(0, 0, cA, oC); PG8_STA(0, 1, cA, oC);
    if (wr == 1) PG8_BAR;
    PG8_WAIT_V(2); PG8_BAR;
    PG8_STB(1, 0, cB + kstep); PG8_STA(1, 0, cA + kstep, oC); PG8_STB(1, 1, cB + kstep);
    PG8_WAIT_V(6); PG8_BAR;
    for (;;) {
        const bool has_next = S.next(ui + 1, nxt);
        const char* nA = has_next ? nxt.a : cA; const char* nB = has_next ? nxt.b : cB;
        if constexpr (GATHER) { if (has_next) { PG8_FETCH(nxt, oN); } else {
#pragma unroll
            for (int h_ = 0; h_ < 2; ++h_)
#pragma unroll
                for (int i_ = 0; i_ < 2; ++i_) oN[h_][i_] = oC[h_][i_]; } }
        for (int t = 0; t < nt; t += 2) {
            const bool last = (t == nt - 2);
            const char* a1 = cA + (size_t)(t + 1) * kstep;
            const char* a2 = last ? nA : cA + (size_t)(t + 2) * kstep; const char* b2 = last ? nB : cB + (size_t)(t + 2) * kstep;
            const char* a3 = a2 + kstep; const char* b3 = b2 + kstep;
            if constexpr (GATHER) {
#pragma unroll
                for (int h_ = 0; h_ < 2; ++h_)
#pragma unroll
                    for (int i_ = 0; i_ < 2; ++i_) o2[h_][i_] = last ? oN[h_][i_] : oC[h_][i_]; }
            PG8_LDB(B0, 0, 0); PG8_LDB(B1, 0, 1); PG8_SCHED; PG8_LDA(At, 0, 0); PG8_STA(1, 1, a1, oC);
            PG8_WAIT_V(8); PG8_WAIT_L(0); PG8_BAR; PG8_MMA(0, 0, At, B0); PG8_MMA(0, 1, At, B1); PG8_BAR; PG8_SCHED;
            PG8_LDA(At, 0, 1); PG8_STB(0, 0, b2); PG8_STB(0, 1, b2); PG8_STA(0, 0, a2, o2);
            PG8_WAIT_V(8); PG8_WAIT_L(0); PG8_BAR; PG8_MMA(1, 0, At, B0); PG8_MMA(1, 1, At, B1); PG8_BAR; PG8_SCHED;
            PG8_LDB(B0, 1, 0); PG8_LDB(B1, 1, 1); PG8_SCHED; PG8_LDA(At, 1, 0); PG8_STA(0, 1, a2, o2);
            PG8_WAIT_V(8); PG8_WAIT_L(0); PG8_BAR; PG8_MMA(0, 0, At, B0); PG8_MMA(0, 1, At, B1); PG8_BAR; PG8_SCHED;
            PG8_LDA(At, 1, 1); PG8_STB(1, 0, b3); PG8_STB(1, 1, b3); PG8_STA(1, 0, a3, o2);
            PG8_WAIT_V(8); PG8_WAIT_L(0); PG8_BAR; PG8_MMA(1, 0, At, B0); PG8_MMA(1, 1, At, B1); PG8_BAR; PG8_SCHED;
        }
        if constexpr (ALIGN_EPI) { if (wr == 0) PG8_BAR; }
        E(acc, cur, wr, wc, fr, fq);
        if (!has_next) break;
#pragma unroll
        for (int a = 0; a < 2; ++a)
#pragma unroll
            for (int b = 0; b < 2; ++b)
#pragma unroll
                for (int m = 0; m < 4; ++m)
#pragma unroll
                    for (int n = 0; n < 2; ++n) acc[a][b][m][n] = (f32x4){0.f, 0.f, 0.f, 0.f};
        cur = nxt; cA = nA; cB = nB; ++ui;
        if constexpr (GATHER) {
#pragma unroll
            for (int h_ = 0; h_ < 2; ++h_)
#pragma unroll
                for (int i_ = 0; i_ < 2; ++i_) oC[h_][i_] = oN[h_][i_]; }
        if constexpr (ALIGN_EPI) { if (wr == 1) PG8_BAR; }
    }
    PG8_WAIT_V(0);
    if constexpr (!ALIGN_EPI) { if (wr == 0) PG8_BAR; }
    PG8_BAR;
#undef PG8_SA
#undef PG8_SB
#undef PG8_STAGE_O
#undef PG8_STB
#undef PG8_STA
#undef PG8_LDA
#undef PG8_LDB
#undef PG8_MMA
#undef PG8_WAIT_V
#undef PG8_WAIT_L
#undef PG8_BAR
#undef PG8_SCHED
#undef PG8_FETCH
}

struct EpiStoreBf16 {
    static constexpr bool PERM = true;
    bf16_t* O; int ldc; int split_cols; size_t split_stride; float scale0;
    __device__ __forceinline__ void operator()(const f32x4 (&acc)[2][2][4][2], const Unit& u, int wr, int wc, int fr, int fq) const {
        const int row0 = u.orow + wr * 64 + fr; int colt = u.ocol; bf16_t* base = O;
        float sc = 1.f; if (split_cols) { const int t = colt / split_cols; base += (size_t)t * split_stride; colt -= t * split_cols; if (t == 0) sc = scale0; }
        const int col0 = colt + wc * 32 + 8 * fq;
#pragma unroll
        for (int ai = 0; ai < 2; ++ai)
#pragma unroll
            for (int m = 0; m < 4; ++m) { bf16_t* rowp = base + (size_t)(row0 + ai * HALF + m * 16) * ldc + col0;
#pragma unroll
                for (int bj = 0; bj < 2; ++bj) { const f32x4 v0 = acc[ai][bj][m][0] * sc, v1 = acc[ai][bj][m][1] * sc;
                    u32x4 w; w.x = cvt_pk_bf16(v0[0], v0[1]); w.y = cvt_pk_bf16(v0[2], v0[3]); w.z = cvt_pk_bf16(v1[0], v1[1]); w.w = cvt_pk_bf16(v1[2], v1[3]);
                    *(u32x4*)(rowp + bj * HALF) = w; } }
    }
};
struct EpiResid {
    static constexpr bool PERM = false;
    const float* x; float* out; bf16_t* hb;
    __device__ __forceinline__ void operator()(const f32x4 (&acc)[2][2][4][2], const Unit& u, int wr, int wc, int fr, int fq) const {
        const int row0 = u.orow + wr * 64 + fr, col0 = u.ocol + wc * 32 + 4 * fq;
#pragma unroll
        for (int ai = 0; ai < 2; ++ai)
#pragma unroll
            for (int m = 0; m < 4; ++m) { const size_t off = (size_t)(row0 + ai * HALF + m * 16) * D + col0;
#pragma unroll
                for (int bj = 0; bj < 2; ++bj)
#pragma unroll
                    for (int n = 0; n < 2; ++n) { const size_t o = off + bj * HALF + n * 16; const f32x4 xv = *(const f32x4*)(x + o); const f32x4 hv = xv + acc[ai][bj][m][n];
                        *(f32x4*)(out + o) = hv; v2u w; w.x = cvt_pk_bf16(hv[0], hv[1]); w.y = cvt_pk_bf16(hv[2], hv[3]); *(v2u*)(hb + o) = w; } }
    }
};
struct EpiGateUp {
    static constexpr bool PERM = true;
    bf16_t* hmid; const f32x2* sw;
    __device__ __forceinline__ void operator()(const f32x4 (&acc)[2][2][4][2], const Unit& u, int wr, int wc, int fr, int fq) const {
        const int col0 = u.ocol + wc * 32 + 8 * fq;
        const GAS f32x2* swg = (const GAS f32x2*)sw + (size_t)u.e * 8192 + u.s0 + wr * 64 + fr;
        f32x2 rws[2][4];
#pragma unroll
        for (int ai = 0; ai < 2; ++ai)
#pragma unroll
            for (int m = 0; m < 4; ++m) rws[ai][m] = swg[ai * HALF + m * 16];
#pragma unroll
        for (int ai = 0; ai < 2; ++ai)
#pragma unroll
            for (int m = 0; m < 4; ++m) { const int r = ai * HALF + wr * 64 + m * 16 + fr; const int slot = u.s0 + r; const bool valid = slot < u.cnt;
                const f32x2 rw = rws[ai][m];
                float hv[8];
#pragma unroll
                for (int n = 0; n < 2; ++n)
#pragma unroll
                    for (int j = 0; j < 4; ++j) { const float g = acc[ai][0][m][n][j] * rw.x, up = acc[ai][1][m][n][j] * rw.x;
                        const float e = __builtin_amdgcn_exp2f(-g * LOG2E); const float s = g * __builtin_amdgcn_rcpf(1.0f + e); hv[n * 4 + j] = valid ? s * up * rw.y : 0.f; }
                u32x4 w; w.x = cvt_pk_bf16(hv[0], hv[1]); w.y = cvt_pk_bf16(hv[2], hv[3]); w.z = cvt_pk_bf16(hv[4], hv[5]); w.w = cvt_pk_bf16(hv[6], hv[7]);
                *(GAS u32x4*)(hmid + (size_t)(u.orow + r) * FF + col0) = w; }
    }
};
struct EpiDown {
    static constexpr bool PERM = true;
    bf16_t* y; const unsigned* tok;
    __device__ __forceinline__ void operator()(const f32x4 (&acc)[2][2][4][2], const Unit& u, int wr, int wc, int fr, int fq) const {
        const int col0 = u.ocol + wc * 32 + 8 * fq;
        const GAS unsigned* tg = (const GAS unsigned*)tok + (size_t)u.e * 8192 + u.s0 + wr * 64 + fr;
        unsigned tis[2][4];
#pragma unroll
        for (int ai = 0; ai < 2; ++ai)
#pragma unroll
            for (int m = 0; m < 4; ++m) tis[ai][m] = tg[ai * HALF + m * 16];
#pragma unroll
        for (int ai = 0; ai < 2; ++ai)
#pragma unroll
            for (int m = 0; m < 4; ++m) { const int r = ai * HALF + wr * 64 + m * 16 + fr; const int slot = u.s0 + r;
                if (slot < u.cnt) { const unsigned ti = tis[ai][m]; const unsigned token = ti & 0xffffu, ks = ti >> 16;
                    bf16_t* rowp = y + ((size_t)ks * T + token) * D + col0;
#pragma unroll
                    for (int bj = 0; bj < 2; ++bj) { const f32x4 v0 = acc[ai][bj][m][0], v1 = acc[ai][bj][m][1];
                        u32x4 w; w.x = cvt_pk_bf16(v0[0], v0[1]); w.y = cvt_pk_bf16(v0[2], v0[3]); w.z = cvt_pk_bf16(v1[0], v1[1]); w.w = cvt_pk_bf16(v1[2], v1[3]);
                        *(GAS u32x4*)(rowp + bj * HALF) = w; } } }
    }
};
struct W2Order {
    int G, c; const char* A; const char* Bt;
    __device__ bool next(int i, Unit& u) const { const int L = i * G + c; if (L >= 32) return false; const int g = L & 3, dt = L >> 2;
        u.a = A + ((size_t)dt * 256 * D + 1024 + 256 * g) * 2; u.b = Bt + (size_t)g * 65536 * 2; u.orow = dt * 256; u.ocol = 1024 + 256 * g; u.e = 0; u.s0 = 0; u.cnt = 0; return true; }
    __device__ __forceinline__ unsigned row_off(const Unit&, int) const { return 0u; }
};
template <int NPN, bool UP> struct MoeOrder {
    int c0, ncu, c, t_lo, t_hi; const PG8_LAS int* tab; const char* A; const char* W; const unsigned* tok;
    __device__ bool next(int i, Unit& u) const {
        if (c < c0 || c >= c0 + ncu) return false;
        const int nt_all = __builtin_amdgcn_readfirstlane(tab[32]); const int hi_ = t_hi < nt_all ? t_hi : nt_all; const int total = (hi_ - t_lo) * NPN;
        const int L = i * ncu + (c - c0); if (L >= total) return false;
        const int Tt = t_lo + L / NPN, pn = L % NPN; int e = 0;
        for (int k = 1; k < 32; ++k) e = (tab[k] <= Tt) ? k : e;
        e = __builtin_amdgcn_readfirstlane(e);
        const int mt = Tt - __builtin_amdgcn_readfirstlane(tab[e]);
        u.e = e; u.s0 = mt * 256; u.cnt = __builtin_amdgcn_readfirstlane(tab[40 + e]); u.orow = Tt * 256;
        if (UP) { u.a = A; u.b = W + ((size_t)(e * 4 + pn) * 256) * D * 2; u.ocol = pn * 128; }
        else { u.a = A + (size_t)Tt * 256 * FF * 2; u.b = W + ((size_t)e * D + pn * 256) * FF * 2; u.ocol = pn * 256; }
        return true;
    }
    __device__ __forceinline__ unsigned row_off(const Unit& u, int R) const {
        const int slot = u.s0 + R; unsigned token = ((const GAS unsigned*)tok)[u.e * 8192 + slot] & 0xffffu; token = (slot < u.cnt) ? token : 0u; return token * (unsigned)(D * 2);
    }
};
}

namespace att {
constexpr int PITCH = 1024, QB = 128, KVB = 64;
constexpr int KBUF0 = 0, VBUF0 = 32768, XBUF0 = 65536;
__device__ __forceinline__ int crow(int r, int hi) { return (r & 3) + 8 * (r >> 2) + 4 * hi; }
__device__ __forceinline__ unsigned cvtpk(float lo, float hi) { unsigned r; asm volatile("v_cvt_pk_bf16_f32 %0, %1, %2" : "=v"(r) : "v"(lo), "v"(hi)); return r; }
typedef short v4i16_t __attribute__((ext_vector_type(4)));
__device__ __forceinline__ v2u vtr(const LAS char* p) { return __builtin_bit_cast(v2u, __builtin_amdgcn_ds_read_tr16_b64_v4i16((LAS v4i16_t*)p)); }
__device__ __forceinline__ float opq(float x) { asm("" : "+v"(x)); return x; }
__device__ __forceinline__ float hswap_max(float m) { auto rr = __builtin_amdgcn_permlane32_swap(__float_as_uint(m), __float_as_uint(m), false, false); return fmaxf(__uint_as_float(rr[0]), __uint_as_float(rr[1])); }
__device__ __forceinline__ float hswap_sum(float m) { auto rr = __builtin_amdgcn_permlane32_swap(__float_as_uint(m), __float_as_uint(m), false, false); return __uint_as_float(rr[0]) + __uint_as_float(rr[1]); }

__device__ __forceinline__ void attn_unit(int b, int h, int qb, const bf16* Q, const bf16* K, const bf16* V, bf16* A3, const float* subg, float lam, LAS unsigned char* lds, LAS float* wsf_all) {
    int lane_ = threadIdx.x & 63; asm volatile("" : "+v"(lane_));
    const int tid = threadIdx.x, lane = lane_, r32 = lane & 31, hi = lane >> 5; const int wid = __builtin_amdgcn_readfirstlane(tid >> 6);
    const int mp = wid >> 2, rg = wid & 3;
    const long rowbase = (long)b * SEQ; const int q0 = qb * QB, qmin = q0 + 32 * rg, qmax = qmin + 31;
    const float slope2 = exp2f(-(float)(h + 1)) * LOG2E;
    LAS float* wsf = wsf_all + wid * 64;
    const bf16* Kh = K + rowbase * PITCH + h * 128; const bf16* Vh = V + rowbase * PITCH + h * 128;
    const int NT = (q0 + QB) / KVB;
    const int drow = 4 * wid + (lane >> 4), dslot = lane & 15;
    const bf16* ksrc = Kh + (long)drow * PITCH + ((dslot ^ (drow & 15)) * 8);
    const bf16* vsrc = Vh + (long)drow * PITCH + (((dslot >> 2) ^ (drow & 3)) * 32) + (dslot & 3) * 8;
    const unsigned lds0 = (unsigned)(unsigned long)lds;
#define ATT_GLDS(gsrc, ldst) do { unsigned keep_; asm volatile("s_mov_b32 %0, m0\n\ts_mov_b32 m0, %2\n\ts_nop 0\n\tglobal_load_lds_dwordx4 %1, off\n\ts_mov_b32 m0, %0" : "=&s"(keep_) : "v"(gsrc), "s"(ldst) : "memory"); } while (0)
#define ATT_DMA_K(t) do { const long to_ = (long)(t) * KVB * PITCH; const unsigned bb_ = (unsigned)__builtin_amdgcn_readfirstlane((int)(lds0 + KBUF0 + (unsigned)((t) & 1) * 16384u)); \
        ATT_GLDS(ksrc + to_, bb_ + (unsigned)wid * 1024u); ATT_GLDS(ksrc + to_ + 32 * PITCH, bb_ + 8192u + (unsigned)wid * 1024u); } while (0)
#define ATT_DMA_V(t) do { const long to_ = (long)(t) * KVB * PITCH; const unsigned bb_ = (unsigned)__builtin_amdgcn_readfirstlane((int)(lds0 + VBUF0 + (unsigned)((t) & 1) * 16384u)); \
        ATT_GLDS(vsrc + to_, bb_ + (unsigned)wid * 1024u); ATT_GLDS(vsrc + to_ + 32 * PITCH, bb_ + 8192u + (unsigned)wid * 1024u); } while (0)
    ATT_DMA_K(0);
    bf16x8 qr[4];
    {
        const bf16* Qw = Q + (rowbase + qmin + r32) * PITCH + h * 128 + mp * 64 + hi * 8;
#pragma unroll
        for (int d0 = 0; d0 < 4; ++d0) qr[d0] = *(const bf16x8*)(Qw + d0 * 16);
        asm volatile("" :: "v"(qr[0]), "v"(qr[1]), "v"(qr[2]), "v"(qr[3]));
    }
    const float s32 = 32.f * slope2;
    const float lbase = slope2 * (float)(4 * hi - r32 - qmin);
#ifdef PROBE_TIME
    const unsigned long long pt0_ = __builtin_amdgcn_s_memrealtime();
#endif
    float mrow = -INFINITY, lsum = 0.f;
    f32x16 o[4];
#pragma unroll
    for (int d0 = 0; d0 < 4; ++d0)
#pragma unroll
        for (int r = 0; r < 16; ++r) o[d0][r] = 0.f;
    v4u pw[4] = {(v4u){0u, 0u, 0u, 0u}, (v4u){0u, 0u, 0u, 0u}, (v4u){0u, 0u, 0u, 0u}, (v4u){0u, 0u, 0u, 0u}};
    bool resc = false;
    const int vq = (lane & 15) >> 2;
    for (int s = 0; s <= NT; ++s) {
        VM_WAIT(); __syncthreads();
        if (s + 1 < NT) ATT_DMA_K(s + 1);
        if (s < NT) ATT_DMA_V(s);
        const bool do_s = s < NT && KVB * s <= qmax, do_pv = s >= 1 && KVB * (s - 1) <= qmax;
        f32x16 p0, p1;
        if (do_s) {
            const LAS unsigned char* kb = lds + KBUF0 + (s & 1) * 16384 + r32 * 256;
            bf16x8 kf[8];
#pragma unroll
            for (int d0 = 0; d0 < 4; ++d0) { const int so = ((mp * 8 + 2 * d0 + hi) ^ (r32 & 15)) * 16; kf[2 * d0] = *(const LAS bf16x8*)(kb + so); kf[2 * d0 + 1] = *(const LAS bf16x8*)(kb + so + 8192); }
#pragma unroll
            for (int r = 0; r < 16; ++r) { p0[r] = 0.f; p1[r] = 0.f; }
#pragma unroll
            for (int d0 = 0; d0 < 4; ++d0) {
                p0 = __builtin_amdgcn_mfma_f32_32x32x16_bf16(kf[2 * d0], qr[d0], p0, 0, 0, 0);
                p1 = __builtin_amdgcn_mfma_f32_32x32x16_bf16(kf[2 * d0 + 1], qr[d0], p1, 0, 0, 0);
            }
        }
        if (do_pv) {
            const int t = s - 1;
            if (resc) {
                float al[16];
#pragma unroll
                for (int r = 0; r < 16; ++r) al[r] = wsf[crow(r, hi)];
#pragma unroll
                for (int d0 = 0; d0 < 4; ++d0)
#pragma unroll
                    for (int r = 0; r < 16; ++r) o[d0][r] = opq(o[d0][r] * al[r]);
            }
            const LAS char* vb = (const LAS char*)(lds + VBUF0 + (t & 1) * 16384) + ((lane >> 4) & 1) * 32 + (lane & 3) * 8 + (4 * hi + vq) * 256;
#pragma unroll
            for (int d0 = 0; d0 < 4; ++d0) {
#pragma unroll
                for (int ks = 0; ks < 4; ++ks) { const v2u lo = vtr(vb + ((d0 ^ vq) * 64) + ks * 4096), hh = vtr(vb + ((d0 ^ vq) * 64) + ks * 4096 + 2048);
                    const v4u vf = (v4u){lo.x, lo.y, hh.x, hh.y};
                    o[d0] = __builtin_amdgcn_mfma_f32_32x32x16_bf16(__builtin_bit_cast(bf16x8, pw[ks]), __builtin_bit_cast(bf16x8, vf), o[d0], 0, 0, 0); }
            }
        }
        if (do_s) {
            const float lb = lbase + slope2 * (float)(KVB * s);
#pragma unroll
            for (int r = 0; r < 16; ++r) { const float cr = (float)((r & 3) + 8 * (r >> 2)); p0[r] = opq(fmaf(slope2, cr, p0[r])); p1[r] = opq(fmaf(slope2, cr, p1[r])); }
            if (KVB * s + 63 > qmin) {
                const int dq = qmin + r32 - KVB * s - 4 * hi;
#pragma unroll
                for (int r = 0; r < 16; ++r) { const int kk = (r & 3) + 8 * (r >> 2); if (kk > dq) p0[r] = -INFINITY; if (kk + 32 > dq) p1[r] = -INFINITY; }
            }
            float m0 = p0[0], m1 = p1[0];
#pragma unroll
            for (int r = 1; r < 16; ++r) { m0 = fmaxf(m0, p0[r]); m1 = fmaxf(m1, p1[r]); }
            float rmt = fmaxf(m0, m1 + s32) + lb; rmt = hswap_max(rmt);
            const float mnew = fmaxf(mrow, rmt);
            const float alpha = __builtin_amdgcn_exp2f(mrow - mnew);
            mrow = mnew;
            const float e0 = mnew - lb, e1 = e0 - s32;
            float sacc = 0.f;
#pragma unroll
            for (int r = 0; r < 16; ++r) { p0[r] = __builtin_amdgcn_exp2f(opq(p0[r] - e0)); p1[r] = __builtin_amdgcn_exp2f(opq(p1[r] - e1)); sacc = opq(sacc + p0[r]); sacc = opq(sacc + p1[r]); }
            lsum = lsum * alpha + sacc;
            pw[0] = (v4u){cvtpk(p0[0], p0[1]), cvtpk(p0[2], p0[3]), cvtpk(p0[4], p0[5]), cvtpk(p0[6], p0[7])};
            pw[1] = (v4u){cvtpk(p0[8], p0[9]), cvtpk(p0[10], p0[11]), cvtpk(p0[12], p0[13]), cvtpk(p0[14], p0[15])};
            pw[2] = (v4u){cvtpk(p1[0], p1[1]), cvtpk(p1[2], p1[3]), cvtpk(p1[4], p1[5]), cvtpk(p1[6], p1[7])};
            pw[3] = (v4u){cvtpk(p1[8], p1[9]), cvtpk(p1[10], p1[11]), cvtpk(p1[12], p1[13]), cvtpk(p1[14], p1[15])};
            resc = !__all(alpha == 1.0f);
            if (resc && hi == 0) wsf[r32] = alpha;
        }
    }
#undef ATT_DMA_K
#undef ATT_DMA_V
#undef ATT_GLDS
#ifdef PROBE_TIME
    if (threadIdx.x == 0) { volatile LAS unsigned* pa_ = (volatile LAS unsigned*)(lds + MISC_OFF + 64); pa_[0] += (unsigned)(__builtin_amdgcn_s_memrealtime() - pt0_); pa_[1] += (unsigned)(NT + 1); }
#endif
    lsum = hswap_sum(lsum);
    if (hi == 0) wsf[r32] = __builtin_amdgcn_rcpf(lsum);
    LDS_WAIT();
    {
        float rl[16];
#pragma unroll
        for (int r = 0; r < 16; ++r) rl[r] = wsf[crow(r, hi)];
#pragma unroll
        for (int d0 = 0; d0 < 4; ++d0)
#pragma unroll
            for (int r = 0; r < 16; ++r) o[d0][r] *= rl[r];
    }
    LAS float* X = (LAS float*)(lds + XBUF0) + rg * 4096;
    if (mp == 1) {
#pragma unroll
        for (int d0 = 0; d0 < 4; ++d0)
#pragma unroll
            for (int r = 0; r < 16; ++r) X[(d0 * 16 + r) * 64 + lane] = o[d0][r];
    }
    __syncthreads();
    if (mp == 0) {
        float ss[16];
#pragma unroll
        for (int r = 0; r < 16; ++r) ss[r] = 0.f;
#pragma unroll
        for (int d0 = 0; d0 < 4; ++d0)
#pragma unroll
            for (int r = 0; r < 16; ++r) { const float dv = o[d0][r] - lam * X[(d0 * 16 + r) * 64 + lane]; o[d0][r] = dv; ss[r] += dv * dv; }
#pragma unroll
        for (int r = 0; r < 16; ++r) {
#pragma unroll
            for (int off = 1; off < 32; off <<= 1) ss[r] += __shfl_xor(ss[r], off);
            ss[r] = rsqrtf(ss[r] * (1.0f / 128.0f) + RMS_EPS) * 0.8f;
        }
        LAS bf16* stg = (LAS bf16*)(lds + KBUF0 + rg * 8192);
#pragma unroll
        for (int d0 = 0; d0 < 4; ++d0) { const float gg = subg[d0 * 32 + r32];
#pragma unroll
            for (int r = 0; r < 16; ++r) { const float v = o[d0][r] * ss[r] * gg; const unsigned pk = cvtpk(v, v); stg[crow(r, hi) * 128 + d0 * 32 + r32] = (bf16)(pk & 0xffffu); } }
        LDS_WAIT(); asm volatile("" ::: "memory");
        bf16* Ow = A3 + (rowbase + qmin) * D + h * 128;
#pragma unroll
        for (int i = 0; i < 8; ++i) { const int row = i * 4 + (lane >> 4), ch = lane & 15; const v4u v = *(const LAS v4u*)(stg + row * 128 + ch * 8); *(GAS v4u*)(Ow + (long)row * D + ch * 8) = v; }
    }
    __syncthreads();
}
}

#define XB_TMO      128
#define XB_XCNT(j)  (256  + 64 * (j))
#define XB_XSUB(j)  (1280 + 64 * (j))
#define XB_XGEN(j)  (2304 + 64 * (j))
#define XB_TOP      3328
#define XB_TOPGEN   3392
#define XCD_BAR_WORDS 3456
#define XB_SPIN_CAP (1u << 18)

__device__ __forceinline__ unsigned xb_ld(unsigned* p)              { return __hip_atomic_load(p, __ATOMIC_RELAXED, __HIP_MEMORY_SCOPE_AGENT); }
__device__ __forceinline__ unsigned xb_add(unsigned* p, unsigned v) { return __hip_atomic_fetch_add(p, v, __ATOMIC_RELAXED, __HIP_MEMORY_SCOPE_AGENT); }
__device__ __forceinline__ unsigned xb_xcc_id() { return (unsigned)__builtin_amdgcn_s_getreg((3 << 11) | 20) & 0xFu; }
#define XB_SPIN(cond, bar) do { unsigned _sp = 0; while (cond) { __builtin_amdgcn_s_sleep(1); \
    if ((++_sp & 255u) == 0u) { if (xb_ld(&(bar)[XB_TMO])) break; if (_sp > XB_SPIN_CAP) { atomicAdd(&(bar)[XB_TMO], 1u); break; } } } } while (0)

struct XcdBarrier { unsigned* bar; unsigned x; volatile LAS unsigned* st; };

__device__ __forceinline__ XcdBarrier xcd_barrier_post(unsigned* bar, volatile LAS unsigned* st) {
    XcdBarrier b; b.bar = bar; b.x = xb_xcc_id(); b.st = st;
    if (threadIdx.x == 0) (void)xb_add(&bar[XB_XCNT(b.x)], 1u);
    return b;
}
__device__ __forceinline__ void xcd_barrier_complete(unsigned* bar, unsigned x, unsigned& nloc, unsigned& nx) {
    const unsigned G = gridDim.x * gridDim.y * gridDim.z;
    unsigned sum, cnt, mine, sp = 0u;
    for (;;) {
        sum = 0u; cnt = 0u; mine = 0u;
#pragma unroll
        for (unsigned j = 0; j < 16; ++j) { const unsigned c = xb_ld(&bar[XB_XCNT(j)]); sum += c; cnt += (c > 0u) ? 1u : 0u; mine = (j == x) ? c : mine; }
        if (sum == G) break;
        __builtin_amdgcn_s_sleep(1);
        if ((++sp & 255u) == 0u) { if (xb_ld(&bar[XB_TMO])) break; if (sp > XB_SPIN_CAP) { atomicAdd(&bar[XB_TMO], 1u); break; } }
    }
    nloc = mine > 0u ? mine : 1u; nx = cnt > 0u ? cnt : 1u;
}
__device__ __forceinline__ void xcd_barrier(const XcdBarrier& b) {
    asm volatile("s_waitcnt vmcnt(0)" ::: "memory");
    __syncthreads();
    if (threadIdx.x == 0) {
        unsigned* bar = b.bar;
        __builtin_amdgcn_s_waitcnt(0);
        unsigned nloc = b.st[0], nx = b.st[1];
        if (nloc == 0u) { xcd_barrier_complete(bar, b.x, nloc, nx); b.st[0] = nloc; b.st[1] = nx; }
        const unsigned old = xb_add(&bar[XB_XSUB(b.x)], 1u);
        const unsigned gen = old / nloc;
        if (old + 1u == (gen + 1u) * nloc) {
            __builtin_amdgcn_fence(__ATOMIC_RELEASE, "agent");
            asm volatile("s_waitcnt vmcnt(0)" ::: "memory");
            const unsigned og = xb_add(&bar[XB_TOP], 1u);
            const unsigned tg = og / nx;
            if (og + 1u == (tg + 1u) * nx) xb_add(&bar[XB_TOPGEN], 1u);
            else XB_SPIN(xb_ld(&bar[XB_TOPGEN]) == tg, bar);
            __builtin_amdgcn_fence(__ATOMIC_ACQUIRE, "agent");
            xb_add(&bar[XB_XGEN(b.x)], 1u);
            asm volatile("s_waitcnt vmcnt(0)" ::: "memory");
        } else {
            XB_SPIN(xb_ld(&bar[XB_XGEN(b.x)]) == gen, bar);
            __builtin_amdgcn_fence(__ATOMIC_ACQUIRE, "agent");
            asm volatile("s_waitcnt vmcnt(0)" ::: "memory");
        }
    }
    __syncthreads();
}

__device__ __forceinline__ unsigned f2bf(float f) { unsigned u = __builtin_bit_cast(unsigned, f); return (u + 0x7fffu + ((u >> 16) & 1u)) >> 16; }
__device__ __forceinline__ unsigned pk2(float lo, float hi) { unsigned r; asm volatile("v_cvt_pk_bf16_f32 %0, %1, %2" : "=v"(r) : "v"(lo), "v"(hi)); return r; }
__device__ __forceinline__ float bf2f(unsigned short v) { return __uint_as_float(((unsigned)v) << 16); }
__device__ __forceinline__ float wave_sum(float v) {
#pragma unroll
    for (int o = 1; o < 64; o <<= 1) v += __shfl_xor(v, o);
    return v;
}
struct TrItem { const GAS float* src; int N; GAS bf16* dst; int ldt; const GAS float* ks; };
__device__ __forceinline__ void tr_load(const TrItem& it, f32x4 (&v)[16], f32x2 (&sc)[8], int lane) {
    const int kq = lane >> 4, nq = lane & 15;
    const GAS float* sp = it.src + (size_t)(2 * kq) * it.N + 4 * nq;
#pragma unroll
    for (int i = 0; i < 8; ++i) { v[2 * i] = *(const GAS f32x4*)(sp + (size_t)(8 * i) * it.N); v[2 * i + 1] = *(const GAS f32x4*)(sp + (size_t)(8 * i + 1) * it.N); }
    if (it.ks) {
#pragma unroll
        for (int i = 0; i < 8; ++i) sc[i] = *(const GAS f32x2*)(it.ks + 8 * i + 2 * kq);
    } else {
#pragma unroll
        for (int i = 0; i < 8; ++i) sc[i] = (f32x2){1.f, 1.f};
    }
}
__device__ __forceinline__ void tr_finish(const TrItem& it, f32x4 (&v)[16], f32x2 (&sc)[8], LAS unsigned* scr, int lane) {
    const int kq = lane >> 4, nq = lane & 15;
#pragma unroll
    for (int i = 0; i < 8; ++i)
#pragma unroll
        for (int j = 0; j < 4; ++j) scr[(4 * nq + j) * 33 + 4 * i + kq] = pk2(v[2 * i][j] * sc[i].x, v[2 * i + 1][j] * sc[i].y);
    LDS_WAIT(); asm volatile("" ::: "memory");
    const int c = lane & 7;
#pragma unroll
    for (int jj = 0; jj < 8; ++jj) { const int n = (lane >> 3) + 8 * jj; const LAS unsigned* s = scr + n * 33 + 4 * c;
        v4u o; o.x = s[0]; o.y = s[1]; o.z = s[2]; o.w = s[3];
        *(GAS v4u*)(it.dst + (size_t)n * it.ldt + 8 * c) = o; }
    LDS_WAIT(); asm volatile("" ::: "memory");
}
__device__ __forceinline__ void p0_transpose_item(const float* src, int N, bf16* dst, int ldt, const float* ks, LAS unsigned* scr, int lane) {
    asm volatile("" : "+v"(lane));
    const TrItem it{(const GAS float*)src, N, (GAS bf16*)dst, ldt, (const GAS float*)ks}; f32x4 v[16]; f32x2 sc[8]; tr_load(it, v, sc, lane); tr_finish(it, v, sc, scr, lane);
}

template <int IDX> __device__ __forceinline__ const float* ldarg_ptr() {
    auto ka = __builtin_amdgcn_kernarg_segment_ptr();
    unsigned long long v; asm volatile("s_load_dwordx2 %0, %1, %2\n\ts_waitcnt lgkmcnt(0)" : "=s"(v) : "s"(ka), "i"(IDX * 8) : "memory"); return (const float*)v;
}
struct Args { const float* in[20]; float* out; unsigned char* ws; int ph_lo, ph_hi, li, pad; };
constexpr int NPH = 9;

__global__ void __launch_bounds__(512, 2) hymba_fwd(Args args) {
    extern __shared__ __attribute__((aligned(16))) unsigned char lds_raw[];
    LAS unsigned char* lds = (LAS unsigned char*)lds_raw;
    const int tid = threadIdx.x, lane = tid & 63, wave = __builtin_amdgcn_readfirstlane(tid >> 6);
    const int G = gridDim.x; const int bx = blockIdx.x; const int vcu = (G % 8 == 0) ? (bx % 8) * (G / 8) + bx / 8 : bx;
    gu32* ctl = (gu32*)(args.ws + WS_CTL);
#define LDARG(i) ldarg_ptr<i>()
#define WSPTR(name, off) bf16* name = (bf16*)(ws + (off))
#define PHASE_WS() unsigned char* ws = args.ws; asm volatile("" : "+s"(ws)); float* out = args.out; asm volatile("" : "+s"(out)); (void)out
    volatile LAS unsigned* MISC = (volatile LAS unsigned*)(lds + MISC_OFF);
    if (tid < 4) MISC[tid] = 0u;
    __syncthreads();
    const int lo = args.ph_lo, hi_ph = args.ph_hi;
    const bool use_bar = (hi_ph - lo) > 1;
    XcdBarrier bar; bar.bar = (unsigned*)(ctl + CW_BAR); bar.x = 0; bar.st = nullptr;
    if (use_bar) bar = xcd_barrier_post((unsigned*)(ctl + CW_BAR), MISC);
#ifndef PHASE_MASK
#define PHASE_MASK 0x1FF
#endif
#define IN(k) (((PHASE_MASK >> (k)) & 1) && lo <= (k) && (k) < hi_ph)
#define BOTH(k) (IN(k) && IN((k) + 1))
#define GRID_BAR() do { xcd_barrier(bar); } while (0)
    const int gw = vcu * 8 + wave, NGW = G * 8;

    if (IN(0)) {
        PHASE_WS(); WSPTR(wfrag, WS_WFRAG); WSPTR(bt2, WS_BT2); WSPTR(win_t, WS_WIN); WSPTR(wout_t, WS_WOUT); WSPTR(wout_t2, WS_WOUT2); WSPTR(XN, WS_XN);
        const float* x = LDARG(0); const float* norm1_g = LDARG(1); const float* w_in = LDARG(2); const float* pool_w = LDARG(8); const float* pool_scale = LDARG(9); const float* w_out = LDARG(10);
        const float* norm2_g = LDARG(11); const float* w_coarse = LDARG(12); const float* w_fine = LDARG(14);
        LAS unsigned* scr = (LAS unsigned*)(lds + wave * 16384);
        constexpr int I_IN = 32 * 64, I_OUT = 32 * 32, I_OUT2 = 16 * 32;
        constexpr int NITEMS = I_IN + I_OUT + I_OUT2;
        for (int it = gw; it < NITEMS; it += NGW) {
            int r = it;
            if (r < I_IN) { const int kb = r / 64, nb = r % 64, k0 = 64 * kb, n0 = 64 * nb; p0_transpose_item(w_in + (size_t)k0 * INW + n0, INW, win_t + (size_t)n0 * D + k0, D, nullptr, scr, lane); continue; } r -= I_IN;
            if (r < I_OUT) { const int kb = r / 32, nb = r % 32, k0 = 64 * kb, n0 = 64 * nb; p0_transpose_item(w_out + (size_t)k0 * D + n0, D, wout_t + (size_t)n0 * D + k0, D, nullptr, scr, lane); continue; } r -= I_OUT;
            { const int kb = r / 32, nb = r % 32, k0 = 64 * kb, n0 = 64 * nb; p0_transpose_item(w_out + (size_t)k0 * D + n0, D, wout_t2 + (size_t)n0 * D + k0, D, nullptr, scr, lane); }
        }
        for (int i = blockIdx.x * 512 + tid; i < 4 * 256 * 256 / 4; i += G * 512) { const int e4 = (i & 63) * 4, gc = i >> 6, g = gc >> 8;
            const f32x4 w = *(const f32x4*)(pool_w + (size_t)gc * 256 + e4); const f32x4 s = *(const f32x4*)(pool_scale + g * 256 + e4);
            v2u o; o.x = pk2(w[0] * s[0], w[1] * s[1]); o.y = pk2(w[2] * s[2], w[3] * s[3]); *(v2u*)(bt2 + (size_t)gc * 256 + e4) = o; }
        for (int i = blockIdx.x * 512 + tid; i < 128 * 2 * 64; i += G * 512) { const int ln = i & 63, nt_ = (i >> 6) & 1, gs = i >> 7; const int n = ln & 31;
            unsigned hw[4], lw[4];
#pragma unroll
            for (int jp = 0; jp < 4; ++jp) { float v[2];
#pragma unroll
                for (int q = 0; q < 2; ++q) { const int k = 16 * gs + 8 * (ln >> 5) + 2 * jp + q; float w = 0.f;
                    if (nt_ == 0) w = w_fine[((size_t)(n >> 3) * D + k) * 8 + (n & 7)]; else if (n < 4) w = w_coarse[(size_t)k * 4 + n];
                    v[q] = w * norm2_g[k]; }
                const unsigned h0 = f2bf(v[0]), h1 = f2bf(v[1]); hw[jp] = h0 | (h1 << 16);
                lw[jp] = f2bf(v[0] - __uint_as_float(h0 << 16)) | (f2bf(v[1] - __uint_as_float(h1 << 16)) << 16); }
            *(v4u*)(wfrag + ((size_t)((gs * 2 + nt_) * 2 + 0) * 64 + ln) * 8) = (v4u){hw[0], hw[1], hw[2], hw[3]};
            *(v4u*)(wfrag + ((size_t)((gs * 2 + nt_) * 2 + 1) * 64 + ln) * 8) = (v4u){lw[0], lw[1], lw[2], lw[3]}; }
        for (int m = gw; m < T; m += NGW) {
            const f32x4* xr = (const f32x4*)(x + (size_t)m * D) + 2 * lane; f32x4 v[8]; float s = 0.f;
#pragma unroll
            for (int j = 0; j < 4; ++j) { v[2 * j] = xr[128 * j]; v[2 * j + 1] = xr[128 * j + 1]; }
#pragma unroll
            for (int j = 0; j < 8; ++j) s += (v[j].x * v[j].x + v[j].y * v[j].y) + (v[j].z * v[j].z + v[j].w * v[j].w);
            const float rstd = rsqrtf(wave_sum(s) * (1.f / D) + RMS_EPS);
            v4u* o16 = (v4u*)(XN + (size_t)m * D) + lane;
#pragma unroll
            for (int j = 0; j < 4; ++j) { const f32x4 g0 = ((const f32x4*)norm1_g)[2 * lane + 128 * j], g1 = ((const f32x4*)norm1_g)[2 * lane + 128 * j + 1]; const f32x4 a = v[2 * j] * rstd * g0, c = v[2 * j + 1] * rstd * g1;
                o16[64 * j] = (v4u){pk2(a.x, a.y), pk2(a.z, a.w), pk2(c.x, c.y), pk2(c.z, c.w)}; }
        }
        if (BOTH(0)) GRID_BAR();
    }

    if (IN(1)) {
        PHASE_WS(); WSPTR(win_t, WS_WIN); WSPTR(XN, WS_XN); WSPTR(Qb, WS_Q);
        { pg8::DenseOrder S; S.init(T, INW, G, bx, XN, win_t, D, D);
          pg8::EpiStoreBf16 E{Qb, AW, AW, (size_t)T * AW, C2};
          pg8::gemm_phase<pg8::EpiStoreBf16, pg8::DenseOrder, true, false>(lds, D / 64, D, D, S, E); }
        if (BOTH(1)) GRID_BAR();
    }

    if (IN(2)) {
        PHASE_WS(); WSPTR(Qb, WS_Q); WSPTR(Kb, WS_K); WSPTR(Vb, WS_V); WSPTR(Ub, WS_U); WSPTR(A3, WS_A3);
        for (int tb = vcu; tb < T / 32; tb += G) {
            const int gi = wave & 3, chg = lane & 31;
#pragma unroll 1
            for (int k = 0; k < 8; ++k) {
                const int t = tb * 32 + (wave >> 2) * 16 + 2 * k + (lane >> 5), pos = t & (SEQ - 1);
                const bf16* up = Ub + (size_t)t * AW + gi * 256 + chg * 8;
                float a[8];
#pragma unroll
                for (int j = 0; j < 8; ++j) a[j] = 0.f;
                v4u self;
#define POOL_W(W) do { v4u v_[W]; _Pragma("unroll") for (int i = 0; i < W; ++i) { const int back = (i <= pos) ? i : pos; v_[i] = *(const v4u*)(up - (size_t)back * AW); } self = v_[0]; \
                    _Pragma("unroll") for (int i = 0; i < W; ++i) { const float wgt = (i <= pos) ? 1.f : 0.f; _Pragma("unroll") for (int j = 0; j < 4; ++j) { a[2 * j] += wgt * __uint_as_float(v_[i][j] << 16); a[2 * j + 1] += wgt * __uint_as_float(v_[i][j] & 0xffff0000u); } } } while (0)
                if (gi == 0) POOL_W(2); else if (gi == 1) POOL_W(4); else if (gi == 2) POOL_W(8); else POOL_W(16);
#undef POOL_W
                const int w = 2 << gi; const int cw = (pos + 1 < w) ? pos + 1 : w;
                const float inv = 1.0f / (float)cw; v4u o;
#pragma unroll
                for (int j = 0; j < 4; ++j) { const float s0 = __uint_as_float(self[j] << 16), s1 = __uint_as_float(self[j] & 0xffff0000u); o[j] = pk2(a[2 * j] * inv - s0, a[2 * j + 1] * inv - s1); }
                *(v4u*)(A3 + (size_t)t * D + AW + gi * 256 + chg * 8) = o; }
        }
        { WSPTR(bt2, WS_BT2); WSPTR(wout_t, WS_WOUT); WSPTR(wout_t2, WS_WOUT2);
          pg8::W2Order S{G, bx, (const char*)wout_t, (const char*)bt2};
          pg8::EpiStoreBf16 E{wout_t2, D, 0, 0, 1.f};
          int nt_w2 = 256 / 64; asm volatile("" : "+s"(nt_w2));
          pg8::gemm_phase<pg8::EpiStoreBf16, pg8::W2Order, true, false>(lds, nt_w2, D, 256, S, E);
          __syncthreads(); }
        const float* lq1 = LDARG(3); const float* lk1 = LDARG(4); const float* lq2 = LDARG(5); const float* lk2 = LDARG(6); const float* subln_g = LDARG(7);
        float lam;
        { const float p1 = wave_sum(lq1[lane] * lk1[lane]), p2 = wave_sum(lq2[lane] * lk2[lane]); lam = expf(p1) - expf(p2) + 0.2f; }
        LAS float* wsf = (LAS float*)(lds + WSF_OFF);
        {
            volatile LAS int* qslot = (volatile LAS int*)(lds + MISC_OFF + 32);
            LAS unsigned* scr = (LAS unsigned*)(lds + wave * 16384);
            const bool prefer_cvt = (vcu & 15) < 7;
#ifdef PROBE_TIME
            if (tid == 0) { volatile LAS unsigned* pa_ = (volatile LAS unsigned*)(lds + MISC_OFF + 64); pa_[0] = 0u; pa_[1] = 0u; pa_[2] = 0u; pa_[3] = 0u; }
            __syncthreads();
            const unsigned long long pq0_ = __builtin_amdgcn_s_memrealtime();
#endif
            bool att_left = true, cvt_left = true;
            constexpr int CVT_CH = 32, NCH = 24576 / CVT_CH, I_GU = 2 * 32 * 8 * 32;
            const int xq = (int)(xb_xcc_id() & 7u); int qoff = 0;
            for (;;) {
                int kind = -1, idx = 0, aq = 0;
#pragma unroll 1
                for (int pass = 0; pass < 2 && kind < 0; ++pass) {
                    const bool try_cvt = (pass == 0) ? prefer_cvt : !prefer_cvt;
                    if (try_cvt) {
                        if (cvt_left) {
                            if (tid == 0) qslot[0] = (int)__hip_atomic_fetch_add((unsigned*)(ctl + CW_QCVT), 1u, RLX_AGENT);
                            __syncthreads(); idx = qslot[0]; __syncthreads();
                            if (idx < NCH) kind = 1; else cvt_left = false;
                        }
                    } else {
                        while (att_left && kind < 0) {
                            aq = (xq + qoff) & 7;
                            if (tid == 0) qslot[0] = (int)__hip_atomic_fetch_add((unsigned*)(ctl + CW_QATT + 64 * aq), 1u, RLX_AGENT);
                            __syncthreads(); idx = qslot[0]; __syncthreads();
                            if (idx < 64) kind = 0; else { ++qoff; if (qoff == 8) att_left = false; }
                        }
                    }
                }
                if (kind < 0) break;
                if (kind == 1) {
                    const float* norm2_g = LDARG(11); const float* w_gate = LDARG(16); const float* w_up = LDARG(17); const float* w_down = LDARG(18);
                    unsigned char* ws2 = args.ws; asm volatile("" : "+s"(ws2)); bf16* wgu_t = (bf16*)(ws2 + WS_WGU); bf16* wd_t = (bf16*)(ws2 + WS_WD);
                    int lane2 = lane; asm volatile("" : "+v"(lane2));
#define CVT_ITEM(IT, rr) do { int r = (rr); if (r < I_GU) { const bool up = r >= I_GU / 2; if (up) r -= I_GU / 2; const int e = r / 256, q = r % 256, kb = q % 32, nb = q / 32, k0 = 64 * kb, n0 = 64 * nb;   \
                            const float* W = (up ? w_up : w_gate) + (size_t)e * D * FF; const int drow = (n0 >> 7) * 256 + (up ? 128 : 0) + (n0 & 127); \
                            IT = TrItem{(const GAS float*)(W + (size_t)k0 * FF + n0), FF, (GAS bf16*)(wgu_t + ((size_t)e * 1024 + drow) * D + k0), D, (const GAS float*)(norm2_g + k0)}; } \
                        else { r -= I_GU; const int e = r / 256, q = r % 256, kb = q % 8, nb = q / 8, k0 = 64 * kb, n0 = 64 * nb; \
                            IT = TrItem{(const GAS float*)(w_down + (size_t)e * FF * D + (size_t)k0 * D + n0), D, (GAS bf16*)(wd_t + ((size_t)e * D + n0) * FF + k0), FF, (const GAS float*)nullptr}; } } while (0)
                    const int r0 = idx * CVT_CH + wave * (CVT_CH / 8);
                    TrItem ia, ib; f32x4 va[16], vb2[16]; f32x2 sa[8], sb[8];
                    CVT_ITEM(ia, r0); tr_load(ia, va, sa, lane2);
#pragma unroll 1
                    for (int i = 0; i < CVT_CH / 8; i += 2) {
                        CVT_ITEM(ib, r0 + i + 1); tr_load(ib, vb2, sb, lane2);
                        tr_finish(ia, va, sa, scr, lane2);
                        if (i + 2 < CVT_CH / 8) { CVT_ITEM(ia, r0 + i + 2); tr_load(ia, va, sa, lane2); }
                        tr_finish(ib, vb2, sb, scr, lane2);
                    }
#undef CVT_ITEM
                } else {
                    const int qb = 15 - (idx & 15), bh = aq + 8 * (idx >> 4);
#ifdef PROBE_TIME
                    const unsigned long long pu0_ = __builtin_amdgcn_s_memrealtime();
#endif
                    att::attn_unit(bh >> 3, bh & 7, qb, Qb, Kb, Vb, A3, subln_g, lam, lds, wsf);
#ifdef PROBE_TIME
                    if (tid == 0) { volatile LAS unsigned* pa_ = (volatile LAS unsigned*)(lds + MISC_OFF + 64); pa_[2] += (unsigned)(__builtin_amdgcn_s_memrealtime() - pu0_); pa_[3] += 1u; }
#endif
                }
            }
#ifdef PROBE_TIME
            __syncthreads();
            if (bx == 16) { volatile LAS unsigned* pa_ = (volatile LAS unsigned*)(lds + MISC_OFF + 64);
                const unsigned long long now_ = __builtin_amdgcn_s_memrealtime();
                unsigned long long q_ = (PROBE_TIME == 1) ? pa_[0] : (PROBE_TIME == 2) ? pa_[2] : (PROBE_TIME == 3) ? (unsigned)(now_ - pq0_) : (PROBE_TIME == 4) ? pa_[1] * 100ull : pa_[3] * 1000ull;
                const unsigned long long until_ = now_ + 3ull * q_;
                while (__builtin_amdgcn_s_memrealtime() < until_) __builtin_amdgcn_s_sleep(8); }
#endif
        }
        if (BOTH(2)) GRID_BAR();
    }

    if (IN(3)) {
        PHASE_WS(); WSPTR(wout_t2, WS_WOUT2); WSPTR(A3, WS_A3); WSPTR(rb, WS_RB);
        pg8::DenseOrder S; S.init(T, D, G, bx, A3, wout_t2, D, D);
        pg8::EpiStoreBf16 E{rb, D, 0, 0, 1.f};
        pg8::gemm_phase<pg8::EpiStoreBf16, pg8::DenseOrder, true, false>(lds, D / 64, D, D, S, E);
        if (BOTH(3)) GRID_BAR();
    }

    if (IN(4)) {
        PHASE_WS(); WSPTR(wfrag, WS_WFRAG); WSPTR(rb, WS_RB); WSPTR(hb, WS_HB); unsigned* tokl = (unsigned*)(ws + WS_TOK); f32x2* swl = (f32x2*)(ws + WS_SW);
        const float* x = LDARG(0); const float* norm2_g = LDARG(11); const float* b_coarse = LDARG(13); const float* b_fine = LDARG(15);
        LAS float* part = (LAS float*)lds;
        LAS float* ssqs = (LAS float*)(lds + 73728);
        LAS float* logit = (LAS float*)(lds + 73728 + 1024);
        const int r32 = lane & 31, hi = lane >> 5, rsub = lane >> 4, cg = lane & 15;
        LAS unsigned char* stg = lds + wave * 9216;
        const __amdgpu_buffer_rsrc_t rsx = __builtin_amdgcn_make_buffer_rsrc((void*)x, 0, T * D * 4, 0x00020000);
        const __amdgpu_buffer_rsrc_t rsr = __builtin_amdgcn_make_buffer_rsrc((void*)rb, 0, T * D * 2, 0x00020000);
        const __amdgpu_buffer_rsrc_t rsh = __builtin_amdgcn_make_buffer_rsrc((void*)hb, 0, T * D * 2, 0x00020000);
        for (int rblk = vcu; rblk < T / 32; rblk += G) {
            const int R0 = rblk * 32;
            const unsigned vo4 = (unsigned)(rsub * D + 4 * cg) * 4u, vo2 = (unsigned)(rsub * D + 4 * cg) * 2u; const unsigned so0 = (unsigned)(R0 * D + wave * 256);
            f32x16 acc0, acc1;
#pragma unroll
            for (int r = 0; r < 16; ++r) { acc0[r] = 0.f; acc1[r] = 0.f; }
            float sq[8];
#pragma unroll
            for (int j = 0; j < 8; ++j) sq[j] = 0.f;
            f32x4 xa[8]; v2u ra[8];
#define P4_LOAD(XV, RV, c) do { _Pragma("unroll") for (int j = 0; j < 8; ++j) { const unsigned so_ = so0 + (unsigned)(4 * j * D + 64 * (c)); \
                XV[j] = __builtin_bit_cast(f32x4, __builtin_amdgcn_raw_buffer_load_b128(rsx, vo4, so_ * 4u, 0)); RV[j] = __builtin_amdgcn_raw_buffer_load_b64(rsr, vo2, so_ * 2u, 0); } } while (0)
#define P4_CHUNK(XV, RV, c, NEXT) do { \
                bf16x8 wfr[4][4]; \
                _Pragma("unroll") for (int s_ = 0; s_ < 4; ++s_) { const bf16x8* wf_ = (const bf16x8*)wfrag + (size_t)(wave * 16 + 4 * (c) + s_) * 256 + lane; wfr[s_][0] = wf_[0]; wfr[s_][1] = wf_[64]; wfr[s_][2] = wf_[128]; wfr[s_][3] = wf_[192]; } \
                _Pragma("unroll") for (int j = 0; j < 8; ++j) { f32x4 h4 = XV[j]; \
                    h4.x += __uint_as_float(RV[j].x << 16); h4.y += __uint_as_float(RV[j].x & 0xffff0000u); h4.z += __uint_as_float(RV[j].y << 16); h4.w += __uint_as_float(RV[j].y & 0xffff0000u); \
                    sq[j] += (h4.x * h4.x + h4.y * h4.y) + (h4.z * h4.z + h4.w * h4.w); \
                    const unsigned h01 = pk2(h4.x, h4.y), h23 = pk2(h4.z, h4.w); \
                    __builtin_amdgcn_raw_buffer_store_b64((v2u){h01, h23}, rsh, vo2, (so0 + (unsigned)(4 * j * D + 64 * (c))) * 2u, 0); \
                    const unsigned l01 = pk2(h4.x - __uint_as_float(h01 << 16), h4.y - __uint_as_float(h01 & 0xffff0000u)), l23 = pk2(h4.z - __uint_as_float(h23 << 16), h4.w - __uint_as_float(h23 & 0xffff0000u)); \
                    *(LAS v2u*)(stg + (4 * j + rsub) * 144 + cg * 8) = (v2u){h01, h23}; *(LAS v2u*)(stg + 4608 + (4 * j + rsub) * 144 + cg * 8) = (v2u){l01, l23}; } \
                if (NEXT) { P4_LOAD(XV, RV, (c) + 1); } \
                LDS_WAIT(); asm volatile("" ::: "memory"); \
                _Pragma("unroll") for (int s_ = 0; s_ < 4; ++s_) { \
                    const bf16x8 ah = *(const LAS bf16x8*)(stg + r32 * 144 + s_ * 32 + hi * 16), al = *(const LAS bf16x8*)(stg + 4608 + r32 * 144 + s_ * 32 + hi * 16); \
                    acc0 = __builtin_amdgcn_mfma_f32_32x32x16_bf16(ah, wfr[s_][0], acc0, 0, 0, 0); acc0 = __builtin_amdgcn_mfma_f32_32x32x16_bf16(al, wfr[s_][0], acc0, 0, 0, 0); acc0 = __builtin_amdgcn_mfma_f32_32x32x16_bf16(ah, wfr[s_][1], acc0, 0, 0, 0); \
                    acc1 = __builtin_amdgcn_mfma_f32_32x32x16_bf16(ah, wfr[s_][2], acc1, 0, 0, 0); acc1 = __builtin_amdgcn_mfma_f32_32x32x16_bf16(al, wfr[s_][2], acc1, 0, 0, 0); acc1 = __builtin_amdgcn_mfma_f32_32x32x16_bf16(ah, wfr[s_][3], acc1, 0, 0, 0); } \
                LDS_WAIT(); asm volatile("" ::: "memory"); __builtin_amdgcn_sched_barrier(0); } while (0)
            P4_LOAD(xa, ra, 0);
#pragma unroll 1
            for (int c = 0; c < 4; ++c) P4_CHUNK(xa, ra, c, c < 3);
#undef P4_LOAD
#undef P4_CHUNK
#pragma unroll
            for (int j = 0; j < 8; ++j) {
#pragma unroll
                for (int off = 1; off < 16; off <<= 1) sq[j] += __shfl_xor(sq[j], off);
            }
            __syncthreads();
#pragma unroll
            for (int r = 0; r < 16; ++r) { part[((wave * 2 + 0) * 16 + r) * 64 + lane] = acc0[r]; part[((wave * 2 + 1) * 16 + r) * 64 + lane] = acc1[r]; }
            if (cg == 0) {
#pragma unroll
                for (int j = 0; j < 8; ++j) ssqs[wave * 32 + 4 * j + rsub] = sq[j]; }
            __syncthreads();
#pragma unroll
            for (int q = 0; q < 4; ++q) { const int idx = tid + 512 * q; float sm = 0.f;
#pragma unroll
                for (int w = 0; w < 8; ++w) sm += part[w * 2048 + idx];
                const int nt_ = idx >> 10, r = (idx >> 6) & 15, ln = idx & 63; const int row = att::crow(r, ln >> 5), n = nt_ * 32 + (ln & 31);
                logit[row * 64 + n] = sm; }
            __syncthreads();
            if (tid < 32) {
                const int row = tid, token = R0 + row; float ss = 0.f;
#pragma unroll
                for (int w = 0; w < 8; ++w) ss += ssqs[w * 32 + row];
                const float rs = rsqrtf(ss * (1.f / D) + RMS_EPS);
                const LAS float* lg = logit + row * 64;
                float c[4];
#pragma unroll
                for (int k = 0; k < 4; ++k) c[k] = lg[32 + k] * rs + b_coarse[k];
                float cb = c[0]; int g = 0;
#pragma unroll
                for (int k = 1; k < 4; ++k) if (c[k] > cb) { cb = c[k]; g = k; }
                float den = 0.f;
#pragma unroll
                for (int k = 0; k < 4; ++k) den += expf(c[k] - cb);
                const float pg = 1.0f / den;
                float f[8];
#pragma unroll
                for (int k = 0; k < 8; ++k) f[k] = lg[g * 8 + k] * rs + b_fine[g * 8 + k];
                float v0 = f[0]; int i0 = 0;
#pragma unroll
                for (int k = 1; k < 8; ++k) if (f[k] > v0) { v0 = f[k]; i0 = k; }
                float v1 = -INFINITY; int i1 = 0;
#pragma unroll
                for (int k = 0; k < 8; ++k) if (k != i0 && f[k] > v1) { v1 = f[k]; i1 = k; }
                const float ex = expf(v1 - v0); const float w0 = pg / (1.0f + ex), w1 = pg * ex / (1.0f + ex);
                const int e0 = g * 8 + i0, e1 = g * 8 + i1;
                const unsigned s0 = __hip_atomic_fetch_add((unsigned*)(ctl + CW_CNT + 64 * e0), 1u, RLX_AGENT);
                const unsigned s1 = __hip_atomic_fetch_add((unsigned*)(ctl + CW_CNT + 64 * e1), 1u, RLX_AGENT);
                tokl[(size_t)e0 * 8192 + s0] = (unsigned)token; swl[(size_t)e0 * 8192 + s0] = (f32x2){rs, w0};
                tokl[(size_t)e1 * 8192 + s1] = (unsigned)token | 0x10000u; swl[(size_t)e1 * 8192 + s1] = (f32x2){rs, w1};
            }
        }
        __syncthreads();
        if (BOTH(4)) GRID_BAR();
    }

    if (IN(5) || IN(6) || IN(7)) {
        PHASE_WS(); WSPTR(hb, WS_HB); WSPTR(wgu_t, WS_WGU); WSPTR(wd_t, WS_WD); WSPTR(hmid, WS_HMID); WSPTR(yb, WS_Y); unsigned* tokl = (unsigned*)(ws + WS_TOK); f32x2* swl = (f32x2*)(ws + WS_SW);
        LAS int* tab = (LAS int*)(lds + TAB_OFF);
        if (tid < 32) tab[40 + tid] = (int)__hip_atomic_load((unsigned*)(ctl + CW_CNT + 64 * tid), RLX_AGENT);
        __syncthreads();
        if (tid == 0) { int acc = 0; for (int e = 0; e < 32; ++e) { tab[e] = acc; acc += (tab[40 + e] + 255) >> 8; } tab[32] = acc; }
        __syncthreads();
        const int NTt = __builtin_amdgcn_readfirstlane(tab[32]); const int T0 = NTt < 64 ? NTt : 64;
        int nb = (NTt - T0) * 4; if (nb > G / 2) nb = G / 2;
        if (IN(5)) {
            pg8::MoeOrder<4, true> S{0, G, vcu, 0, T0, tab, (const char*)hb, (const char*)wgu_t, tokl};
            pg8::EpiGateUp E{hmid, swl};
            pg8::gemm_phase<pg8::EpiGateUp, pg8::MoeOrder<4, true>, true, true>(lds, D / 64, D, D, S, E);
            if (BOTH(5)) GRID_BAR();
        }
        if (IN(6)) {
            { pg8::MoeOrder<4, true> S{0, nb, vcu, T0, NTt, tab, (const char*)hb, (const char*)wgu_t, tokl};
              pg8::EpiGateUp E{hmid, swl};
              pg8::gemm_phase<pg8::EpiGateUp, pg8::MoeOrder<4, true>, true, true>(lds, D / 64, D, D, S, E); }
            { pg8::MoeOrder<8, false> S{nb, G - nb, vcu, 0, T0, tab, (const char*)hmid, (const char*)wd_t, tokl};
              pg8::EpiDown E{yb, tokl};
              pg8::gemm_phase<pg8::EpiDown, pg8::MoeOrder<8, false>, true, false>(lds, FF / 64, FF, FF, S, E); }
            if (BOTH(6)) GRID_BAR();
        }
        if (IN(7)) {
            pg8::MoeOrder<8, false> S{0, G, vcu, T0, NTt, tab, (const char*)hmid, (const char*)wd_t, tokl};
            pg8::EpiDown E{yb, tokl};
            pg8::gemm_phase<pg8::EpiDown, pg8::MoeOrder<8, false>, true, false>(lds, FF / 64, FF, FF, S, E);
            if (BOTH(7)) GRID_BAR();
        }
    }

    if (IN(8)) {
        PHASE_WS(); WSPTR(yb, WS_Y); WSPTR(hb, WS_HB);
        const float* final_g = LDARG(19);
        for (int m = gw; m < T; m += NGW) {
            f32x4* orow = (f32x4*)(out + (size_t)m * D) + 2 * lane; f32x4 v[8]; float s = 0.f;
            const v4u* y0 = (const v4u*)(yb + (size_t)m * D) + lane; const v4u* y1 = (const v4u*)(yb + ((size_t)T + m) * D) + lane; const v4u* r0 = (const v4u*)(hb + (size_t)m * D) + lane;
#pragma unroll
            for (int j = 0; j < 4; ++j) { const v4u a = y0[64 * j], b = y1[64 * j], c = r0[64 * j];
                v[2 * j].x = __uint_as_float(a.x << 16) + __uint_as_float(b.x << 16) + __uint_as_float(c.x << 16); v[2 * j].y = __uint_as_float(a.x & 0xffff0000u) + __uint_as_float(b.x & 0xffff0000u) + __uint_as_float(c.x & 0xffff0000u);
                v[2 * j].z = __uint_as_float(a.y << 16) + __uint_as_float(b.y << 16) + __uint_as_float(c.y << 16); v[2 * j].w = __uint_as_float(a.y & 0xffff0000u) + __uint_as_float(b.y & 0xffff0000u) + __uint_as_float(c.y & 0xffff0000u);
                v[2 * j + 1].x = __uint_as_float(a.z << 16) + __uint_as_float(b.z << 16) + __uint_as_float(c.z << 16); v[2 * j + 1].y = __uint_as_float(a.z & 0xffff0000u) + __uint_as_float(b.z & 0xffff0000u) + __uint_as_float(c.z & 0xffff0000u);
                v[2 * j + 1].z = __uint_as_float(a.w << 16) + __uint_as_float(b.w << 16) + __uint_as_float(c.w << 16); v[2 * j + 1].w = __uint_as_float(a.w & 0xffff0000u) + __uint_as_float(b.w & 0xffff0000u) + __uint_as_float(c.w & 0xffff0000u); }
#pragma unroll
            for (int j = 0; j < 8; ++j) s += (v[j].x * v[j].x + v[j].y * v[j].y) + (v[j].z * v[j].z + v[j].w * v[j].w);
            const float rstd = rsqrtf(wave_sum(s) * (1.f / D) + RMS_EPS);
#pragma unroll
            for (int j = 0; j < 4; ++j) { const f32x4 g0 = ((const f32x4*)final_g)[2 * lane + 128 * j], g1 = ((const f32x4*)final_g)[2 * lane + 128 * j + 1]; orow[128 * j] = v[2 * j] * rstd * g0; orow[128 * j + 1] = v[2 * j + 1] * rstd * g1; }
        }
    }
#undef IN
#undef BOTH
#undef GRID_BAR
}

extern "C" void kernel_launch(void* const* d_in, const int* in_sizes, int n_in, void* d_out, int out_size, void* d_ws, size_t ws_size, hipStream_t stream) {
    static int grid = 0;
    if (grid == 0) {
        if (n_in != 20 || out_size != T * D || ws_size < WS_END) { fprintf(stderr, "kernel_launch: unexpected shapes (n_in %d out %d ws %zu)\n", n_in, out_size, ws_size); grid = -1; return; }
        int dev = 0, cus = 0, per_cu = 0;
        if (hipGetDevice(&dev) != hipSuccess || hipDeviceGetAttribute(&cus, hipDeviceAttributeMultiprocessorCount, dev) != hipSuccess) { grid = -1; return; }
        if (hipFuncSetAttribute((const void*)hymba_fwd, hipFuncAttributeMaxDynamicSharedMemorySize, LDS_BYTES) != hipSuccess) { fprintf(stderr, "kernel_launch: hipFuncSetAttribute failed\n"); grid = -1; return; }
        if (hipOccupancyMaxActiveBlocksPerMultiprocessor(&per_cu, (const void*)hymba_fwd, 512, LDS_BYTES) != hipSuccess || per_cu < 1) fprintf(stderr, "kernel_launch: occupancy query reports %d\n", per_cu);
        (void)hipGetLastError();
        grid = cus;
    }
    if (grid < 0) return;
    (void)hipMemsetAsync((char*)d_ws + WS_CTL, 0, CTL_ZERO_BYTES, stream);
    Args a{};
    for (int i = 0; i < 20; ++i) a.in[i] = (const float*)d_in[i];
    a.out = (float*)d_out; a.ws = (unsigned char*)d_ws;
    if (MK_N_LAUNCHES == 1) { a.ph_lo = 0; a.ph_hi = NPH; a.li = 0; hipLaunchKernelGGL(hymba_fwd, dim3(grid), dim3(512), LDS_BYTES, stream, a); }
    else { for (int p = 0; p < NPH; ++p) { a.ph_lo = p; a.ph_hi = p + 1; a.li = p; hipLaunchKernelGGL(hymba_fwd, dim3(grid), dim3(512), LDS_BYTES, stream, a);
            if (p == PROBE_DUP) { if (p == 4) (void)hipMemsetAsync((char*)d_ws + WS_CTL, 0, CTL_ZERO_BYTES, stream); if (p == 2) (void)hipMemsetAsync((char*)d_ws + WS_CTL + CW_QATT * 4, 0, 8 * 256, stream); hipLaunchKernelGGL(hymba_fwd, dim3(grid), dim3(512), LDS_BYTES, stream, a); } } }
}
```
